# Optimizing an MI355X kernel written in HIP

```python
import math
import jax, jax.numpy as jnp
from jax import lax
import numpy as np

D_MODEL = 2048
BATCH = 4
SEQ = 4096
DEPTH = 1
DEC_BATCH = 32
DEC_SEQ = 16
PAST_LEN = 4096

CHUNK = 64
HEAD_DIM = 128
GDN_HEADS = 8
GDN_CONV = 4
SWA_HEADS = 8
SWA_KV_HEADS = 2
SWA_GROUP = SWA_HEADS // SWA_KV_HEADS
WINDOW = 128
D_FF = 5632
FFN_CONV = 3
N_MOD = 6
EPS = 1e-6

GDN_WIDTH = GDN_HEADS * HEAD_DIM
SWA_WIDTH = SWA_HEADS * HEAD_DIM
KV_WIDTH = SWA_KV_HEADS * HEAD_DIM
QKV_D_WIDTH = 3 * GDN_WIDTH
MIX_WIDTH = GDN_WIDTH + SWA_WIDTH
IN_WIDTH = QKV_D_WIDTH + GDN_WIDTH + 2 * GDN_HEADS + SWA_WIDTH + 2 * KV_WIDTH

kernel_name = 'hybrid_gdn_swa_convffn_stream_step'


def rms_norm(x, w):
    xf = x.astype(jnp.float32)
    y = xf * lax.rsqrt(jnp.mean(xf * xf, axis=-1, keepdims=True) + EPS)
    return (y * w.astype(jnp.float32)).astype(x.dtype)


def l2_norm(x):
    xf = x.astype(jnp.float32)
    return xf * lax.rsqrt(jnp.sum(xf * xf, axis=-1, keepdims=True) + EPS)


def causal_dwconv(x_ext, w):
    width = w.shape[0]
    L = x_ext.shape[1] - width + 1
    out = x_ext[:, 0:L] * w[0]
    for i in range(1, width):
        out = out + x_ext[:, i:i + L] * w[i]
    return out


def alibi_slopes():
    h = jnp.arange(1, SWA_HEADS + 1, dtype=jnp.float32)
    return (2.0 ** (-8.0 * h / SWA_HEADS)).reshape(SWA_KV_HEADS, SWA_GROUP)


def gated_delta_rule(q, k, v, g, beta, s0, chunk):
    B, L, H, DK = q.shape
    DV = v.shape[-1]
    n = L // chunk

    def to_blocks(t):
        t = t.reshape((B, n, chunk, H) + t.shape[3:])
        return jnp.moveaxis(t, 3, 1)

    q, k, v, g, beta = [to_blocks(t) for t in (q, k, v, g, beta)]
    gc = jnp.cumsum(g, axis=-1)
    idx = jnp.arange(chunk)
    incl = idx[:, None] >= idx[None, :]
    strict = idx[:, None] > idx[None, :]
    decay = jnp.exp(jnp.where(incl, gc[..., :, None] - gc[..., None, :], -jnp.inf))
    kb = k * beta[..., None]
    a = jnp.where(strict, jnp.einsum('bhnid,bhnjd->bhnij', kb, k) * decay, 0.0)
    t_mat = a + jnp.eye(chunk, dtype=a.dtype)
    rhs = jnp.concatenate([v * beta[..., None], kb * jnp.exp(gc)[..., None]], axis=-1)
    sol = lax.linalg.triangular_solve(t_mat, rhs, left_side=True, lower=True, unit_diagonal=True)
    u, w = sol[..., :DV], sol[..., DV:]
    qk = jnp.where(incl, jnp.einsum('bhnid,bhnjd->bhnij', q, k) * decay, 0.0)
    qg = q * jnp.exp(gc)[..., None]
    kd = k * jnp.exp(gc[..., -1:] - gc)[..., None]
    gl = jnp.exp(gc[..., -1])

    def step(s, xs):
        u_n, w_n, qk_n, qg_n, kd_n, gl_n = xs
        v_new = u_n - jnp.einsum('bhck,bhkv->bhcv', w_n, s)
        o_n = jnp.einsum('bhck,bhkv->bhcv', qg_n, s) + jnp.einsum('bhij,bhjv->bhiv', qk_n, v_new)
        s = s * gl_n[..., None, None] + jnp.einsum('bhck,bhcv->bhkv', kd_n, v_new)
        return s, o_n

    xs = tuple(jnp.moveaxis(t, 2, 0) for t in (u, w, qk, qg, kd, gl))
    s_fin, o = lax.scan(step, s0, xs)
    o = jnp.transpose(o, (1, 0, 3, 2, 4)).reshape(B, L, H, DV)
    return o, s_fin


def banded_sink_alibi_attention(q, k_ext, v_ext, pos0, chunk, sinks, slopes):
    B, L, HQ, D = q.shape
    n = L // chunk
    span = WINDOW + chunk
    kidx = jnp.arange(n)[:, None] * chunk + jnp.arange(span)[None, :]
    kb = jnp.take(k_ext, kidx, axis=1)
    vb = jnp.take(v_ext, kidx, axis=1)
    qb = q.reshape(B, n, chunk, SWA_KV_HEADS, SWA_GROUP, D)
    qpos = pos0 + jnp.arange(L).reshape(n, chunk)
    kpos = pos0 - WINDOW + kidx
    dist = jnp.abs(qpos[:, :, None] - kpos[:, None, :]).astype(jnp.float32)
    valid = (kpos >= 0)[:, None, :]
    s = jnp.einsum('bnqhgd,bnkhd->bnhgqk', qb, kb).astype(jnp.float32) * (D ** -0.5)
    s = s - slopes[:, :, None, None] * dist[:, None, None]
    s = jnp.where(valid[:, None, None], s, -jnp.inf)
    sink = sinks.astype(jnp.float32)[:, :, None, None]
    m = jnp.maximum(jnp.max(s, axis=-1, keepdims=True), sink)
    p = jnp.exp(s - m)
    probs = p / (jnp.sum(p, axis=-1, keepdims=True) + jnp.exp(sink - m))
    o = jnp.einsum('bnhgqk,bnkhd->bnqhgd', probs.astype(v_ext.dtype), vb)
    return o.reshape(B, L, HQ * D)


def hybrid_layer(x, c, conv_prev, s0, k_prev, v_prev, ffn_prev, pos0,
                 ada_w, ada_b, norm1_w, norm2_w, w_in, conv_qkv_w, a_log, dt_bias, gdn_norm_w,
                 q_norm_w, k_norm_w, sinks, w_o, w_up, ffn_conv_w, ffn_conv_b, w_down):
    B, L, _ = x.shape
    chunk = min(CHUNK, L)
    f32 = jnp.float32
    mod = (jax.nn.silu(c) @ ada_w + ada_b).reshape(B, N_MOD, D_MODEL)[:, :, None, :]
    shift1, scale1, gate1, shift2, scale2, gate2 = [mod[:, i] for i in range(N_MOD)]

    h = rms_norm(x, norm1_w) * (1 + scale1) + shift1
    proj = h @ w_in
    cuts = [QKV_D_WIDTH, QKV_D_WIDTH + GDN_WIDTH, QKV_D_WIDTH + GDN_WIDTH + GDN_HEADS,
            QKV_D_WIDTH + GDN_WIDTH + 2 * GDN_HEADS, QKV_D_WIDTH + GDN_WIDTH + 2 * GDN_HEADS + SWA_WIDTH,
            QKV_D_WIDTH + GDN_WIDTH + 2 * GDN_HEADS + SWA_WIDTH + KV_WIDTH]
    qkv_d, z_d, a_d, b_d, q_a, k_a, v_a = jnp.split(proj, cuts, axis=-1)

    qkv_ext = jnp.concatenate([conv_prev, qkv_d], axis=1)
    qkv_c = jax.nn.silu(causal_dwconv(qkv_ext, conv_qkv_w))
    qd, kd, vd = jnp.split(qkv_c, 3, axis=-1)
    qd = l2_norm(qd.reshape(B, L, GDN_HEADS, HEAD_DIM)) * (HEAD_DIM ** -0.5)
    kd = l2_norm(kd.reshape(B, L, GDN_HEADS, HEAD_DIM))
    vd = vd.reshape(B, L, GDN_HEADS, HEAD_DIM).astype(f32)
    g = -jnp.exp(a_log.astype(f32)) * jax.nn.softplus(a_d.astype(f32) + dt_bias.astype(f32))
    beta = jax.nn.sigmoid(b_d.astype(f32))
    o_d, s_new = gated_delta_rule(qd, kd, vd, g, beta, s0.astype(f32), chunk)
    o_d = rms_norm(o_d, gdn_norm_w) * jax.nn.silu(z_d.reshape(B, L, GDN_HEADS, HEAD_DIM).astype(f32))
    o_d = o_d.reshape(B, L, GDN_WIDTH).astype(x.dtype)

    qa = rms_norm(q_a.reshape(B, L, SWA_HEADS, HEAD_DIM), q_norm_w)
    ka = rms_norm(k_a.reshape(B, L, SWA_KV_HEADS, HEAD_DIM), k_norm_w)
    va = v_a.reshape(B, L, SWA_KV_HEADS, HEAD_DIM)
    k_ext = jnp.concatenate([k_prev, ka], axis=1)
    v_ext = jnp.concatenate([v_prev, va], axis=1)
    o_a = banded_sink_alibi_attention(qa, k_ext, v_ext, pos0, chunk,
                                      sinks.reshape(SWA_KV_HEADS, SWA_GROUP), alibi_slopes())

    x = x + gate1 * (jnp.concatenate([o_d, o_a], axis=-1) @ w_o)

    h2 = rms_norm(x, norm2_w) * (1 + scale2) + shift2
    u = h2 @ w_up
    u_ext = jnp.concatenate([ffn_prev, u], axis=1)
    u_c = causal_dwconv(u_ext, ffn_conv_w) + ffn_conv_b
    gt, up = jnp.split(u_c, 2, axis=-1)
    x = x + gate2 * ((jax.nn.silu(gt) * up) @ w_down)
    return (x, qkv_ext[:, -(GDN_CONV - 1):], s_new.astype(s0.dtype), k_ext[:, -WINDOW:],
            v_ext[:, -WINDOW:], u_ext[:, -(FFN_CONV - 1):])


def setup_inputs(seed: int = 0) -> dict:
    key = jax.random.key(seed)
    kit = iter(jax.random.split(key, 40))
    f32 = jnp.float32

    def nrm(shape, scale=1.0):
        return jax.random.normal(next(kit), shape, f32) * scale

    dt = jnp.exp(jax.random.uniform(next(kit), (DEPTH, GDN_HEADS), f32, math.log(1e-3), math.log(1e-1)))
    return {
        'x_prompt': nrm((BATCH, SEQ, D_MODEL)),
        'x_sample': nrm((DEC_BATCH, DEC_SEQ, D_MODEL)),
        'state_conv_qkv': nrm((DEPTH, DEC_BATCH, GDN_CONV - 1, QKV_D_WIDTH)),
        'state_delta': nrm((DEPTH, DEC_BATCH, GDN_HEADS, HEAD_DIM, HEAD_DIM), 0.1),
        'cache_swa_k': nrm((DEPTH, DEC_BATCH, WINDOW, SWA_KV_HEADS, HEAD_DIM)),
        'cache_swa_v': nrm((DEPTH, DEC_BATCH, WINDOW, SWA_KV_HEADS, HEAD_DIM)),
        'state_ffn_conv': nrm((DEPTH, DEC_BATCH, FFN_CONV - 1, 2 * D_FF)),
        'c_prompt': nrm((BATCH, D_MODEL)),
        'c_sample': nrm((DEC_BATCH, D_MODEL)),
        'ada_w': nrm((DEPTH, D_MODEL, N_MOD * D_MODEL), 0.5 * D_MODEL ** -0.5),
        'ada_b': nrm((DEPTH, N_MOD * D_MODEL), 0.1),
        'norm1_w': 1.0 + nrm((DEPTH, D_MODEL), 0.05),
        'norm2_w': 1.0 + nrm((DEPTH, D_MODEL), 0.05),
        'w_in': nrm((DEPTH, D_MODEL, IN_WIDTH), D_MODEL ** -0.5),
        'conv_qkv_w': nrm((DEPTH, GDN_CONV, QKV_D_WIDTH), GDN_CONV ** -0.5),
        'a_log': jnp.log(jax.random.uniform(next(kit), (DEPTH, GDN_HEADS), f32, 1.0, 16.0)),
        'dt_bias': dt + jnp.log(-jnp.expm1(-dt)),
        'gdn_norm_w': 1.0 + nrm((DEPTH, HEAD_DIM), 0.05),
        'q_norm_w': 1.0 + nrm((DEPTH, HEAD_DIM), 0.05),
        'k_norm_w': 1.0 + nrm((DEPTH, HEAD_DIM), 0.05),
        'sinks': nrm((DEPTH, SWA_HEADS), 0.5),
        'w_o': nrm((DEPTH, MIX_WIDTH, D_MODEL), MIX_WIDTH ** -0.5),
        'w_up': nrm((DEPTH, D_MODEL, 2 * D_FF), D_MODEL ** -0.5),
        'ffn_conv_w': nrm((DEPTH, FFN_CONV, 2 * D_FF), FFN_CONV ** -0.5),
        'ffn_conv_b': nrm((DEPTH, 2 * D_FF), 0.02),
        'w_down': nrm((DEPTH, D_FF, D_MODEL), D_FF ** -0.5),
    }


def reference(x_prompt, x_sample, state_conv_qkv, state_delta, cache_swa_k, cache_swa_v, state_ffn_conv,
              c_prompt, c_sample, ada_w, ada_b, norm1_w, norm2_w, w_in, conv_qkv_w, a_log, dt_bias,
              gdn_norm_w, q_norm_w, k_norm_w, sinks, w_o, w_up, ffn_conv_w, ffn_conv_b, w_down):
    xp, xs = x_prompt, x_sample
    acc_p = [[] for _ in range(5)]
    acc_s = [[] for _ in range(5)]
    for l in range(DEPTH):
        lw = (ada_w[l], ada_b[l], norm1_w[l], norm2_w[l], w_in[l], conv_qkv_w[l], a_log[l], dt_bias[l],
              gdn_norm_w[l], q_norm_w[l], k_norm_w[l], sinks[l], w_o[l], w_up[l], ffn_conv_w[l],
              ffn_conv_b[l], w_down[l])
        b, dt = xp.shape[0], xp.dtype
        zero_state = (jnp.zeros((b, GDN_CONV - 1, QKV_D_WIDTH), dt),
                      jnp.zeros((b, GDN_HEADS, HEAD_DIM, HEAD_DIM), dt),
                      jnp.zeros((b, WINDOW, SWA_KV_HEADS, HEAD_DIM), dt),
                      jnp.zeros((b, WINDOW, SWA_KV_HEADS, HEAD_DIM), dt),
                      jnp.zeros((b, FFN_CONV - 1, 2 * D_FF), dt))
        xp, *new_p = hybrid_layer(xp, c_prompt, *zero_state, 0, *lw)
        xs, *new_s = hybrid_layer(xs, c_sample, state_conv_qkv[l], state_delta[l], cache_swa_k[l],
                                  cache_swa_v[l], state_ffn_conv[l], PAST_LEN, *lw)
        for acc, t in zip(acc_p, new_p):
            acc.append(t)
        for acc, t in zip(acc_s, new_s):
            acc.append(t)
    p_conv_qkv, p_delta, p_swa_k, p_swa_v, p_ffn_conv = [jnp.stack(a) for a in acc_p]
    s_conv_qkv, s_delta, s_swa_k, s_swa_v, s_ffn_conv = [jnp.stack(a) for a in acc_s]
    return (xp, xs, p_conv_qkv, p_delta, p_swa_k, p_swa_v, p_ffn_conv,
            s_conv_qkv, s_delta, s_swa_k, s_swa_v, s_ffn_conv)
```

```cpp
#include <hip/hip_runtime.h>
#include <hip/hip_cooperative_groups.h>
#include <cstdio>
#include <cstdint>
namespace cg = cooperative_groups;

#ifndef N_LAUNCH_MODE
#define N_LAUNCH_MODE 1
#endif

#define LAS __attribute__((address_space(3)))
typedef unsigned short bf16_t;
typedef short bf16x8 __attribute__((ext_vector_type(8)));
typedef float f32x4 __attribute__((ext_vector_type(4)));
typedef float f32x2 __attribute__((ext_vector_type(2)));
typedef unsigned u32x4 __attribute__((ext_vector_type(4)));
typedef unsigned u32x2 __attribute__((ext_vector_type(2)));

constexpr int D = 2048, MP = 16384, MS = 512, MT = MP + MS, LP = 4096, LS = 16, NBP = 4, NBS = 32;
constexpr int NPROJ = 5632, NIN_PAD = 5888, INW = 5648, FF = 5632, FF2 = 11264;
constexpr int NMODW = 12288;
constexpr float EPS = 1e-6f;
constexpr int NTHR = 512;
constexpr int LDS_BYTES = 163840;

constexpr size_t O_YP = 0, O_YS = O_YP + (size_t)MP * D, O_PCONV = O_YS + (size_t)MS * D, O_PDELTA = O_PCONV + 4 * 3 * 3072,
                 O_PK = O_PDELTA + (size_t)4 * 8 * 128 * 128, O_PV = O_PK + 4 * 128 * 2 * 128, O_PFFN = O_PV + 4 * 128 * 2 * 128,
                 O_SCONV = O_PFFN + 4 * 2 * FF2, O_SDELTA = O_SCONV + 32 * 3 * 3072, O_SK = O_SDELTA + (size_t)32 * 8 * 128 * 128,
                 O_SV = O_SK + 32 * 128 * 2 * 128, O_SFFN = O_SV + 32 * 128 * 2 * 128, O_END = O_SFFN + 32 * 2 * FF2;

constexpr size_t WS_WUP = 0, WS_WDN = WS_WUP + (size_t)FF2 * D * 2, WS_WIN = WS_WDN + (size_t)D * FF * 2, WS_WO = WS_WIN + (size_t)NIN_PAD * D * 2,
                 WS_MOD = WS_WO + (size_t)D * D * 2, WS_AB = WS_MOD + (size_t)36 * NMODW * 4, WS_H = WS_AB + (size_t)MT * 16 * 4,
                 WS_PROJ = WS_H + (size_t)MT * D * 2, WS_GDN = WS_PROJ + (size_t)MT * NPROJ * 2;
constexpr size_t CH_BYTES = 73984, CH_W = 0, CH_QG = 16384, CH_QK = 32768, CH_KD = 40960, CH_UT = 57344, CH_GL = 73728;
constexpr size_t WS_END = WS_GDN + (size_t)2048 * CH_BYTES;
constexpr size_t WS_HEAD = WS_GDN, WS_HALO = WS_HEAD + (size_t)256 * 2 * FF2 * 4, WS_US = WS_HALO + (size_t)256 * 2 * FF2 * 4;
static_assert(WS_US + (size_t)MS * FF2 * 4 <= WS_END, "ffn side buffers");
constexpr size_t WS_BAR = WS_END, WS_ALL = WS_BAR + 16384;
static_assert(WS_ALL <= (size_t)536870912, "workspace");

struct Params { const float* in[26]; float* out; unsigned char* ws; int ph_lo, ph_hi; };
typedef const __attribute__((address_space(4))) Params* PP;

typedef __bf16 bf16x2_t __attribute__((ext_vector_type(2)));
__device__ __forceinline__ unsigned cvt_pk_bf16(float lo, float hi) { f32x2 f = {lo, hi}; bf16x2_t v = __builtin_convertvector(f, bf16x2_t); return __builtin_bit_cast(unsigned, v); }
__device__ __forceinline__ float bf_lo(unsigned u) { return __uint_as_float(u << 16); }
__device__ __forceinline__ float bf_hi(unsigned u) { return __uint_as_float(u & 0xffff0000u); }
__device__ __forceinline__ float bf2f(bf16_t b) { return __uint_as_float(((unsigned)b) << 16); }
__device__ __forceinline__ float silu_f(float x) { return x * __builtin_amdgcn_rcpf(1.0f + __expf(-x)); }
__device__ __forceinline__ float sigmoid_f(float x) { return __builtin_amdgcn_rcpf(1.0f + __expf(-x)); }
__device__ __forceinline__ float softplus_f(float x) { return x > 20.f ? x : log1pf(__expf(x)); }
template <int CTRL> __device__ __forceinline__ float dpp0(float v) { return __builtin_bit_cast(float, __builtin_amdgcn_update_dpp(0, __builtin_bit_cast(int, v), CTRL, 0xf, 0xf, true)); }
__device__ __forceinline__ int cond_of_row(int m) { return m < MP ? (m >> 12) : 4 + ((m - MP) >> 4); }
__device__ __forceinline__ void unpack8(u32x4 v, float* f) { f[0] = bf_lo(v.x); f[1] = bf_hi(v.x); f[2] = bf_lo(v.y); f[3] = bf_hi(v.y); f[4] = bf_lo(v.z); f[5] = bf_hi(v.z); f[6] = bf_lo(v.w); f[7] = bf_hi(v.w); }
__device__ __forceinline__ bf16x8 as_bf16x8(u32x4 v) { return __builtin_bit_cast(bf16x8, v); }

namespace pg8 {
constexpr int BM = 256, BK = 64, HALF = 128, HTB = HALF * BK * 2, STAGE_BYTES = 8 * HTB, NXCD = 8, WGM = 2;
__host__ __device__ __forceinline__ int lds_byte(int r, int c) { const int st = (r >> 4) * 2 + (c >> 5), rr = r & 15, cc = c & 31, ob = rr * 64 + cc * 2; return st * 1024 + (ob ^ (((ob >> 9) & 1) << 5)); }
__host__ __device__ __forceinline__ void stage_rc(int b, int& R, int& C) { const int st = b / 1024, sb = b % 1024, swz = sb ^ (((sb >> 9) & 1) << 5); R = (st >> 1) * 16 + swz / 64; C = (st & 1) * 32 + (swz % 64) / 2; }
struct Unit { int pm, pn, ks; };
struct Gemm { const bf16_t* A; const bf16_t* Bt; int M, N, K, ldk; };
struct StaticOrder {
    int nM, nN, nwg, G, c;
    __host__ __device__ __forceinline__ void init(int M, int N, int G_, int c_) { nM = M / BM; nN = N / BM; nwg = nM * nN; G = G_; c = c_; }
    __host__ __device__ bool next(int i, Unit& u) const {
        const long L = (long)i * G + c; if (L >= nwg) return false;
        int wgid = (int)L; { const int q = nwg / NXCD, r = nwg % NXCD, xcd = wgid % NXCD, off = wgid / NXCD; wgid = (xcd < r ? xcd * (q + 1) : r * (q + 1) + (xcd - r) * q) + off; }
        const int nig = WGM * nN, gid = wgid / nig, fm = gid * WGM, gsz = (nM - fm) < WGM ? (nM - fm) : WGM;
        u.pm = fm + ((wgid % nig) % gsz); u.pn = (wgid % nig) / gsz; u.ks = 0; return true;
    }
};
struct SplitOrder {
    int nM, nN, nS, nwg, G, c;
    __host__ __device__ __forceinline__ void init(int M, int N, int nS_, int G_, int c_) { nM = M / BM; nN = N / BM; nS = nS_; nwg = nM * nN * nS; G = G_; c = c_; }
    __host__ __device__ bool next(int i, Unit& u) const {
        const long L = (long)i * G + c; if (L >= nwg) return false;
        const int l = (int)L; u.ks = l % nS; const int t = l / nS; u.pn = t % nN; u.pm = t / nN; return true;
    }
};

template <class Epi, class Sched>
__device__ __forceinline__ void gemm_phase(LAS unsigned char* lds, const Gemm g, const Sched& S, const Epi& E) {
    const int tid = threadIdx.x, wid = __builtin_amdgcn_readfirstlane(tid >> 6), lane = tid & 63, wr = wid >> 2, wc = wid & 3, fr = lane & 15, fq = lane >> 4;
    const int K = g.ldk, nt = g.K / BK;
    const size_t sstep = (size_t)g.K * 2;
    unsigned voffA[2];
#pragma unroll
    for (int i = 0; i < 2; ++i) { int R, C; stage_rc(tid * 16 + i * 8192, R, C); voffA[i] = (unsigned)(R * K + C) * 2u; }
    const size_t kstep = (size_t)(BK * 2);
    const size_t hstep = (size_t)HALF * K * 2;
    const size_t tstep = 2 * hstep;
    const unsigned ldsw = (unsigned)wid * 1024u;
    const int aoff = lds_byte(wr * 64 + fr, fq * 8), boff = lds_byte(wc * 32 + fr, fq * 8);
#define PG8_SA(b, h) (((b) * 2 + (h)) * HTB)
#define PG8_SB(b, h) ((4 + (b) * 2 + (h)) * HTB)
#define PG8_STAGE(bufoff, gbase, voff) do { _Pragma("unroll") for (int _i = 0; _i < 2; ++_i) \
        __builtin_amdgcn_global_load_lds((const unsigned*)((const char*)(gbase) + (voff)[_i]), (LAS unsigned*)(lds + (bufoff) + ldsw + _i * 8192), 16, 0, 0); } while (0)
#define PG8_LDA(dst, b, h) do { _Pragma("unroll") for (int m = 0; m < 4; ++m) _Pragma("unroll") for (int k = 0; k < 2; ++k) dst[m][k] = *(const LAS bf16x8*)(lds + PG8_SA(b, h) + aoff + m * 2048 + k * 1024); } while (0)
#define PG8_LDB(dst, b, h) do { _Pragma("unroll") for (int n = 0; n < 2; ++n) _Pragma("unroll") for (int k = 0; k < 2; ++k) dst[n][k] = *(const LAS bf16x8*)(lds + PG8_SB(b, h) + boff + n * 2048 + k * 1024); } while (0)
#define PG8_MMA(ai, bj, At, Bt) do { __builtin_amdgcn_s_setprio(1); _Pragma("unroll") for (int m = 0; m < 4; ++m) _Pragma("unroll") for (int n = 0; n < 2; ++n) _Pragma("unroll") for (int k = 0; k < 2; ++k) \
        acc[ai][bj][m][n] = __builtin_amdgcn_mfma_f32_16x16x32_bf16(Bt[n][k], At[m][k], acc[ai][bj][m][n], 0, 0, 0); __builtin_amdgcn_s_setprio(0); } while (0)
#define PG8_WAIT_V(n) asm volatile("s_waitcnt vmcnt(" #n ")" ::: "memory")
#define PG8_WAIT_L(n) asm volatile("s_waitcnt lgkmcnt(" #n ")" ::: "memory")
#define PG8_BAR __builtin_amdgcn_s_barrier()
#define PG8_SCHED __builtin_amdgcn_sched_barrier(0)
    Unit cur, nxt; int ui = 0;
    if (!S.next(0, cur)) return;
    f32x4 acc[2][2][4][2];
#pragma unroll
    for (int a = 0; a < 2; ++a)
#pragma unroll
        for (int b = 0; b < 2; ++b)
#pragma unroll
            for (int m = 0; m < 4; ++m)
#pragma unroll
                for (int n = 0; n < 2; ++n) acc[a][b][m][n] = (f32x4){0.f, 0.f, 0.f, 0.f};
    bf16x8 At[4][2], B0[2][2], B1[2][2];
    const char* cA = (const char*)g.A + (size_t)cur.pm * tstep + cur.ks * sstep; const char* cB = (const char*)g.Bt + (size_t)cur.pn * tstep + cur.ks * sstep;
    PG8_STAGE(PG8_SB(0, 0), cB, voffA); PG8_STAGE(PG8_SA(0, 0), cA, voffA); PG8_STAGE(PG8_SB(0, 1), cB + hstep, voffA); PG8_STAGE(PG8_SA(0, 1), cA + hstep, voffA);
    if (wr == 1) PG8_BAR;
    PG8_WAIT_V(4); PG8_BAR;
    PG8_STAGE(PG8_SB(1, 0), cB + kstep, voffA); PG8_STAGE(PG8_SA(1, 0), cA + kstep, voffA); PG8_STAGE(PG8_SB(1, 1), cB + hstep + kstep, voffA);
    PG8_WAIT_V(6); PG8_BAR;
    for (;;) {
        const bool has_next = S.next(ui + 1, nxt);
        const char* nA = has_next ? (const char*)g.A + (size_t)nxt.pm * tstep + nxt.ks * sstep : cA; const char* nB = has_next ? (const char*)g.Bt + (size_t)nxt.pn * tstep + nxt.ks * sstep : cB;
        for (int t = 0; t < nt; t += 2) {
            const bool last = (t == nt - 2);
            const char* a1 = cA + (size_t)(t + 1) * kstep;
            const char* a2 = last ? nA : cA + (size_t)(t + 2) * kstep; const char* b2 = last ? nB : cB + (size_t)(t + 2) * kstep;
            const char* a3 = a2 + kstep; const char* b3 = b2 + kstep;
            PG8_LDB(B0, 0, 0); PG8_SCHED; PG8_LDA(At, 0, 0); PG8_STAGE(PG8_SA(1, 1), a1 + hstep, voffA);
            PG8_WAIT_L(8); PG8_BAR; PG8_WAIT_L(0); PG8_MMA(0, 0, At, B0); PG8_BAR; PG8_SCHED;
            PG8_LDB(B1, 0, 1); PG8_STAGE(PG8_SB(0, 0), b2, voffA);
            PG8_BAR; PG8_WAIT_L(0); PG8_MMA(0, 1, At, B1); PG8_BAR;
            PG8_LDA(At, 0, 1); PG8_STAGE(PG8_SA(0, 0), a2, voffA);
            PG8_BAR; PG8_WAIT_L(0); PG8_MMA(1, 0, At, B0); PG8_BAR; PG8_SCHED;
            PG8_STAGE(PG8_SB(0, 1), b2 + hstep, voffA);
            PG8_WAIT_V(6); PG8_BAR; PG8_MMA(1, 1, At, B1); PG8_BAR;
            PG8_LDB(B0, 1, 0); PG8_SCHED; PG8_LDA(At, 1, 0); PG8_STAGE(PG8_SA(0, 1), a2 + hstep, voffA);
            PG8_WAIT_L(8); PG8_BAR; PG8_WAIT_L(0); PG8_MMA(0, 0, At, B0); PG8_BAR; PG8_SCHED;
            PG8_LDB(B1, 1, 1); PG8_STAGE(PG8_SB(1, 0), b3, voffA);
            PG8_BAR; PG8_WAIT_L(0); PG8_MMA(0, 1, At, B1); PG8_BAR;
            PG8_LDA(At, 1, 1); PG8_STAGE(PG8_SA(1, 0), a3, voffA);
            PG8_BAR; PG8_WAIT_L(0); PG8_MMA(1, 0, At, B0); PG8_BAR; PG8_SCHED;
            PG8_STAGE(PG8_SB(1, 1), b3 + hstep, voffA);
            PG8_WAIT_V(6); PG8_BAR; PG8_MMA(1, 1, At, B1); PG8_BAR;
        }
        E(acc, cur, wr, wc, fr, fq);
        if (!has_next) break;
#pragma unroll
        for (int a = 0; a < 2; ++a)
#pragma unroll
            for (int b = 0; b < 2; ++b)
#pragma unroll
                for (int m = 0; m < 4; ++m)
#pragma unroll
                    for (int n = 0; n < 2; ++n) acc[a][b][m][n] = (f32x4){0.f, 0.f, 0.f, 0.f};
        cur = nxt; cA = nA; cB = nB; ++ui;
    }
    PG8_WAIT_V(0);
    if (wr == 0) PG8_BAR;
    PG8_BAR;
#undef PG8_SA
#undef PG8_SB
#undef PG8_STAGE
#undef PG8_LDA
#undef PG8_LDB
#undef PG8_MMA
#undef PG8_WAIT_V
#undef PG8_WAIT_L
#undef PG8_BAR
#undef PG8_SCHED
}
}
using pg8::Unit;

struct Epi1 {
    bf16_t* P; float* AB;
    __device__ __forceinline__ void operator()(const f32x4 (&acc)[2][2][4][2], const Unit& u, int wr, int wc, int fr, int fq) const {
        const int row0 = u.pm * 256 + wr * 64 + fr;
        if (u.pn < 22) {
            const int col0 = u.pn * 256 + wc * 32 + 4 * fq;
#pragma unroll
            for (int ai = 0; ai < 2; ++ai)
#pragma unroll
                for (int m = 0; m < 4; ++m) { bf16_t* rowp = P + (size_t)(row0 + ai * 128 + m * 16) * NPROJ + col0;
#pragma unroll
                    for (int bj = 0; bj < 2; ++bj)
#pragma unroll
                        for (int n = 0; n < 2; ++n) { const f32x4 a = acc[ai][bj][m][n]; u32x2 w; w.x = cvt_pk_bf16(a[0], a[1]); w.y = cvt_pk_bf16(a[2], a[3]); *(u32x2*)(rowp + bj * 128 + n * 16) = w; } }
        } else if (wc == 0) {
#pragma unroll
            for (int ai = 0; ai < 2; ++ai)
#pragma unroll
                for (int m = 0; m < 4; ++m) *(f32x4*)(AB + (size_t)(row0 + ai * 128 + m * 16) * 16 + 4 * fq) = acc[ai][0][m][0];
        }
    }
};
struct EpiRes {
    const float* xa; const float* xb; float* out; const float* mod; int gi;
    __device__ __forceinline__ void operator()(const f32x4 (&acc)[2][2][4][2], const Unit& u, int wr, int wc, int fr, int fq) const {
        const int row0 = u.pm * 256 + wr * 64 + fr, col0 = u.pn * 256 + wc * 32 + 4 * fq;
        const float* gr = mod + (size_t)cond_of_row(u.pm * 256) * NMODW + gi * D + col0;
        f32x4 g4[2][2];
#pragma unroll
        for (int bj = 0; bj < 2; ++bj)
#pragma unroll
            for (int n = 0; n < 2; ++n) g4[bj][n] = *(const f32x4*)(gr + bj * 128 + n * 16);
#pragma unroll
        for (int ai = 0; ai < 2; ++ai) {
            f32x4 xv[4][2][2];
#pragma unroll
            for (int m = 0; m < 4; ++m) { const float* xr = xa + (size_t)(row0 + ai * 128 + m * 16) * D + col0;
#pragma unroll
                for (int bj = 0; bj < 2; ++bj)
#pragma unroll
                    for (int n = 0; n < 2; ++n) xv[m][bj][n] = *(const f32x4*)(xr + bj * 128 + n * 16); }
            __builtin_amdgcn_sched_barrier(0);
#pragma unroll
            for (int m = 0; m < 4; ++m) { float* orow = out + (size_t)(row0 + ai * 128 + m * 16) * D + col0;
#pragma unroll
                for (int bj = 0; bj < 2; ++bj)
#pragma unroll
                    for (int n = 0; n < 2; ++n) *(f32x4*)(orow + bj * 128 + n * 16) = xv[m][bj][n] + g4[bj][n] * acc[ai][bj][m][n]; }
        }
    }
};
struct EpiPart {
    float* part;
    __device__ __forceinline__ void operator()(const f32x4 (&acc)[2][2][4][2], const Unit& u, int wr, int wc, int fr, int fq) const {
        const int row0 = u.pm * 256 + wr * 64 + fr, col0 = u.pn * 256 + wc * 32 + 4 * fq;
        float* base = part + (size_t)u.ks * MS * D;
#pragma unroll
        for (int ai = 0; ai < 2; ++ai)
#pragma unroll
            for (int m = 0; m < 4; ++m) { float* orow = base + (size_t)(row0 + ai * 128 + m * 16) * D + col0;
#pragma unroll
                for (int bj = 0; bj < 2; ++bj)
#pragma unroll
                    for (int n = 0; n < 2; ++n) *(f32x4*)(orow + bj * 128 + n * 16) = acc[ai][bj][m][n]; }
    }
};
struct Epi3 {
    bf16_t* ACT; float* HEAD; float* HALO; float* US; const float* cw; const float* cb;
    __device__ __forceinline__ void operator()(const f32x4 (&acc)[2][2][4][2], const Unit& u, int wr, int wc, int fr, int fq) const {
        const int cg0 = u.pn * 128 + wc * 32 + 4 * fq;
        if (u.pm >= 64) {
            const int row0 = (u.pm - 64) * 256 + wr * 64 + fr;
#pragma unroll
            for (int ai = 0; ai < 2; ++ai)
#pragma unroll
                for (int m = 0; m < 4; ++m) { float* rp = US + (size_t)(row0 + ai * 128 + m * 16) * FF2 + cg0;
#pragma unroll
                    for (int bj = 0; bj < 2; ++bj)
#pragma unroll
                        for (int n = 0; n < 2; ++n) *(f32x4*)(rp + bj * FF + n * 16) = acc[ai][bj][m][n]; }
            return;
        }
#pragma unroll
        for (int n = 0; n < 2; ++n) {
            const int cg = cg0 + n * 16;
            f32x4 w0[2], w1[2], w2[2], bb[2];
#pragma unroll
            for (int bj = 0; bj < 2; ++bj) { const int c = cg + bj * FF; w0[bj] = *(const f32x4*)(cw + c); w1[bj] = *(const f32x4*)(cw + FF2 + c); w2[bj] = *(const f32x4*)(cw + 2 * FF2 + c); bb[bj] = *(const f32x4*)(cb + c); }
#pragma unroll
            for (int ai = 0; ai < 2; ++ai) {
                const int blk = u.pm * 4 + ai * 2 + wr;
                const int rowb = blk * 64;
                f32x4 p15[2] = {{0.f, 0.f, 0.f, 0.f}, {0.f, 0.f, 0.f, 0.f}}, p14[2] = {{0.f, 0.f, 0.f, 0.f}, {0.f, 0.f, 0.f, 0.f}};
#pragma unroll
                for (int m = 0; m < 4; ++m) {
                    f32x4 uc[2];
#pragma unroll
                    for (int bj = 0; bj < 2; ++bj) { const f32x4 cur = acc[ai][bj][m][n]; f32x4 pr1, pr2, n15, n14;
#pragma unroll
                        for (int j = 0; j < 4; ++j) { pr1[j] = dpp0<0x111>(cur[j]) + p15[bj][j]; pr2[j] = dpp0<0x112>(cur[j]) + p14[bj][j]; n15[j] = dpp0<0x10F>(cur[j]); n14[j] = dpp0<0x10E>(cur[j]); }
                        p15[bj] = n15; p14[bj] = n14;
                        uc[bj] = w2[bj] * cur + w1[bj] * pr1 + w0[bj] * pr2 + bb[bj];
                        if (m == 0 && fr < 2) *(f32x4*)(HEAD + (size_t)(blk * 2 + fr) * FF2 + cg + bj * FF) = cur;
                        if (m == 3 && fr >= 14) *(f32x4*)(HALO + (size_t)(blk * 2 + fr - 14) * FF2 + cg + bj * FF) = cur;
                    }
                    if (m > 0 || fr >= 2) { u32x2 w; w.x = cvt_pk_bf16(silu_f(uc[0][0]) * uc[1][0], silu_f(uc[0][1]) * uc[1][1]); w.y = cvt_pk_bf16(silu_f(uc[0][2]) * uc[1][2], silu_f(uc[0][3]) * uc[1][3]);
                        *(u32x2*)(ACT + (size_t)(rowb + m * 16 + fr) * FF + cg) = w; }
                }
            }
        }
    }
};

struct TileDesc { const float* W; bf16_t* Wt; int K, N, k0, n0, sc0, nv; };
struct ConvPtrs { const float* up; const float* dn; const float* in; const float* o; unsigned char* ws; };
__device__ __forceinline__ ConvPtrs conv_ptrs(PP p) { ConvPtrs c; c.up = p->in[22]; c.dn = p->in[25]; c.in = p->in[13]; c.o = p->in[21]; c.ws = p->ws; return c; }
__device__ __forceinline__ TileDesc tile_desc(const float* up, const float* dn, const float* win, const float* wo, unsigned char* ws, int t) {
    constexpr int T_UP = 32 * 88, T_DN = 88 * 16, T_IN = 32 * 46;
    const int cls = t < T_UP ? 0 : t < T_UP + T_DN ? 1 : t < T_UP + T_DN + T_IN ? 2 : 3;
    const int u = t - (cls == 0 ? 0 : cls == 1 ? T_UP : cls == 2 ? T_UP + T_DN : T_UP + T_DN + T_IN);
    const int NTn = cls == 0 ? 88 : cls == 2 ? 46 : 16; const int q4 = u >> 2; const int nt = q4 % NTn, kt = (q4 / NTn) * 4 + (u & 3), n0 = nt * 128;
    TileDesc d;
    d.W = cls == 0 ? up : cls == 1 ? dn : cls == 2 ? win : wo;
    d.Wt = (bf16_t*)(ws + (cls == 0 ? WS_WUP : cls == 1 ? WS_WDN : cls == 2 ? WS_WIN : WS_WO));
    d.K = cls == 1 ? FF : D; d.N = cls == 0 ? FF2 : cls == 2 ? INW : D; d.k0 = kt * 64; d.n0 = n0;
    const int pn = n0 >> 8;
    d.sc0 = cls == 0 ? ((n0 & 255) < 128 ? 128 * pn : FF + 128 * pn) : cls == 2 ? (n0 < 4096 ? n0 : (n0 < NPROJ ? n0 + 16 : 4096)) : n0;
    d.nv = cls == 2 ? (n0 < NPROJ ? 128 : (n0 == NPROJ ? 16 : 0)) : 128;
    return d;
}
__device__ __forceinline__ void tile_load(const TileDesc& d, f32x4 (&v)[4]) {
    const int tx = threadIdx.x & 31, ty = threadIdx.x >> 5;
#pragma unroll
    for (int ps = 0; ps < 4; ++ps) v[ps] = (4 * tx < d.nv) ? *(const f32x4*)(d.W + (size_t)(d.k0 + ps * 16 + ty) * d.N + d.sc0 + 4 * tx) : (f32x4){0.f, 0.f, 0.f, 0.f};
}
__device__ __forceinline__ void tile_to_lds(const f32x4 (&v)[4], float* tile) {
    const int tx = threadIdx.x & 31, ty = threadIdx.x >> 5;
#pragma unroll
    for (int ps = 0; ps < 4; ++ps) *(f32x4*)(tile + (ps * 16 + ty) * 132 + ((4 * tx + 8 * ps) & 127)) = v[ps];
}
__device__ __forceinline__ void tile_store(const TileDesc& d, const float* tile) {
    const int n = threadIdx.x >> 2, ks = threadIdx.x & 3; float v[16];
#pragma unroll
    for (int j = 0; j < 16; ++j) v[j] = tile[(ks * 16 + j) * 132 + ((n + 8 * ks) & 127)];
    u32x4 w0, w1; w0.x = cvt_pk_bf16(v[0], v[1]); w0.y = cvt_pk_bf16(v[2], v[3]); w0.z = cvt_pk_bf16(v[4], v[5]); w0.w = cvt_pk_bf16(v[6], v[7]);
    w1.x = cvt_pk_bf16(v[8], v[9]); w1.y = cvt_pk_bf16(v[10], v[11]); w1.z = cvt_pk_bf16(v[12], v[13]); w1.w = cvt_pk_bf16(v[14], v[15]);
    bf16_t* dst = d.Wt + (size_t)(d.n0 + n) * d.K + d.k0 + ks * 16; *(u32x4*)dst = w0; *(u32x4*)(dst + 8) = w1;
}
__device__ __forceinline__ void convert_seq(const ConvPtrs p, int n_extra, int first, int base, int stride, int t_all, int split, int shift, float* tile) {
    const int cnt = n_extra + (base < t_all ? (t_all - base + stride - 1) / stride : 0);
    auto tid_of = [&](int i) { const int v = i < n_extra ? first + 64 * i : base + stride * (i - n_extra); return v < split ? v : v + shift; };
    f32x4 ra[4], rb[4];
    if (cnt > 0) tile_load(tile_desc(p.up, p.dn, p.in, p.o, p.ws, tid_of(0)), ra);
    if (cnt > 1) tile_load(tile_desc(p.up, p.dn, p.in, p.o, p.ws, tid_of(1)), rb);
    for (int i = 0; i < cnt; i += 2) {
        { const TileDesc d = tile_desc(p.up, p.dn, p.in, p.o, p.ws, tid_of(i));
          tile_to_lds(ra, tile); if (i + 2 < cnt) tile_load(tile_desc(p.up, p.dn, p.in, p.o, p.ws, tid_of(i + 2)), ra);
          __syncthreads(); tile_store(d, tile); __syncthreads(); }
        if (i + 1 < cnt) { const TileDesc d = tile_desc(p.up, p.dn, p.in, p.o, p.ws, tid_of(i + 1));
          tile_to_lds(rb, tile); if (i + 3 < cnt) tile_load(tile_desc(p.up, p.dn, p.in, p.o, p.ws, tid_of(i + 3)), rb);
          __syncthreads(); tile_store(d, tile); __syncthreads(); }
    }
}
__device__ __forceinline__ void adaln_strip(PP p, int strip, float* lds) {
    const float* cpr = p->in[7]; const float* csm = p->in[8]; const float* aw = p->in[9]; const float* ab = p->in[10];
    float* mod = (float*)(p->ws + WS_MOD);
    const int tid = threadIdx.x, col4 = tid & 15, kg = (tid >> 4) & 15, rh = tid >> 8;
    float* sc = lds;
    float* red = lds + 36 * 256;
    f32x4 acc[18];
#pragma unroll
    for (int i = 0; i < 18; ++i) acc[i] = (f32x4){0.f, 0.f, 0.f, 0.f};
    const int n0 = strip * 64 + col4 * 4;
    f32x4 w[4], wn[4], wm[4];
#pragma unroll
    for (int q = 0; q < 4; ++q) { w[q] = *(const f32x4*)(aw + (size_t)(kg * 4 + q) * NMODW + n0); wn[q] = *(const f32x4*)(aw + (size_t)(64 + kg * 4 + q) * NMODW + n0); }
#pragma unroll 1
    for (int step = 0; step < 32; ++step) {
        const int kc = (step >> 2) * 256, kl = (step & 3) * 64 + kg * 4;
        if (step + 2 < 32) { const int kn = ((step + 2) >> 2) * 256 + ((step + 2) & 3) * 64 + kg * 4;
#pragma unroll
            for (int q = 0; q < 4; ++q) wm[q] = *(const f32x4*)(aw + (size_t)(kn + q) * NMODW + n0); }
        if ((step & 3) == 0) {
            __syncthreads();
#pragma unroll 1
            for (int hb = 0; hb < 2; ++hb) {
                float cv[9];
#pragma unroll
                for (int it2 = 0; it2 < 9; ++it2) { const int e = tid + (hb * 9 + it2) * NTHR, i = e >> 8, k = e & 255; cv[it2] = i < 4 ? cpr[i * D + kc + k] : csm[(i - 4) * D + kc + k]; }
#pragma unroll
                for (int it2 = 0; it2 < 9; ++it2) sc[tid + (hb * 9 + it2) * NTHR] = silu_f(cv[it2]);
            }
            __syncthreads();
        }
#pragma unroll
        for (int i = 0; i < 18; ++i) { const f32x4 s4 = *(const f32x4*)(sc + (rh * 18 + i) * 256 + kl);
            acc[i] += w[0] * s4[0]; acc[i] += w[1] * s4[1]; acc[i] += w[2] * s4[2]; acc[i] += w[3] * s4[3]; }
#pragma unroll
        for (int q = 0; q < 4; ++q) { w[q] = wn[q]; wn[q] = wm[q]; }
    }
    __syncthreads();
    for (int g = 0; g < 16; ++g) {
        if (kg == g) {
#pragma unroll
            for (int i = 0; i < 18; ++i) { float* rp = red + (rh * 18 + i) * 64 + col4 * 4;
#pragma unroll
                for (int j = 0; j < 4; ++j) rp[j] = (g == 0 ? 0.f : rp[j]) + acc[i][j]; }
        }
        __syncthreads();
    }
    for (int e = tid; e < 36 * 64; e += NTHR) { const int i = e >> 6, c = e & 63; mod[(size_t)i * NMODW + strip * 64 + c] = red[e] + ab[strip * 64 + c]; }
    __syncthreads();
}
__device__ __forceinline__ void phase0(PP p, unsigned char* smem) {
    float* lds = (float*)smem;
    const int bid = blockIdx.x, G = gridDim.x;
    constexpr int T_ALL = 32 * 88 + 88 * 16 + 32 * 46 + 32 * 16;
    if (G == 256) {
        if (bid < 192) adaln_strip(p, bid, lds);
        const ConvPtrs cp = conv_ptrs(p);
        if (bid < 192) convert_seq(cp, 0, 0, 832 + bid, 256, T_ALL - 2112, 2112, 2112, lds);
        else convert_seq(cp, 13, bid - 192, 832 + bid, 256, T_ALL - 2112, 2112, 2112, lds);
    } else {
        for (int s2 = bid; s2 < 192; s2 += G) adaln_strip(p, s2, lds);
        const ConvPtrs cp = conv_ptrs(p); convert_seq(cp, 0, 0, bid, G, T_ALL, T_ALL, 0, lds);
    }
}

__device__ __forceinline__ void norm_phase(PP p, const float* xa, const float* xb, const float* nw, int si, bool reduce_parts) {
    const float* mod = (const float*)(p->ws + WS_MOD); bf16_t* H = (bf16_t*)(p->ws + WS_H); float* outp = p->out; const float* parts = (const float*)(p->ws + WS_GDN);
    const int wave = threadIdx.x >> 6, lane = threadIdx.x & 63;
    const int stride = gridDim.x * 8;
    int m = blockIdx.x * 8 + wave;
    f32x4 wv[8];
#pragma unroll
    for (int i = 0; i < 8; ++i) wv[i] = *(const f32x4*)(nw + i * 256 + lane * 4);
    f32x4 v[8], vn[8];
    if (m < MT) { const float* xr = m < MP ? xa + (size_t)m * D : xb + (size_t)(m - MP) * D;
#pragma unroll
        for (int i = 0; i < 8; ++i) v[i] = *(const f32x4*)(xr + i * 256 + lane * 4); }
    while (m < MT) {
        const int mn = m + stride;
        const float* mr = mod + (size_t)cond_of_row(m) * NMODW + si * D;
        f32x4 sh[8], scl[8];
#pragma unroll
        for (int i = 0; i < 8; ++i) { sh[i] = *(const f32x4*)(mr + i * 256 + lane * 4); scl[i] = *(const f32x4*)(mr + D + i * 256 + lane * 4); }
        if (mn < MT) { const float* xr = mn < MP ? xa + (size_t)mn * D : xb + (size_t)(mn - MP) * D;
#pragma unroll
            for (int i = 0; i < 8; ++i) vn[i] = *(const f32x4*)(xr + i * 256 + lane * 4); }
        if (reduce_parts && m >= MP) {
            const float* part = parts + (size_t)(m - MP) * D; const float* g1 = mod + (size_t)cond_of_row(m) * NMODW + 2 * D;
#pragma unroll
            for (int i = 0; i < 8; ++i) { f32x4 a = {0.f, 0.f, 0.f, 0.f};
#pragma unroll
                for (int sp = 0; sp < 8; ++sp) a += *(const f32x4*)(part + (size_t)sp * MS * D + i * 256 + lane * 4);
                v[i] += *(const f32x4*)(g1 + i * 256 + lane * 4) * a; *(f32x4*)(outp + (size_t)m * D + i * 256 + lane * 4) = v[i]; }
        }
        float ss = 0.f;
#pragma unroll
        for (int i = 0; i < 8; ++i) ss += v[i][0] * v[i][0] + v[i][1] * v[i][1] + v[i][2] * v[i][2] + v[i][3] * v[i][3];
#pragma unroll
        for (int o = 32; o >= 1; o >>= 1) ss += __shfl_xor(ss, o);
        const float rstd = rsqrtf(ss * (1.0f / D) + EPS);
#pragma unroll
        for (int i = 0; i < 8; ++i) { const int c = i * 256 + lane * 4;
            const f32x4 h = (v[i] * rstd * wv[i]) * (scl[i] + 1.0f) + sh[i]; u32x2 o; o.x = cvt_pk_bf16(h[0], h[1]); o.y = cvt_pk_bf16(h[2], h[3]); *(u32x2*)(H + (size_t)m * D + c) = o; }
#pragma unroll
        for (int i = 0; i < 8; ++i) v[i] = vn[i];
        m = mn;
    }
}

__device__ __forceinline__ void team_bar(unsigned* cnt, unsigned& target) {
    target += 4u;
    __builtin_amdgcn_fence(__ATOMIC_RELEASE, "workgroup");
    if ((threadIdx.x & 63) == 0) (void)__hip_atomic_fetch_add(cnt, 1u, __ATOMIC_RELAXED, __HIP_MEMORY_SCOPE_WORKGROUP);
    while (__hip_atomic_load(cnt, __ATOMIC_RELAXED, __HIP_MEMORY_SCOPE_WORKGROUP) < target) __builtin_amdgcn_s_sleep(1);
    __builtin_amdgcn_fence(__ATOMIC_ACQUIRE, "workgroup");
}
constexpr int TEAM_LDS = 81920;
__device__ __forceinline__ void gdn_prep(PP p, int item, unsigned char* tl  , unsigned* cnt, unsigned& bt) {
    const int b = item >> 9, h = (item >> 6) & 7, n = item & 63;
    int lt_ = threadIdx.x & 255; asm volatile("" : "+v"(lt_));
    const int lt = lt_, lane = lt & 63, lw = __builtin_amdgcn_readfirstlane(lt >> 6);
    const bf16_t* PROJ = (const bf16_t*)(p->ws + WS_PROJ); const float* AB = (const float*)(p->ws + WS_AB);
    unsigned char* rec = p->ws + WS_GDN + (size_t)item * CH_BYTES;
    const int m0 = b * LP + n * 64;
    bf16_t* QH = (bf16_t*)tl;
    bf16_t* KH = QH + 64 * 136;
    float* GC = (float*)(tl + 34816);
    float* BETA = GC + 64; float* EG = GC + 128; float* BEG = GC + 192;
    bf16_t* QKF = (bf16_t*)(tl + 36864);
    bf16_t* VH = (bf16_t*)(tl + 45056);
    float* AM = (float*)(tl + 62464);
    bf16_t* XS = (bf16_t*)(tl + 45056);
    team_bar(cnt, bt);
    if (lw == 0) {
        const float a = AB[(size_t)(m0 + lane) * 16 + h], bb = AB[(size_t)(m0 + lane) * 16 + 8 + h];
        float g = -__expf(p->in[15][h]) * softplus_f(a + p->in[16][h]);
        float gc = g;
#pragma unroll
        for (int o = 1; o < 64; o <<= 1) { const float t = __shfl_up(gc, o); if (lane >= o) gc += t; }
        const float be = sigmoid_f(bb), eg = __expf(gc);
        GC[lane] = gc; BETA[lane] = be; EG[lane] = eg; BEG[lane] = be * eg;
        if (lane == 63) *(float*)(rec + CH_GL) = eg;
    }
    {
        const float* cw = p->in[14];
#pragma unroll 1
        for (int pass = 0; pass < 2; ++pass) {
            const int slot = pass * 256 + lt, r = slot >> 3, cg = slot & 7; const int t = n * 64 + r;
            u32x4 raw[3][4][2];
#pragma unroll
            for (int which = 0; which < 3; ++which)
#pragma unroll
                for (int i = 0; i < 4; ++i) { const int dr = (t - 3 + i >= 0) ? (r - 3 + i) : r; const bf16_t* src = PROJ + (size_t)(m0 + dr) * NPROJ + which * 1024 + h * 128 + cg * 16;
                    raw[which][i][0] = *(const u32x4*)src; raw[which][i][1] = *(const u32x4*)(src + 8); }
#pragma unroll
            for (int which = 0; which < 3; ++which) {
                const int col = which * 1024 + h * 128 + cg * 16;
                float y[16];
#pragma unroll
                for (int j = 0; j < 16; ++j) y[j] = 0.f;
#pragma unroll
                for (int i = 0; i < 4; ++i) {
                    const float keep = (t - 3 + i >= 0) ? 1.0f : 0.0f;
                    float x[16]; unpack8(raw[which][i][0], x); unpack8(raw[which][i][1], x + 8);
#pragma unroll
                    for (int q = 0; q < 4; ++q) { const f32x4 w = *(const f32x4*)(cw + i * 3072 + col + q * 4) * keep;
#pragma unroll
                        for (int j = 0; j < 4; ++j) y[q * 4 + j] += w[j] * x[q * 4 + j]; }
                }
                float ss = 0.f;
#pragma unroll
                for (int j = 0; j < 16; ++j) { y[j] = silu_f(y[j]); ss += y[j] * y[j]; }
                float rn = 1.0f;
                if (which < 2) { ss += __shfl_xor(ss, 1); ss += __shfl_xor(ss, 2); ss += __shfl_xor(ss, 4); rn = rsqrtf(ss + EPS) * (which == 0 ? 0.08838834764831845f : 1.0f); }
                u32x4 w0, w1;
                w0.x = cvt_pk_bf16(y[0] * rn, y[1] * rn); w0.y = cvt_pk_bf16(y[2] * rn, y[3] * rn); w0.z = cvt_pk_bf16(y[4] * rn, y[5] * rn); w0.w = cvt_pk_bf16(y[6] * rn, y[7] * rn);
                w1.x = cvt_pk_bf16(y[8] * rn, y[9] * rn); w1.y = cvt_pk_bf16(y[10] * rn, y[11] * rn); w1.z = cvt_pk_bf16(y[12] * rn, y[13] * rn); w1.w = cvt_pk_bf16(y[14] * rn, y[15] * rn);
                bf16_t* dst = (which == 0 ? QH : which == 1 ? KH : VH) + r * 136 + cg * 16;
                *(u32x4*)dst = w0; *(u32x4*)(dst + 8) = w1;
            }
            if (n == 63 && r >= 61) {
                float* pc = p->out + O_PCONV + (size_t)(b * 3 + (r - 61)) * 3072;
#pragma unroll
                for (int which = 0; which < 3; ++which) { const int col = which * 1024 + h * 128 + cg * 16; float x[16]; unpack8(raw[which][3][0], x); unpack8(raw[which][3][1], x + 8);
#pragma unroll
                    for (int j = 0; j < 16; ++j) pc[col + j] = x[j]; }
            }
        }
    }
    team_bar(cnt, bt);
    {
        const int fr = lane & 15, kq = lane >> 4;
#pragma unroll
        for (int rep = 0; rep < 4; ++rep) {
            const int tt = lw + rep * 4, ti = tt >> 2, tj = tt & 3;
            f32x4 ck = {0.f, 0.f, 0.f, 0.f}, cq = {0.f, 0.f, 0.f, 0.f};
            if (tj <= ti) {
#pragma unroll
                for (int kk = 0; kk < 4; ++kk) {
                    const bf16x8 ak = *(const bf16x8*)(KH + (16 * ti + fr) * 136 + kk * 32 + kq * 8);
                    const bf16x8 aq = *(const bf16x8*)(QH + (16 * ti + fr) * 136 + kk * 32 + kq * 8);
                    const bf16x8 bk = *(const bf16x8*)(KH + (16 * tj + fr) * 136 + kk * 32 + kq * 8);
                    ck = __builtin_amdgcn_mfma_f32_16x16x32_bf16(ak, bk, ck, 0, 0, 0);
                    cq = __builtin_amdgcn_mfma_f32_16x16x32_bf16(aq, bk, cq, 0, 0, 0);
                }
            }
            const int j = 16 * tj + fr; const float gj = GC[j];
            const int cc = 16 * (tj & 1) + fr; const int kqp = (cc & 15) >> 2, jp = (cc & 3) + (cc >= 16 ? 4 : 0), kc = tj >> 1;
#pragma unroll
            for (int r = 0; r < 4; ++r) {
                const int i = 16 * ti + 4 * kq + r; const float dec = __expf(GC[i] - gj);
                AM[i * 68 + j] = (i > j) ? BETA[i] * dec * ck[r] : 0.f;
                const float qv = (i >= j) ? dec * cq[r] : 0.f;
                const int L = (4 * kq + r) + 16 * kqp;
                QKF[((ti * 2 + kc) * 64 + L) * 8 + jp] = (bf16_t)(cvt_pk_bf16(qv, 0.f) & 0xffffu);
            }
        }
    }
    team_bar(cnt, bt);
    float x[64];
    {
        const int c = lt;
        int zv; asm volatile("v_mov_b32 %0, 0" : "=v"(zv));
        const float* AMv = AM + zv; const float* SCL = (c < 128 ? BETA : BEG) + zv; const bf16_t* R = (c < 128 ? VH : KH) + (c & 127);
        f32x4 amc[16], amn[8];
        float rc = bf2f(R[0]) * SCL[0], rn = 0.f;
#pragma unroll
        for (int i = 0; i < 64; ++i) {
            __builtin_amdgcn_sched_barrier(0);
#pragma unroll
            for (int jj = 8; jj < (i + 3) / 4; ++jj) amc[jj] = *(const f32x4*)(AMv + i * 68 + jj * 4);
            if (i + 1 < 64) { rn = bf2f(R[(i + 1) * 136]) * SCL[i + 1];
#pragma unroll
                for (int jj = 0; jj < ((i + 4) / 4 < 8 ? (i + 4) / 4 : 8); ++jj) amn[jj] = *(const f32x4*)(AMv + (i + 1) * 68 + jj * 4); }
            float a = rc;
#pragma unroll
            for (int jj = 0; jj < (i + 3) / 4; ++jj) {
#pragma unroll
                for (int q = 0; q < 4; ++q) if (jj * 4 + q < i) asm("v_fma_f32 %0, -%1, %2, %0" : "+v"(a) : "v"(amc[jj][q]), "v"(x[jj * 4 + q])); }
            x[i] = a;
            rc = rn;
#pragma unroll
            for (int jj = 0; jj < 8; ++jj) amc[jj] = amn[jj];
        }
    }
    team_bar(cnt, bt);
#pragma unroll
    for (int i = 0; i < 64; ++i) XS[i * 264 + lt] = (bf16_t)(cvt_pk_bf16(x[i], 0.f) & 0xffffu);
    team_bar(cnt, bt);
    {
        const int L = lane, mrow = L & 15, kqp = L >> 4;
        const float g63 = GC[63];
#pragma unroll
        for (int rnd = 0; rnd < 4; ++rnd) { const int f = rnd * 4 + lw, mt = f >> 2, kk = f & 3; const int c = 16 * mt + mrow;
            const u32x2 lo = *(const u32x2*)(XS + c * 264 + 128 + 32 * kk + 4 * kqp), hi = *(const u32x2*)(XS + c * 264 + 128 + 32 * kk + 16 + 4 * kqp);
            u32x4 w; w.x = lo.x; w.y = lo.y; w.z = hi.x; w.w = hi.y;
            *(u32x4*)(rec + CH_W + (size_t)f * 1024 + L * 16) = w; }
#pragma unroll
        for (int rnd = 0; rnd < 2; ++rnd) { const int slot = rnd * 256 + lt, dv = slot >> 2, cs = slot & 3; unsigned pk[8];
#pragma unroll
            for (int q = 0; q < 8; ++q) { const unsigned lo = XS[(16 * cs + 2 * q) * 264 + dv], hi = XS[(16 * cs + 2 * q + 1) * 264 + dv]; pk[q] = lo | (hi << 16); }
            u32x4 w0, w1; w0.x = pk[0]; w0.y = pk[1]; w0.z = pk[2]; w0.w = pk[3]; w1.x = pk[4]; w1.y = pk[5]; w1.z = pk[6]; w1.w = pk[7];
            bf16_t* ut = (bf16_t*)(rec + CH_UT) + dv * 64 + cs * 16; *(u32x4*)ut = w0; *(u32x4*)(ut + 8) = w1; }
#pragma unroll
        for (int rnd = 0; rnd < 4; ++rnd) {
            const int f = rnd * 4 + lw, mt = f >> 2, kk = f & 3; const int c = 16 * mt + mrow; const float e = EG[c];
            const u32x2 lo = *(const u32x2*)(QH + c * 136 + 32 * kk + 4 * kqp), hi = *(const u32x2*)(QH + c * 136 + 32 * kk + 16 + 4 * kqp);
            u32x4 w; w.x = cvt_pk_bf16(bf_lo(lo.x) * e, bf_hi(lo.x) * e); w.y = cvt_pk_bf16(bf_lo(lo.y) * e, bf_hi(lo.y) * e); w.z = cvt_pk_bf16(bf_lo(hi.x) * e, bf_hi(hi.x) * e); w.w = cvt_pk_bf16(bf_lo(hi.y) * e, bf_hi(hi.y) * e);
            *(u32x4*)(rec + CH_QG + (size_t)f * 1024 + L * 16) = w;
        }
#pragma unroll
        for (int rnd = 0; rnd < 4; ++rnd) {
            const int f = rnd * 4 + lw, d = f >> 1, kc = f & 1; const int dk = 16 * d + mrow;
            float v[8];
#pragma unroll
            for (int j = 0; j < 8; ++j) { const int c = 32 * kc + (j < 4 ? 4 * kqp + j : 16 + 4 * kqp + (j - 4)); v[j] = bf2f(KH[c * 136 + dk]) * __expf(g63 - GC[c]); }
            u32x4 w; w.x = cvt_pk_bf16(v[0], v[1]); w.y = cvt_pk_bf16(v[2], v[3]); w.z = cvt_pk_bf16(v[4], v[5]); w.w = cvt_pk_bf16(v[6], v[7]);
            *(u32x4*)(rec + CH_KD + (size_t)f * 1024 + L * 16) = w;
        }
#pragma unroll
        for (int rnd = 0; rnd < 2; ++rnd) { const int e = rnd * 256 + lt; *(u32x4*)(rec + CH_QK + (size_t)e * 16) = *(const u32x4*)((const unsigned char*)QKF + e * 16); }
    }
}

__device__ __forceinline__ void gdn_sample(PP p, int item, unsigned char* smem) {
    const int b = item >> 3, h = item & 7;
    const int tid = threadIdx.x;
    const bf16_t* PROJ = (const bf16_t*)(p->ws + WS_PROJ); const float* AB = (const float*)(p->ws + WS_AB);
    bf16_t* OM = (bf16_t*)(p->ws + WS_H);
    const int m0 = MP + b * 16;
    float* Q = (float*)smem; float* K = Q + 16 * 128; float* V = K + 16 * 128; float* O = V + 16 * 128;
    float* RED = O + 16 * 128;
    float* RED2 = RED + 4 * 128;
    float* GG = RED2 + 4 * 128;
    __syncthreads();
    if (tid < 16) { const float a = AB[(size_t)(m0 + tid) * 16 + h], bb = AB[(size_t)(m0 + tid) * 16 + 8 + h];
        GG[tid] = __expf(-__expf(p->in[15][h]) * softplus_f(a + p->in[16][h])); GG[16 + tid] = sigmoid_f(bb); }
    {
        const int r = tid >> 5, cg = tid & 31; const float* cw = p->in[14]; const float* st = p->in[2] + (size_t)b * 3 * 3072;
#pragma unroll
        for (int which = 0; which < 3; ++which) {
            const int col = which * 1024 + h * 128 + cg * 4; float y[4] = {0.f, 0.f, 0.f, 0.f};
#pragma unroll
            for (int i = 0; i < 4; ++i) { const int t = r - 3 + i; float x[4];
                const u32x2 vp = *(const u32x2*)(PROJ + (size_t)(m0 + (t >= 0 ? t : 0)) * NPROJ + col); const f32x4 vs = *(const f32x4*)(st + (size_t)(t >= 0 ? 0 : 3 + t) * 3072 + col);
                x[0] = t >= 0 ? bf_lo(vp.x) : vs[0]; x[1] = t >= 0 ? bf_hi(vp.x) : vs[1]; x[2] = t >= 0 ? bf_lo(vp.y) : vs[2]; x[3] = t >= 0 ? bf_hi(vp.y) : vs[3];
                const f32x4 w = *(const f32x4*)(cw + i * 3072 + col);
#pragma unroll
                for (int j = 0; j < 4; ++j) y[j] += w[j] * x[j]; }
            float ss = 0.f;
#pragma unroll
            for (int j = 0; j < 4; ++j) { y[j] = silu_f(y[j]); ss += y[j] * y[j]; }
            float rn = 1.0f;
            if (which < 2) {
#pragma unroll
                for (int o = 1; o < 32; o <<= 1) ss += __shfl_xor(ss, o);
                rn = rsqrtf(ss + EPS) * (which == 0 ? 0.08838834764831845f : 1.0f); }
            float* dst = (which == 0 ? Q : which == 1 ? K : V) + r * 128 + cg * 4;
#pragma unroll
            for (int j = 0; j < 4; ++j) dst[j] = y[j] * rn;
            if (r >= 13) {
                const u32x2 v = *(const u32x2*)(PROJ + (size_t)(m0 + r) * NPROJ + col);
                *(f32x4*)(p->out + O_SCONV + (size_t)(b * 3 + r - 13) * 3072 + col) = (f32x4){bf_lo(v.x), bf_hi(v.x), bf_lo(v.y), bf_hi(v.y)}; }
        }
    }
    const int dv = tid & 127, kg = tid >> 7;
    float S[32];
    const float* s0 = p->in[3] + ((size_t)(b * 8 + h) * 128 + kg * 32) * 128 + dv;
#pragma unroll
    for (int i = 0; i < 32; ++i) S[i] = s0[(size_t)i * 128];
    __syncthreads();
    for (int t = 0; t < 16; ++t) {
        const float a = GG[t], be = GG[16 + t]; float part = 0.f;
#pragma unroll
        for (int i = 0; i < 32; ++i) { S[i] *= a; part += K[t * 128 + kg * 32 + i] * S[i]; }
        RED[kg * 128 + dv] = part;
        __syncthreads();
        const float ks = RED[dv] + RED[128 + dv] + RED[256 + dv] + RED[384 + dv];
        const float rr = be * (V[t * 128 + dv] - ks); float po = 0.f;
#pragma unroll
        for (int i = 0; i < 32; ++i) { S[i] += K[t * 128 + kg * 32 + i] * rr; po += Q[t * 128 + kg * 32 + i] * S[i]; }
        RED2[kg * 128 + dv] = po;
        __syncthreads();
        if (kg == 0) O[t * 128 + dv] = RED2[dv] + RED2[128 + dv] + RED2[256 + dv] + RED2[384 + dv];
    }
    float* sd = p->out + O_SDELTA + ((size_t)(b * 8 + h) * 128 + kg * 32) * 128 + dv;
#pragma unroll
    for (int i = 0; i < 32; ++i) sd[(size_t)i * 128] = S[i];
    __syncthreads();
    {
        const int r = tid >> 5, cg = tid & 31; const f32x4 o = *(const f32x4*)(O + r * 128 + cg * 4);
        float ss = o[0] * o[0] + o[1] * o[1] + o[2] * o[2] + o[3] * o[3];
#pragma unroll
        for (int of = 1; of < 32; of <<= 1) ss += __shfl_xor(ss, of);
        const float rs = rsqrtf(ss * (1.0f / 128.f) + EPS); const f32x4 w = *(const f32x4*)(p->in[17] + cg * 4);
        const u32x2 zz = *(const u32x2*)(PROJ + (size_t)(m0 + r) * NPROJ + 3072 + h * 128 + cg * 4);
        const float z[4] = {bf_lo(zz.x), bf_hi(zz.x), bf_lo(zz.y), bf_hi(zz.y)};
        u32x2 ow; ow.x = cvt_pk_bf16(o[0] * rs * w[0] * silu_f(z[0]), o[1] * rs * w[1] * silu_f(z[1])); ow.y = cvt_pk_bf16(o[2] * rs * w[2] * silu_f(z[2]), o[3] * rs * w[3] * silu_f(z[3]));
        *(u32x2*)(OM + (size_t)(m0 + r) * D + h * 128 + cg * 4) = ow;
    }
}

template <int NT  , bool SAMPLE>
__device__ __forceinline__ void swa_item(PP p, int b, int n, int hk, unsigned char* smem) {
    constexpr int SPAN = SAMPLE ? 144 : 192, NQ = SAMPLE ? 16 : 64, VP = NT * 16 + 8;
    const int tid = threadIdx.x, lane = tid & 63, wave = tid >> 6, fr = lane & 15, kq = lane >> 4;
    const bf16_t* PROJ = (const bf16_t*)(p->ws + WS_PROJ); bf16_t* OM = (bf16_t*)(p->ws + WS_H);
    bf16_t* KS = (bf16_t*)smem;
    bf16_t* VT = KS + NT * 16 * 136;
    const int mq0 = SAMPLE ? MP + b * 16 : b * LP + n * 64;
    const float* knw = p->in[19];
    __syncthreads();
    u32x4 kraw[3][2], vraw[3][2];
    if (!SAMPLE) {
#pragma unroll
        for (int pass = 0; pass < 3; ++pass) {
            { const int t = n * 64 - 128 + pass * 64 + (tid >> 3); const bf16_t* src = PROJ + (size_t)(b * LP + (t > 0 ? t : 0)) * NPROJ + 5120 + hk * 128 + (tid & 7) * 16; kraw[pass][0] = *(const u32x4*)src; kraw[pass][1] = *(const u32x4*)(src + 8); }
            { const int t = n * 64 - 128 + pass * 64 + lane; const bf16_t* src = PROJ + (size_t)(b * LP + (t > 0 ? t : 0)) * NPROJ + 5376 + hk * 128 + wave * 16; vraw[pass][0] = *(const u32x4*)src; vraw[pass][1] = *(const u32x4*)(src + 8); }
        }
    }
#pragma unroll
    for (int pass = 0; pass < (NT * 16) / 64 + ((NT * 16) % 64 ? 1 : 0); ++pass) {
        const int key = pass * 64 + (tid >> 3), cg = tid & 7;
        if (key < NT * 16) {
            float x[16]; bool valid = key < SPAN; bool fresh = false; int srow = 0;
            if (SAMPLE) { if (key >= 128) { fresh = true; srow = mq0 + key - 128; } }
            else { const int t = n * 64 - 128 + key; valid = valid && t >= 0; fresh = true; srow = b * LP + t; }
            if (!valid) {
#pragma unroll
                for (int j = 0; j < 16; ++j) x[j] = 0.f;
            } else if (fresh) {
                if (SAMPLE) { const bf16_t* src = PROJ + (size_t)srow * NPROJ + 5120 + hk * 128 + cg * 16; unpack8(*(const u32x4*)src, x); unpack8(*(const u32x4*)(src + 8), x + 8); }
                else { unpack8(kraw[pass][0], x); unpack8(kraw[pass][1], x + 8); }
                float ss = 0.f;
#pragma unroll
                for (int j = 0; j < 16; ++j) ss += x[j] * x[j];
                ss += __shfl_xor(ss, 1); ss += __shfl_xor(ss, 2); ss += __shfl_xor(ss, 4);
                const float rs = rsqrtf(ss * (1.0f / 128.f) + EPS);
#pragma unroll
                for (int j = 0; j < 16; ++j) x[j] = x[j] * rs * knw[cg * 16 + j];
            } else {
                const float* src = p->in[4] + ((size_t)(b * 128 + key) * 2 + hk) * 128 + cg * 16;
#pragma unroll
                for (int q = 0; q < 4; ++q) { const f32x4 v = *(const f32x4*)(src + q * 4); x[q * 4] = v[0]; x[q * 4 + 1] = v[1]; x[q * 4 + 2] = v[2]; x[q * 4 + 3] = v[3]; }
            }
            u32x4 w0, w1;
            w0.x = cvt_pk_bf16(x[0], x[1]); w0.y = cvt_pk_bf16(x[2], x[3]); w0.z = cvt_pk_bf16(x[4], x[5]); w0.w = cvt_pk_bf16(x[6], x[7]);
            w1.x = cvt_pk_bf16(x[8], x[9]); w1.y = cvt_pk_bf16(x[10], x[11]); w1.z = cvt_pk_bf16(x[12], x[13]); w1.w = cvt_pk_bf16(x[14], x[15]);
            *(u32x4*)(KS + key * 136 + cg * 16) = w0; *(u32x4*)(KS + key * 136 + cg * 16 + 8) = w1;
            float* dst = nullptr;
            if (SAMPLE) { if (key >= 16 && key < 144) dst = p->out + O_SK + ((size_t)(b * 128 + key - 16) * 2 + hk) * 128 + cg * 16; }
            else { if (n >= 62 && key >= 128) dst = p->out + O_PK + ((size_t)(b * 128 + (n - 62) * 64 + key - 128) * 2 + hk) * 128 + cg * 16; }
            if (dst) {
#pragma unroll
                for (int q = 0; q < 4; ++q) *(f32x4*)(dst + q * 4) = (f32x4){x[q * 4], x[q * 4 + 1], x[q * 4 + 2], x[q * 4 + 3]}; }
        }
    }
#pragma unroll
    for (int pass = 0; pass < (NT * 16) / 64 + ((NT * 16) % 64 ? 1 : 0); ++pass) {
        const int key = pass * 64 + lane, cg = wave;
        if (key < NT * 16) {
            float x[16]; bool valid = key < SPAN; bool fresh = false; int srow = 0;
            if (SAMPLE) { if (key >= 128) { fresh = true; srow = mq0 + key - 128; } }
            else { const int t = n * 64 - 128 + key; valid = valid && t >= 0; fresh = true; srow = b * LP + t; }
            if (!valid) {
#pragma unroll
                for (int j = 0; j < 16; ++j) x[j] = 0.f;
            } else if (fresh) { if (SAMPLE) { const bf16_t* src = PROJ + (size_t)srow * NPROJ + 5376 + hk * 128 + cg * 16; unpack8(*(const u32x4*)src, x); unpack8(*(const u32x4*)(src + 8), x + 8); } else { unpack8(vraw[pass][0], x); unpack8(vraw[pass][1], x + 8); } }
            else { const float* src = p->in[5] + ((size_t)(b * 128 + key) * 2 + hk) * 128 + cg * 16;
#pragma unroll
                for (int q = 0; q < 4; ++q) { const f32x4 v = *(const f32x4*)(src + q * 4); x[q * 4] = v[0]; x[q * 4 + 1] = v[1]; x[q * 4 + 2] = v[2]; x[q * 4 + 3] = v[3]; } }
#pragma unroll
            for (int j = 0; j < 16; ++j) VT[(cg * 16 + j) * VP + key] = (bf16_t)(cvt_pk_bf16(x[j], 0.f) & 0xffffu);
            float* dst = nullptr;
            if (SAMPLE) { if (key >= 16 && key < 144) dst = p->out + O_SV + ((size_t)(b * 128 + key - 16) * 2 + hk) * 128 + cg * 16; }
            else { if (n >= 62 && key >= 128) dst = p->out + O_PV + ((size_t)(b * 128 + (n - 62) * 64 + key - 128) * 2 + hk) * 128 + cg * 16; }
            if (dst) {
#pragma unroll
                for (int q = 0; q < 4; ++q) *(f32x4*)(dst + q * 4) = (f32x4){x[q * 4], x[q * 4 + 1], x[q * 4 + 2], x[q * 4 + 3]}; }
        }
    }
    __syncthreads();
    if (wave * 32 < NQ * 4) {
        const float* qnw = p->in[18];
        int hq[2], mrow[2], iq[2]; float slope[2], sink[2];
        bf16x8 QF[2][4];
#pragma unroll
        for (int nt2 = 0; nt2 < 2; ++nt2) {
            const int rho = wave * 32 + nt2 * 16 + fr; const int g = rho / NQ; iq[nt2] = rho % NQ; hq[nt2] = hk * 4 + g; mrow[nt2] = mq0 + iq[nt2];
            slope[nt2] = exp2f(-(float)(hq[nt2] + 1)); sink[nt2] = p->in[20][hq[nt2]];
        }
        { u32x4 qr[2][4];
#pragma unroll
          for (int nt2 = 0; nt2 < 2; ++nt2)
#pragma unroll
              for (int kk = 0; kk < 4; ++kk) qr[nt2][kk] = *(const u32x4*)(PROJ + (size_t)mrow[nt2] * NPROJ + 4096 + hq[nt2] * 128 + kk * 32 + kq * 8);
#pragma unroll
          for (int nt2 = 0; nt2 < 2; ++nt2) { float qx[4][8]; float ss = 0.f;
#pragma unroll
              for (int kk = 0; kk < 4; ++kk) { unpack8(qr[nt2][kk], qx[kk]);
#pragma unroll
                  for (int j = 0; j < 8; ++j) ss += qx[kk][j] * qx[kk][j]; }
              ss += __shfl_xor(ss, 16); ss += __shfl_xor(ss, 32);
              const float sc = rsqrtf(ss * (1.0f / 128.f) + EPS) * 0.08838834764831845f;
#pragma unroll
              for (int kk = 0; kk < 4; ++kk) { float w[8];
#pragma unroll
                  for (int j = 0; j < 8; ++j) w[j] = qx[kk][j] * sc * qnw[kk * 32 + kq * 8 + j];
                  u32x4 pk; pk.x = cvt_pk_bf16(w[0], w[1]); pk.y = cvt_pk_bf16(w[2], w[3]); pk.z = cvt_pk_bf16(w[4], w[5]); pk.w = cvt_pk_bf16(w[6], w[7]); QF[nt2][kk] = as_bf16x8(pk); } } }
        bf16x8 PB[2][NT / 2];
#pragma unroll
        for (int nt2 = 0; nt2 < 2; ++nt2) {
            f32x4 st[NT]; float mx = sink[nt2];
#pragma unroll
            for (int mt = 0; mt < NT; mt += 2) {
                __builtin_amdgcn_sched_barrier(0);
                f32x4 a0 = {0.f, 0.f, 0.f, 0.f}, a1 = {0.f, 0.f, 0.f, 0.f};
#pragma unroll
                for (int kk = 0; kk < 4; ++kk) { const bf16x8 k0 = *(const bf16x8*)(KS + (16 * mt + fr) * 136 + kk * 32 + kq * 8), k1 = *(const bf16x8*)(KS + (16 * mt + 16 + fr) * 136 + kk * 32 + kq * 8);
                    a0 = __builtin_amdgcn_mfma_f32_16x16x32_bf16(k0, QF[nt2][kk], a0, 0, 0, 0); a1 = __builtin_amdgcn_mfma_f32_16x16x32_bf16(k1, QF[nt2][kk], a1, 0, 0, 0); }
                int ib = iq[nt2] + 128 - 4 * kq; asm volatile("" : "+v"(ib));
#pragma unroll
                for (int r = 0; r < 4; ++r) { const int key = 16 * mt + 4 * kq + r; bool v0 = key < SPAN, v1 = key + 16 < SPAN; if (!SAMPLE) { v0 = v0 && (n * 64 - 128 + key >= 0); v1 = v1 && (n * 64 - 112 + key >= 0); }
                    const float s0 = v0 ? a0[r] - slope[nt2] * fabsf((float)(ib - (16 * mt + r))) : -INFINITY, s1 = v1 ? a1[r] - slope[nt2] * fabsf((float)(ib - (16 * mt + 16 + r))) : -INFINITY;
                    a0[r] = s0; a1[r] = s1; mx = fmaxf(mx, fmaxf(s0, s1)); }
                st[mt] = a0; st[mt + 1] = a1;
            }
            __builtin_amdgcn_sched_barrier(0);
            mx = fmaxf(mx, __shfl_xor(mx, 16)); mx = fmaxf(mx, __shfl_xor(mx, 32));
            float sum = 0.f;
#pragma unroll
            for (int mt = 0; mt < NT; ++mt)
#pragma unroll
                for (int r = 0; r < 4; ++r) { const float e = __expf(st[mt][r] - mx); st[mt][r] = e; sum += e; }
            sum += __shfl_xor(sum, 16); sum += __shfl_xor(sum, 32);
            const float inv = __builtin_amdgcn_rcpf(sum + __expf(sink[nt2] - mx));
#pragma unroll
            for (int kc = 0; kc < NT / 2; ++kc) { u32x4 pk; pk.x = cvt_pk_bf16(st[2 * kc][0] * inv, st[2 * kc][1] * inv); pk.y = cvt_pk_bf16(st[2 * kc][2] * inv, st[2 * kc][3] * inv);
                pk.z = cvt_pk_bf16(st[2 * kc + 1][0] * inv, st[2 * kc + 1][1] * inv); pk.w = cvt_pk_bf16(st[2 * kc + 1][2] * inv, st[2 * kc + 1][3] * inv); PB[nt2][kc] = as_bf16x8(pk); }
        }
#pragma unroll
        for (int dt = 0; dt < 8; ++dt) {
            __builtin_amdgcn_sched_barrier(0);
            f32x4 o0 = {0.f, 0.f, 0.f, 0.f}, o1 = {0.f, 0.f, 0.f, 0.f};
#pragma unroll
            for (int kc = 0; kc < NT / 2; ++kc) { const u32x2 lo = *(const u32x2*)(VT + (16 * dt + fr) * VP + 32 * kc + 4 * kq), hi = *(const u32x2*)(VT + (16 * dt + fr) * VP + 32 * kc + 16 + 4 * kq);
                u32x4 va; va.x = lo.x; va.y = lo.y; va.z = hi.x; va.w = hi.y;
                o0 = __builtin_amdgcn_mfma_f32_16x16x32_bf16(as_bf16x8(va), PB[0][kc], o0, 0, 0, 0); o1 = __builtin_amdgcn_mfma_f32_16x16x32_bf16(as_bf16x8(va), PB[1][kc], o1, 0, 0, 0); }
            u32x2 ow; ow.x = cvt_pk_bf16(o0[0], o0[1]); ow.y = cvt_pk_bf16(o0[2], o0[3]);
            *(u32x2*)(OM + (size_t)mrow[0] * D + 1024 + hq[0] * 128 + 16 * dt + 4 * kq) = ow;
            ow.x = cvt_pk_bf16(o1[0], o1[1]); ow.y = cvt_pk_bf16(o1[2], o1[3]);
            *(u32x2*)(OM + (size_t)mrow[1] * D + 1024 + hq[1] * 128 + 16 * dt + 4 * kq) = ow;
        }
    }
}

__device__ __forceinline__ void phase3(PP p, unsigned char* smem) {
#ifndef P3_MASK
#define P3_MASK 15
#endif
    const int bid = blockIdx.x, G = gridDim.x;
#ifndef P3_REP
#define P3_REP 0
#endif
    if (P3_MASK & 1) {
        unsigned* cnt = (unsigned*)(smem + 36352) ;
        if (threadIdx.x < 2) cnt[threadIdx.x] = 0u;
        __syncthreads();
        const int team = threadIdx.x >> 8; unsigned bt = 0u;
        for (int r_ = 0; r_ < 1 + (P3_REP & 1); ++r_) for (int it = bid + G * team; it < 2048; it += 2 * G) gdn_prep(p, it, smem + team * TEAM_LDS, cnt + team, bt);
        __syncthreads();
    }
    if (P3_MASK & 2) for (int r_ = 0; r_ < 1 + ((P3_REP >> 1) & 1); ++r_) for (int v = bid; v < 512; v += G) { const int u = (G == 256) ? (v & 7) * 64 + ((v >> 3) & 31) + 32 * (v >> 8) : v;
        swa_item<12, false>(p, u >> 7, (u >> 1) & 63, u & 1, smem); }
    if (P3_MASK & 4) for (int r_ = 0; r_ < 1 + ((P3_REP >> 2) & 1); ++r_) for (int u = bid; u < 256; u += G) gdn_sample(p, u, smem);
    if (P3_MASK & 8) for (int u = G - 1 - bid; u < 64; u += G) swa_item<10, true>(p, u >> 1, 0, u & 1, smem);
    if (G == 256 && bid < 192) { __syncthreads(); const ConvPtrs cp = conv_ptrs(p); convert_seq(cp, 0, 0, bid, 192, 576, 0, 2112, (float*)smem); }
}

__device__ __forceinline__ void scan_chunk(f32x4 (&S)[8], const unsigned char* cur, float gl, bf16_t* op0, int lane, int fr, int kq, int wave) {
#define FRAG(off, f) (*(const bf16x8*)(cur + (off) + (f) * 1024 + lane * 16))
    bf16x8 sB[4];
#pragma unroll
    for (int kk = 0; kk < 4; ++kk) { u32x4 pk; pk.x = cvt_pk_bf16(S[2 * kk][0], S[2 * kk][1]); pk.y = cvt_pk_bf16(S[2 * kk][2], S[2 * kk][3]); pk.z = cvt_pk_bf16(S[2 * kk + 1][0], S[2 * kk + 1][1]); pk.w = cvt_pk_bf16(S[2 * kk + 1][2], S[2 * kk + 1][3]); sB[kk] = as_bf16x8(pk); }
    bf16x8 Wf[16]; u32x2 uu[4];
#pragma unroll
    for (int f = 0; f < 16; ++f) Wf[f] = FRAG(CH_W, f);
#pragma unroll
    for (int mt = 0; mt < 4; ++mt) uu[mt] = *(const u32x2*)(cur + 57344 + (wave * 16 + fr) * 128 + (16 * mt + 4 * kq) * 2);
    __builtin_amdgcn_sched_barrier(0);
    f32x4 P[4], O[4];
#pragma unroll
    for (int mt = 0; mt < 4; ++mt) { P[mt] = (f32x4){0.f, 0.f, 0.f, 0.f}; O[mt] = (f32x4){0.f, 0.f, 0.f, 0.f}; }
    bf16x8 Gf[16];
#pragma unroll
    for (int kk = 0; kk < 4; ++kk) {
#pragma unroll
        for (int mt = 0; mt < 4; ++mt) { P[mt] = __builtin_amdgcn_mfma_f32_16x16x32_bf16(Wf[mt * 4 + kk], sB[kk], P[mt], 0, 0, 0); Gf[kk * 4 + mt] = FRAG(CH_QG, mt * 4 + kk); }
    }
    __builtin_amdgcn_sched_barrier(0);
    bf16x8 Kf[8], Df[16];
#pragma unroll
    for (int kk = 0; kk < 4; ++kk) {
#pragma unroll
        for (int mt = 0; mt < 4; ++mt) { O[mt] = __builtin_amdgcn_mfma_f32_16x16x32_bf16(Gf[kk * 4 + mt], sB[kk], O[mt], 0, 0, 0); if (kk < 2) Kf[kk * 4 + mt] = FRAG(CH_QK, mt * 2 + kk); else Df[(kk - 2) * 4 + mt] = FRAG(CH_KD, (kk - 2) * 4 + mt); }
    }
    f32x4 vn[4];
#pragma unroll
    for (int mt = 0; mt < 4; ++mt) vn[mt] = (f32x4){bf_lo(uu[mt].x) - P[mt][0], bf_hi(uu[mt].x) - P[mt][1], bf_lo(uu[mt].y) - P[mt][2], bf_hi(uu[mt].y) - P[mt][3]};
    bf16x8 vB[2];
#pragma unroll
    for (int kc = 0; kc < 2; ++kc) { u32x4 pk; pk.x = cvt_pk_bf16(vn[2 * kc][0], vn[2 * kc][1]); pk.y = cvt_pk_bf16(vn[2 * kc][2], vn[2 * kc][3]); pk.z = cvt_pk_bf16(vn[2 * kc + 1][0], vn[2 * kc + 1][1]); pk.w = cvt_pk_bf16(vn[2 * kc + 1][2], vn[2 * kc + 1][3]); vB[kc] = as_bf16x8(pk); }
    __builtin_amdgcn_sched_barrier(0);
#pragma unroll
    for (int kc = 0; kc < 2; ++kc) {
#pragma unroll
        for (int mt = 0; mt < 4; ++mt) { O[mt] = __builtin_amdgcn_mfma_f32_16x16x32_bf16(Kf[kc * 4 + mt], vB[kc], O[mt], 0, 0, 0); Df[8 + kc * 4 + mt] = FRAG(CH_KD, 8 + kc * 4 + mt); }
    }
#pragma unroll
    for (int d = 0; d < 8; ++d) S[d] = S[d] * gl;
    __builtin_amdgcn_sched_barrier(0);
#pragma unroll
    for (int kc = 0; kc < 2; ++kc) {
#pragma unroll
        for (int d = 0; d < 8; ++d) S[d] = __builtin_amdgcn_mfma_f32_16x16x32_bf16(Df[d * 2 + kc], vB[kc], S[d], 0, 0, 0);
    }
#pragma unroll
    for (int mt = 0; mt < 4; ++mt) { bf16_t* op = op0 + (size_t)(16 * mt) * D;
#pragma unroll
        for (int r = 0; r < 4; ++r) op[(size_t)r * D] = (bf16_t)(cvt_pk_bf16(O[mt][r], 0.f) & 0xffffu); }
#undef FRAG
}
__device__ __forceinline__ void phase4(PP p, unsigned char* smem) {
    const int tid = threadIdx.x, lane = tid & 63, wave = tid >> 6, fr = lane & 15, kq = lane >> 4;
    bf16_t* OM = (bf16_t*)(p->ws + WS_H);
    constexpr int NCW = 2, NS = 8 / NCW, USL = 2048 * NCW, BUF = 57344 + USL;
    if (gridDim.x == 256 && blockIdx.x >= 128) { const ConvPtrs cp = conv_ptrs(p); convert_seq(cp, 0, 0, (int)blockIdx.x - 128, 128, 1536, 0, 2688, (float*)smem); return; }
    for (int item = blockIdx.x; item < 32 * NS; item += gridDim.x) {
        const int xcd = item & 7, iw = item >> 3; const int bh = xcd * 4 + iw / NS, ds = iw % NS; const int b = bh >> 3, h = bh & 7, dvb = ds * 16 * NCW, dv0 = dvb + (wave < NCW ? wave : 0) * 16;
        const unsigned char* rec0 = p->ws + WS_GDN + (size_t)(bh * 64) * CH_BYTES;
        f32x4 S[8];
#pragma unroll
        for (int d = 0; d < 8; ++d) S[d] = (f32x4){0.f, 0.f, 0.f, 0.f};
        u32x4 sa[8], sb[8];
#define SC_LOAD(st, c) do { const unsigned char* r_ = rec0 + (size_t)(c) * CH_BYTES; _Pragma("unroll") for (int i = 0; i < 7; ++i) st[i] = *(const u32x4*)(r_ + (size_t)(i * 512 + tid) * 16); \
        if (tid < 128 * NCW) st[7] = *(const u32x4*)(r_ + CH_UT + (size_t)dvb * 128 + tid * 16); } while (0)
#define SC_STORE(st, buf) do { unsigned char* d_ = smem + (buf) * BUF; _Pragma("unroll") for (int i = 0; i < 7; ++i) *(u32x4*)(d_ + (size_t)(i * 512 + tid) * 16) = st[i]; \
        if (tid < 128 * NCW) *(u32x4*)(d_ + 57344 + tid * 16) = st[7]; } while (0)
        __syncthreads();
        const int glv = __builtin_bit_cast(int, *(const float*)(rec0 + (size_t)lane * CH_BYTES + CH_GL));
        SC_LOAD(sa, 0); SC_LOAD(sb, 1);
        SC_STORE(sa, 0);
        __syncthreads();
        bf16_t* opb = OM + (size_t)(b * LP + 4 * kq) * D + h * 128 + dv0 + fr;
        for (int n = 0; n < 64; n += 2) {
            if (n + 2 < 64) SC_LOAD(sa, n + 2);
            if (wave < NCW) scan_chunk(S, smem, __builtin_bit_cast(float, __builtin_amdgcn_readlane(glv, n)), opb + (size_t)(n * 64) * D, lane, fr, kq, wave);
            SC_STORE(sb, 1);
            __syncthreads();
            if (n + 3 < 64) SC_LOAD(sb, n + 3);
            if (wave < NCW) scan_chunk(S, smem + BUF, __builtin_bit_cast(float, __builtin_amdgcn_readlane(glv, n + 1)), opb + (size_t)((n + 1) * 64) * D, lane, fr, kq, wave);
            if (n + 2 < 64) SC_STORE(sa, 0);
            __syncthreads();
        }
#undef SC_LOAD
#undef SC_STORE
        if (wave < NCW) {
            float* pd = p->out + O_PDELTA + (size_t)bh * 128 * 128;
#pragma unroll
            for (int d = 0; d < 8; ++d)
#pragma unroll
                for (int r = 0; r < 4; ++r) pd[(size_t)(16 * d + 4 * kq + r) * 128 + dv0 + fr] = S[d][r];
        }
    }
}

__device__ __forceinline__ void phase5(PP p) {
    const bf16_t* PROJ = (const bf16_t*)(p->ws + WS_PROJ); bf16_t* OM = (bf16_t*)(p->ws + WS_H);
    const int tid = threadIdx.x, sub = tid & 15, grp = tid >> 4;
    const float* gw = p->in[17];
    for (int pr = blockIdx.x * 32 + grp; pr < MP * 8; pr += gridDim.x * 32) {
        const int m = pr >> 3, h = pr & 7;
        bf16_t* op = OM + (size_t)m * D + h * 128 + sub * 8;
        float o[8], z[8]; unpack8(*(const u32x4*)op, o); unpack8(*(const u32x4*)(PROJ + (size_t)m * NPROJ + 3072 + h * 128 + sub * 8), z);
        float ss = 0.f;
#pragma unroll
        for (int j = 0; j < 8; ++j) ss += o[j] * o[j];
        ss += __shfl_xor(ss, 1); ss += __shfl_xor(ss, 2); ss += __shfl_xor(ss, 4); ss += __shfl_xor(ss, 8);
        const float rs = rsqrtf(ss * (1.0f / 128.f) + EPS);
        float w[8];
#pragma unroll
        for (int j = 0; j < 8; ++j) w[j] = o[j] * rs * gw[sub * 8 + j] * silu_f(z[j]);
        u32x4 pk; pk.x = cvt_pk_bf16(w[0], w[1]); pk.y = cvt_pk_bf16(w[2], w[3]); pk.z = cvt_pk_bf16(w[4], w[5]); pk.w = cvt_pk_bf16(w[6], w[7]);
        *(u32x4*)op = pk;
    }
}

__device__ __forceinline__ void phase9(PP p) {
    const float* HEAD = (const float*)(p->ws + WS_HEAD); const float* HALO = (const float*)(p->ws + WS_HALO); const float* US = (const float*)(p->ws + WS_US);
    bf16_t* ACT = (bf16_t*)(p->ws + WS_PROJ); const float* cw = p->in[23]; const float* cb = p->in[24]; const float* st = p->in[6]; float* outp = p->out;
    const int gt = blockIdx.x * NTHR + threadIdx.x, gs = gridDim.x * NTHR;
    constexpr int FQ = FF / 4, FQ2 = FF2 / 4;
    const f32x4 z4 = {0.f, 0.f, 0.f, 0.f};
    for (int e = gt; e < 256 * 2 * FQ; e += gs) {
        const int c = (e % FQ) * 4, rr = (e / FQ) & 1, blk = e / (2 * FQ);
        const bool first = (blk & 63) == 0;
        f32x4 uc[2];
#pragma unroll
        for (int s = 0; s < 2; ++s) { const int cu = c + s * FF;
            const f32x4 u0 = *(const f32x4*)(HEAD + (size_t)(blk * 2 + rr) * FF2 + cu);
            const float* h1 = first ? HEAD : HALO + (size_t)((blk - 1) * 2 + 1) * FF2; const float* h0 = first ? HEAD : HALO + (size_t)((blk - 1) * 2) * FF2;
            const f32x4 a1 = *(const f32x4*)(h1 + cu), a0 = *(const f32x4*)(h0 + cu), hd0 = *(const f32x4*)(HEAD + (size_t)(blk * 2) * FF2 + cu);
            const f32x4 u1 = rr == 0 ? (first ? z4 : a1) : hd0;
            const f32x4 u2 = rr == 0 ? (first ? z4 : a0) : (first ? z4 : a1);
            uc[s] = *(const f32x4*)(cw + 2 * FF2 + cu) * u0 + *(const f32x4*)(cw + FF2 + cu) * u1 + *(const f32x4*)(cw + cu) * u2 + *(const f32x4*)(cb + cu); }
        u32x2 w; w.x = cvt_pk_bf16(silu_f(uc[0][0]) * uc[1][0], silu_f(uc[0][1]) * uc[1][1]); w.y = cvt_pk_bf16(silu_f(uc[0][2]) * uc[1][2], silu_f(uc[0][3]) * uc[1][3]);
        *(u32x2*)(ACT + (size_t)(blk * 64 + rr) * FF + c) = w;
    }
    for (int e = gt; e < MS * FQ; e += gs) {
        const int c = (e % FQ) * 4, row = e / FQ, b = row >> 4, t = row & 15;
        f32x4 uc[2];
#pragma unroll
        for (int s = 0; s < 2; ++s) { const int cu = c + s * FF;
            const f32x4 u0 = *(const f32x4*)(US + (size_t)row * FF2 + cu);
            const f32x4 u1 = *(const f32x4*)((t >= 1 ? US + (size_t)(row - 1) * FF2 : st + (size_t)(b * 2 + 1) * FF2) + cu);
            const f32x4 u2 = *(const f32x4*)((t >= 2 ? US + (size_t)(row - 2) * FF2 : st + (size_t)(b * 2 + t) * FF2) + cu);
            uc[s] = *(const f32x4*)(cw + 2 * FF2 + cu) * u0 + *(const f32x4*)(cw + FF2 + cu) * u1 + *(const f32x4*)(cw + cu) * u2 + *(const f32x4*)(cb + cu); }
        u32x2 w; w.x = cvt_pk_bf16(silu_f(uc[0][0]) * uc[1][0], silu_f(uc[0][1]) * uc[1][1]); w.y = cvt_pk_bf16(silu_f(uc[0][2]) * uc[1][2], silu_f(uc[0][3]) * uc[1][3]);
        *(u32x2*)(ACT + (size_t)(MP + row) * FF + c) = w;
    }
    for (int e = gt; e < 4 * 2 * FQ2; e += gs) { const int cu = (e % FQ2) * 4, rr = (e / FQ2) & 1, b = e / (2 * FQ2); *(f32x4*)(outp + O_PFFN + (size_t)e * 4) = *(const f32x4*)(HALO + (size_t)((b * 64 + 63) * 2 + rr) * FF2 + cu); }
    for (int e = gt; e < 32 * 2 * FQ2; e += gs) { const int cu = (e % FQ2) * 4, rr = (e / FQ2) & 1, b = e / (2 * FQ2); *(f32x4*)(outp + O_SFFN + (size_t)e * 4) = *(const f32x4*)(US + (size_t)(b * 16 + 14 + rr) * FF2 + cu); }
}

#define XB_TMO      128
#define XB_XCNT(j)  (256  + 64 * (j))
#define XB_XSUB(j)  (1280 + 64 * (j))
#define XB_XGEN(j)  (2304 + 64 * (j))
#define XB_TOP      3328
#define XB_TOPGEN   3392
#define XCD_BAR_WORDS 3456
#define XB_SPIN_CAP (1u << 18)
__device__ __forceinline__ unsigned xb_ld(unsigned* p)              { return __hip_atomic_load(p, __ATOMIC_RELAXED, __HIP_MEMORY_SCOPE_AGENT); }
__device__ __forceinline__ unsigned xb_add(unsigned* p, unsigned v) { return __hip_atomic_fetch_add(p, v, __ATOMIC_RELAXED, __HIP_MEMORY_SCOPE_AGENT); }
__device__ __forceinline__ unsigned xb_xcc_id() { return (unsigned)__builtin_amdgcn_s_getreg((3 << 11) | 20) & 0xFu; }
#define XB_SPIN(cond, bar) do { unsigned _sp = 0; while (cond) { __builtin_amdgcn_s_sleep(1); \
    if ((++_sp & 255u) == 0u) { if (xb_ld(&(bar)[XB_TMO])) break; if (_sp > XB_SPIN_CAP) { atomicAdd(&(bar)[XB_TMO], 1u); break; } } } } while (0)
struct XcdBarrier { unsigned* bar; unsigned x; volatile LAS unsigned* st; };
__device__ __forceinline__ bool sum_ok(unsigned* bar) { return xb_ld(&bar[XB_TMO]) == 0u; }
__device__ __forceinline__ XcdBarrier xcd_barrier_post(unsigned* bar, volatile LAS unsigned* st) {
    XcdBarrier b; b.bar = bar; b.x = xb_xcc_id(); b.st = st;
    if (threadIdx.x == 0) st[2] = xb_add(&bar[XB_XCNT(b.x)], 1u);
    return b;
}
__device__ __forceinline__ void xcd_barrier_complete(unsigned* bar, unsigned x, unsigned& nloc, unsigned& nx, unsigned& all32) {
    const unsigned G = gridDim.x * gridDim.y * gridDim.z;
    unsigned sum, cnt, mine, sp = 0u;
    for (;;) {
        sum = 0u; cnt = 0u; mine = 0u; all32 = 1u;
#pragma unroll
        for (unsigned j = 0; j < 16; ++j) { const unsigned c = xb_ld(&bar[XB_XCNT(j)]); sum += c; cnt += (c > 0u) ? 1u : 0u; mine = (j == x) ? c : mine; if (c != 0u && c != 32u) all32 = 0u; }
        if (sum == G) break;
        __builtin_amdgcn_s_sleep(1);
        if ((++sp & 255u) == 0u) { if (xb_ld(&bar[XB_TMO])) break; if (sp > XB_SPIN_CAP) { atomicAdd(&bar[XB_TMO], 1u); break; } }
    }
    nloc = mine > 0u ? mine : 1u; nx = cnt > 0u ? cnt : 1u;
}
__device__ __forceinline__ void xcd_barrier(const XcdBarrier& b) {
    asm volatile("s_waitcnt vmcnt(0)" ::: "memory");
    __syncthreads();
    if (threadIdx.x == 0) {
        unsigned* bar = b.bar;
        __builtin_amdgcn_s_waitcnt(0);
        unsigned nloc = b.st[0], nx = b.st[1];
        if (nloc == 0u) { unsigned all32 = 0u; xcd_barrier_complete(bar, b.x, nloc, nx, all32); b.st[0] = nloc; b.st[1] = nx; b.st[3] = (all32 != 0u && nx == 8u && sum_ok(bar)) ? 1u : 0u; }
        const unsigned old = xb_add(&bar[XB_XSUB(b.x)], 1u);
        const unsigned gen = old / nloc;
        if (old + 1u == (gen + 1u) * nloc) {
            __builtin_amdgcn_fence(__ATOMIC_RELEASE, "agent");
            asm volatile("s_waitcnt vmcnt(0)" ::: "memory");
            const unsigned og = xb_add(&bar[XB_TOP], 1u);
            const unsigned tg = og / nx;
            if (og + 1u == (tg + 1u) * nx) xb_add(&bar[XB_TOPGEN], 1u);
            else XB_SPIN(xb_ld(&bar[XB_TOPGEN]) == tg, bar);
            __builtin_amdgcn_fence(__ATOMIC_ACQUIRE, "agent");
            xb_add(&bar[XB_XGEN(b.x)], 1u);
            asm volatile("s_waitcnt vmcnt(0)" ::: "memory");
        } else {
            XB_SPIN(xb_ld(&bar[XB_XGEN(b.x)]) == gen, bar);
            __builtin_amdgcn_fence(__ATOMIC_ACQUIRE, "agent");
            asm volatile("s_waitcnt vmcnt(0)" ::: "memory");
        }
    }
    __syncthreads();
}

constexpr int N_PHASES = 12;
__global__ void __launch_bounds__(NTHR, 2) hybrid_fwd(Params p_) {
    extern __shared__ __attribute__((aligned(16))) unsigned char smem[];
    PP p = (PP)__builtin_amdgcn_kernarg_segment_ptr();
    const int lo = p->ph_lo, hi = p->ph_hi;
    const int G = gridDim.x;
    volatile LAS unsigned* bst = (volatile LAS unsigned*)((LAS unsigned char*)smem + LDS_BYTES - 16);
    XcdBarrier xbar; xbar.bar = (unsigned*)(p->ws + WS_BAR); xbar.x = 0; xbar.st = bst;
    if (hi - lo > 1) { if (threadIdx.x < 4) bst[threadIdx.x] = 0u; __syncthreads(); xbar = xcd_barrier_post((unsigned*)(p->ws + WS_BAR), bst); }
#ifndef PH_MASK
#define PH_MASK 0xfff
#endif
#define IN(k) (((PH_MASK >> (k)) & 1) && lo <= (k) && (k) < hi)
#ifndef REP_MASK
#define REP_MASK 0
#endif
#define VCU() ((bst[3] == 1u && (hi - lo > 1)) ? (int)(xbar.x + 8u * bst[2]) : (int)blockIdx.x)
#define LAUNDER() asm volatile("" : "+s"(p))
#define REP(k) for (int rep_ = 0; rep_ < 1 + ((REP_MASK >> (k)) & 1); ++rep_)
#define SEAM(k) do { if (IN(k) && IN((k) + 1)) { xcd_barrier(xbar); } } while (0)
    if (hi == 0x7fffffff) cg::this_grid().sync();
    LAUNDER();
    if (IN(0)) REP(0) phase0(p, smem);
    SEAM(0);
    LAUNDER();
    if (IN(1)) REP(1) norm_phase(p, p->in[0], p->in[1], p->in[11], 0, false);
    SEAM(1);
    LAUNDER();
    if (IN(2)) REP(2) { pg8::Gemm g{(const bf16_t*)(p->ws + WS_H), (const bf16_t*)(p->ws + WS_WIN), MT, NIN_PAD, D, D}; pg8::StaticOrder S; S.init(MT, NIN_PAD, G, VCU());
        Epi1 E{(bf16_t*)(p->ws + WS_PROJ), (float*)(p->ws + WS_AB)}; pg8::gemm_phase<Epi1, pg8::StaticOrder>((LAS unsigned char*)smem, g, S, E); }
    SEAM(2);
    LAUNDER();
    if (IN(3)) REP(3) phase3(p, smem);
    SEAM(3);
    LAUNDER();
    if (IN(4)) REP(4) phase4(p, smem);
    SEAM(4);
    LAUNDER();
    if (IN(5)) phase5(p);
    SEAM(5);
    LAUNDER();
    if (IN(6)) REP(6) { pg8::Gemm g{(const bf16_t*)(p->ws + WS_H), (const bf16_t*)(p->ws + WS_WO), MP, D, D, D}; pg8::StaticOrder S; S.init(MP, D, G, VCU());
        EpiRes E{p->in[0], p->in[1], p->out, (const float*)(p->ws + WS_MOD), 2}; pg8::gemm_phase<EpiRes, pg8::StaticOrder>((LAS unsigned char*)smem, g, S, E);
        pg8::Gemm g2{(const bf16_t*)(p->ws + WS_H) + (size_t)MP * D, (const bf16_t*)(p->ws + WS_WO), MS, D, 256, D}; pg8::SplitOrder S2; S2.init(MS, D, D / 256, G, VCU());
        EpiPart E2{(float*)(p->ws + WS_GDN)}; pg8::gemm_phase<EpiPart, pg8::SplitOrder>((LAS unsigned char*)smem, g2, S2, E2); }
    SEAM(6);
    LAUNDER();
    if (IN(7)) REP(7) norm_phase(p, p->out, p->in[1], p->in[12], 3, true);
    SEAM(7);
    LAUNDER();
    if (IN(8)) REP(8) { pg8::Gemm g{(const bf16_t*)(p->ws + WS_H), (const bf16_t*)(p->ws + WS_WUP), MT, FF2, D, D}; pg8::StaticOrder S; S.init(MT, FF2, G, VCU());
        Epi3 E{(bf16_t*)(p->ws + WS_PROJ), (float*)(p->ws + WS_HEAD), (float*)(p->ws + WS_HALO), (float*)(p->ws + WS_US), p->in[23], p->in[24]}; pg8::gemm_phase<Epi3, pg8::StaticOrder>((LAS unsigned char*)smem, g, S, E); }
    SEAM(8);
    LAUNDER();
    if (IN(9)) REP(9) phase9(p);
    SEAM(9);
    LAUNDER();
    if (IN(10)) { pg8::Gemm g{(const bf16_t*)(p->ws + WS_PROJ), (const bf16_t*)(p->ws + WS_WDN), MP, D, FF, FF}; pg8::StaticOrder S; S.init(MP, D, G, VCU());
        EpiRes E{p->out, p->out + (size_t)MP * D, p->out, (const float*)(p->ws + WS_MOD), 5}; pg8::gemm_phase<EpiRes, pg8::StaticOrder>((LAS unsigned char*)smem, g, S, E);
        pg8::Gemm g2{(const bf16_t*)(p->ws + WS_PROJ) + (size_t)MP * FF, (const bf16_t*)(p->ws + WS_WDN), MS, D, 512, FF}; pg8::SplitOrder S2; S2.init(MS, D, FF / 512, G, VCU());
        EpiPart E2{(float*)(p->ws + WS_GDN)}; pg8::gemm_phase<EpiPart, pg8::SplitOrder>((LAS unsigned char*)smem, g2, S2, E2); }
    SEAM(10);
    LAUNDER();
    if (IN(11)) {
        const float* part = (const float*)(p->ws + WS_GDN); const float* mod = (const float*)(p->ws + WS_MOD);
        for (int e = blockIdx.x * NTHR + threadIdx.x; e < MS * D / 4; e += G * NTHR) { const int row = e >> 9, c = (e & 511) * 4; f32x4 a = {0.f, 0.f, 0.f, 0.f};
#pragma unroll
            for (int sp = 0; sp < 11; ++sp) a += *(const f32x4*)(part + (size_t)sp * MS * D + (size_t)row * D + c);
            float* o = p->out + (size_t)(MP + row) * D + c; *(f32x4*)o = *(const f32x4*)o + *(const f32x4*)(mod + (size_t)(4 + (row >> 4)) * NMODW + 5 * D + c) * a; } }
#undef IN
#undef SEAM
}

extern "C" void kernel_launch(void* const* d_in, const int* in_sizes, int n_in, void* d_out, int out_size, void* d_ws, size_t ws_size, hipStream_t stream) {
    static int grid = 0;
    if (grid == 0) {
        if (n_in != 26 || (size_t)out_size != O_END || ws_size < WS_ALL) { fprintf(stderr, "kernel_launch: unexpected shapes (n_in %d out %d ws %zu)\n", n_in, out_size, ws_size); grid = -1; return; }
        int dev = 0, cus = 0, per_cu = 0;
        hipGetDevice(&dev); hipDeviceGetAttribute(&cus, hipDeviceAttributeMultiprocessorCount, dev);
        if (hipFuncSetAttribute((const void*)hybrid_fwd, hipFuncAttributeMaxDynamicSharedMemorySize, LDS_BYTES) != hipSuccess) { fprintf(stderr, "kernel_launch: hipFuncSetAttribute failed\n"); grid = -1; return; }
        if (hipOccupancyMaxActiveBlocksPerMultiprocessor(&per_cu, (const void*)hybrid_fwd, NTHR, LDS_BYTES) != hipSuccess || per_cu < 1) { fprintf(stderr, "kernel_launch: occupancy query says %d\n", per_cu); per_cu = 1; }
        (void)hipGetLastError();
        grid = cus * 1;
    }
    if (grid < 0) return;
    Params p{};
    for (int i = 0; i < 26; ++i) p.in[i] = (const float*)d_in[i];
    p.out = (float*)d_out; p.ws = (unsigned char*)d_ws;
#if N_LAUNCH_MODE == 1
    if (hipMemsetAsync((char*)d_ws + WS_BAR, 0, 16384, stream) != hipSuccess) { fprintf(stderr, "kernel_launch: memset failed\n"); return; }
    p.ph_lo = 0; p.ph_hi = N_PHASES;
    void* args[] = {&p};
    hipError_t e = hipLaunchCooperativeKernel((const void*)hybrid_fwd, dim3(grid), dim3(NTHR), args, LDS_BYTES, stream);
    if (e != hipSuccess) fprintf(stderr, "cooperative launch failed: %s (grid %d)\n", hipGetErrorString(e), grid);
#else
    for (int ph = 0; ph < N_PHASES; ++ph) { p.ph_lo = ph; p.ph_hi = ph + 1; hipLaunchKernelGGL(hybrid_fwd, dim3(grid), dim3(NTHR), LDS_BYTES, stream, p); }
#endif
}
```

```cpp
#include <hip/hip_runtime.h>
#include <hip/hip_cooperative_groups.h>
#include <cstdio>
#include <cstdint>
namespace cg = cooperative_groups;

#ifndef N_LAUNCH_MODE
#define N_LAUNCH_MODE 1
#endif

#define LAS __attribute__((address_space(3)))
typedef unsigned short bf16_t;
typedef short bf16x8 __attribute__((ext_vector_type(8)));
typedef float f32x4 __attribute__((ext_vector_type(4)));
typedef float f32x2 __attribute__((ext_vector_type(2)));
typedef unsigned u32x4 __attribute__((ext_vector_type(4)));
typedef unsigned u32x2 __attribute__((ext_vector_type(2)));

constexpr int D = 2048, MP = 16384, MS = 512, MT = MP + MS, LP = 4096, LS = 16, NBP = 4, NBS = 32;
constexpr int NPROJ = 5632, NIN_PAD = 5888, INW = 5648, FF = 5632, FF2 = 11264;
constexpr int NMODW = 12288;
constexpr float EPS = 1e-6f;
constexpr int NTHR = 512;
constexpr int LDS_BYTES = 163840;

constexpr size_t O_YP = 0, O_YS = O_YP + (size_t)MP * D, O_PCONV = O_YS + (size_t)MS * D, O_PDELTA = O_PCONV + 4 * 3 * 3072,
                 O_PK = O_PDELTA + (size_t)4 * 8 * 128 * 128, O_PV = O_PK + 4 * 128 * 2 * 128, O_PFFN = O_PV + 4 * 128 * 2 * 128,
                 O_SCONV = O_PFFN + 4 * 2 * FF2, O_SDELTA = O_SCONV + 32 * 3 * 3072, O_SK = O_SDELTA + (size_t)32 * 8 * 128 * 128,
                 O_SV = O_SK + 32 * 128 * 2 * 128, O_SFFN = O_SV + 32 * 128 * 2 * 128, O_END = O_SFFN + 32 * 2 * FF2;

constexpr size_t WS_WUP = 0, WS_WDN = WS_WUP + (size_t)FF2 * D * 2, WS_WIN = WS_WDN + (size_t)D * FF * 2, WS_WO = WS_WIN + (size_t)NIN_PAD * D * 2,
                 WS_MOD = WS_WO + (size_t)D * D * 2, WS_AB = WS_MOD + (size_t)36 * NMODW * 4, WS_H = WS_AB + (size_t)MT * 16 * 4,
                 WS_PROJ = WS_H + (size_t)MT * D * 2, WS_GDN = WS_PROJ + (size_t)MT * NPROJ * 2;
constexpr size_t CH_BYTES = 73984, CH_W = 0, CH_QG = 16384, CH_QK = 32768, CH_KD = 40960, CH_UT = 57344, CH_GL = 73728;
constexpr size_t WS_END = WS_GDN + (size_t)2048 * CH_BYTES;
constexpr size_t WS_HEAD = WS_GDN, WS_HALO = WS_HEAD + (size_t)256 * 2 * FF2 * 4, WS_US = WS_HALO + (size_t)256 * 2 * FF2 * 4;
static_assert(WS_US + (size_t)MS * FF2 * 4 <= WS_END, "ffn side buffers");
constexpr size_t WS_BAR = WS_END, WS_ALL = WS_BAR + 16384;
static_assert(WS_ALL <= (size_t)536870912, "workspace");

struct Params { const float* in[26]; float* out; unsigned char* ws; int ph_lo, ph_hi; };
typedef const __attribute__((address_space(4))) Params* PP;

typedef __bf16 bf16x2_t __attribute__((ext_vector_type(2)));
__device__ __forceinline__ unsigned cvt_pk_bf16(float lo, float hi) { f32x2 f = {lo, hi}; bf16x2_t v = __builtin_convertvector(f, bf16x2_t); return __builtin_bit_cast(unsigned, v); }
__device__ __forceinline__ float bf_lo(unsigned u) { return __uint_as_float(u << 16); }
__device__ __forceinline__ float bf_hi(unsigned u) { return __uint_as_float(u & 0xffff0000u); }
__device__ __forceinline__ float bf2f(bf16_t b) { return __uint_as_float(((unsigned)b) << 16); }
__device__ __forceinline__ float silu_f(float x) { return x * __builtin_amdgcn_rcpf(1.0f + __expf(-x)); }
__device__ __forceinline__ float sigmoid_f(float x) { return __builtin_amdgcn_rcpf(1.0f + __expf(-x)); }
__device__ __forceinline__ float softplus_f(float x) { return x > 20.f ? x : log1pf(__expf(x)); }
template <int CTRL> __device__ __forceinline__ float dpp0(float v) { return __builtin_bit_cast(float, __builtin_amdgcn_update_dpp(0, __builtin_bit_cast(int, v), CTRL, 0xf, 0xf, true)); }
__device__ __forceinline__ int cond_of_row(int m) { return m < MP ? (m >> 12) : 4 + ((m - MP) >> 4); }
__device__ __forceinline__ void unpack8(u32x4 v, float* f) { f[0] = bf_lo(v.x); f[1] = bf_hi(v.x); f[2] = bf_lo(v.y); f[3] = bf_hi(v.y); f[4] = bf_lo(v.z); f[5] = bf_hi(v.z); f[6] = bf_lo(v.w); f[7] = bf_hi(v.w); }
__device__ __forceinline__ bf16x8 as_bf16x8(u32x4 v) { return __builtin_bit_cast(bf16x8, v); }

namespace pg8 {
constexpr int BM = 256, BK = 64, HALF = 128, HTB = HALF * BK * 2, STAGE_BYTES = 8 * HTB, NXCD = 8, WGM = 2;
__host__ __device__ __forceinline__ int lds_byte(int r, int c) { const int st = (r >> 4) * 2 + (c >> 5), rr = r & 15, cc = c & 31, ob = rr * 64 + cc * 2; return st * 1024 + (ob ^ (((ob >> 9) & 1) << 5)); }
__host__ __device__ __forceinline__ void stage_rc(int b, int& R, int& C) { const int st = b / 1024, sb = b % 1024, swz = sb ^ (((sb >> 9) & 1) << 5); R = (st >> 1) * 16 + swz / 64; C = (st & 1) * 32 + (swz % 64) / 2; }
struct Unit { int pm, pn, ks; };
struct Gemm { const bf16_t* A; const bf16_t* Bt; int M, N, K, ldk; };
struct StaticOrder {
    int nM, nN, nwg, G, c;
    __host__ __device__ __forceinline__ void init(int M, int N, int G_, int c_) { nM = M / BM; nN = N / BM; nwg = nM * nN; G = G_; c = c_; }
    __host__ __device__ bool next(int i, Unit& u) const {
        const long L = (long)i * G + c; if (L >= nwg) return false;
        int wgid = (int)L; { const int q = nwg / NXCD, r = nwg % NXCD, xcd = wgid % NXCD, off = wgid / NXCD; wgid = (xcd < r ? xcd * (q + 1) : r * (q + 1) + (xcd - r) * q) + off; }
        const int nig = WGM * nN, gid = wgid / nig, fm = gid * WGM, gsz = (nM - fm) < WGM ? (nM - fm) : WGM;
        u.pm = fm + ((wgid % nig) % gsz); u.pn = (wgid % nig) / gsz; u.ks = 0; return true;
    }
};
struct SplitOrder {
    int nM, nN, nS, nwg, G, c;
    __host__ __device__ __forceinline__ void init(int M, int N, int nS_, int G_, int c_) { nM = M / BM; nN = N / BM; nS = nS_; nwg = nM * nN * nS; G = G_; c = c_; }
    __host__ __device__ bool next(int i, Unit& u) const {
        const long L = (long)i * G + c; if (L >= nwg) return false;
        const int l = (int)L; u.ks = l % nS; const int t = l / nS; u.pn = t % nN; u.pm = t / nN; return true;
    }
};

template <class Epi, class Sched>
__device__ __forceinline__ void gemm_phase(LAS unsigned char* lds, const Gemm g, const Sched& S, const Epi& E) {
    const int tid = threadIdx.x, wid = __builtin_amdgcn_readfirstlane(tid >> 6), lane = tid & 63, wr = wid >> 2, wc = wid & 3, fr = lane & 15, fq = lane >> 4;
    const int K = g.ldk, nt = g.K / BK;
    const size_t sstep = (size_t)g.K * 2;
    unsigned voffA[2];
#pragma unroll
    for (int i = 0; i < 2; ++i) { int R, C; stage_rc(tid * 16 + i * 8192, R, C); voffA[i] = (unsigned)(R * K + C) * 2u; }
    const size_t kstep = (size_t)(BK * 2);
    const size_t hstep = (size_t)HALF * K * 2;
    const size_t tstep = 2 * hstep;
    const unsigned ldsw = (unsigned)wid * 1024u;
    const int aoff = lds_byte(wr * 64 + fr, fq * 8), boff = lds_byte(wc * 32 + fr, fq * 8);
#define PG8_SA(b, h) (((b) * 2 + (h)) * HTB)
#define PG8_SB(b, h) ((4 + (b) * 2 + (h)) * HTB)
#define PG8_STAGE(bufoff, gbase, voff) do { _Pragma("unroll") for (int _i = 0; _i < 2; ++_i) \
        __builtin_amdgcn_global_load_lds((const unsigned*)((const char*)(gbase) + (voff)[_i]), (LAS unsigned*)(lds + (bufoff) + ldsw + _i * 8192), 16, 0, 0); } while (0)
#define PG8_LDA(dst, b, h) do { _Pragma("unroll") for (int m = 0; m < 4; ++m) _Pragma("unroll") for (int k = 0; k < 2; ++k) dst[m][k] = *(const LAS bf16x8*)(lds + PG8_SA(b, h) + aoff + m * 2048 + k * 1024); } while (0)
#define PG8_LDB(dst, b, h) do { _Pragma("unroll") for (int n = 0; n < 2; ++n) _Pragma("unroll") for (int k = 0; k < 2; ++k) dst[n][k] = *(const LAS bf16x8*)(lds + PG8_SB(b, h) + boff + n * 2048 + k * 1024); } while (0)
#define PG8_MMA(ai, bj, At, Bt) do { __builtin_amdgcn_s_setprio(1); _Pragma("unroll") for (int m = 0; m < 4; ++m) _Pragma("unroll") for (int n = 0; n < 2; ++n) _Pragma("unroll") for (int k = 0; k < 2; ++k) \
        acc[ai][bj][m][n] = __builtin_amdgcn_mfma_f32_16x16x32_bf16(Bt[n][k], At[m][k], acc[ai][bj][m][n], 0, 0, 0); __builtin_amdgcn_s_setprio(0); } while (0)
#define PG8_WAIT_V(n) asm volatile("s_waitcnt vmcnt(" #n ")" ::: "memory")
#define PG8_WAIT_L(n) asm volatile("s_waitcnt lgkmcnt(" #n ")" ::: "memory")
#define PG8_BAR __builtin_amdgcn_s_barrier()
#define PG8_SCHED __builtin_amdgcn_sched_barrier(0)
    Unit cur, nxt; int ui = 0;
    if (!S.next(0, cur)) return;
    f32x4 acc[2][2][4][2];
#pragma unroll
    for (int a = 0; a < 2; ++a)
#pragma unroll
        for (int b = 0; b < 2; ++b)
#pragma unroll
            for (int m = 0; m < 4; ++m)
#pragma unroll
                for (int n = 0; n < 2; ++n) acc[a][b][m][n] = (f32x4){0.f, 0.f, 0.f, 0.f};
    bf16x8 At[4][2], B0[2][2], B1[2][2];
    const char* cA = (const char*)g.A + (size_t)cur.pm * tstep + cur.ks * sstep; const char* cB = (const char*)g.Bt + (size_t)cur.pn * tstep + cur.ks * sstep;
    PG8_STAGE(PG8_SB(0, 0), cB, voffA); PG8_STAGE(PG8_SA(0, 0), cA, voffA); PG8_STAGE(PG8_SB(0, 1), cB + hstep, voffA); PG8_STAGE(PG8_SA(0, 1), cA + hstep, voffA);
    if (wr == 1) PG8_BAR;
    PG8_WAIT_V(4); PG8_BAR;
    PG8_STAGE(PG8_SB(1, 0), cB + kstep, voffA); PG8_STAGE(PG8_SA(1, 0), cA + kstep, voffA); PG8_STAGE(PG8_SB(1, 1), cB + hstep + kstep, voffA);
    PG8_WAIT_V(6); PG8_BAR;
    for (;;) {
        const bool has_next = S.next(ui + 1, nxt);
        const char* nA = has_next ? (const char*)g.A + (size_t)nxt.pm * tstep + nxt.ks * sstep : cA; const char* nB = has_next ? (const char*)g.Bt + (size_t)nxt.pn * tstep + nxt.ks * sstep : cB;
        for (int t = 0; t < nt; t += 2) {
            const bool last = (t == nt - 2);
            const char* a1 = cA + (size_t)(t + 1) * kstep;
            const char* a2 = last ? nA : cA + (size_t)(t + 2) * kstep; const char* b2 = last ? nB : cB + (size_t)(t + 2) * kstep;
            const char* a3 = a2 + kstep; const char* b3 = b2 + kstep;
            PG8_LDB(B0, 0, 0); PG8_SCHED; PG8_LDA(At, 0, 0); PG8_STAGE(PG8_SA(1, 1), a1 + hstep, voffA);
            PG8_WAIT_L(8); PG8_BAR; PG8_WAIT_L(0); PG8_MMA(0, 0, At, B0); PG8_BAR; PG8_SCHED;
            PG8_LDB(B1, 0, 1); PG8_STAGE(PG8_SB(0, 0), b2, voffA);
            PG8_BAR; PG8_WAIT_L(0); PG8_MMA(0, 1, At, B1); PG8_BAR;
            PG8_LDA(At, 0, 1); PG8_STAGE(PG8_SA(0, 0), a2, voffA);
            PG8_BAR; PG8_WAIT_L(0); PG8_MMA(1, 0, At, B0); PG8_BAR; PG8_SCHED;
            PG8_STAGE(PG8_SB(0, 1), b2 + hstep, voffA);
            PG8_WAIT_V(6); PG8_BAR; PG8_MMA(1, 1, At, B1); PG8_BAR;
            PG8_LDB(B0, 1, 0); PG8_SCHED; PG8_LDA(At, 1, 0); PG8_STAGE(PG8_SA(0, 1), a2 + hstep, voffA);
            PG8_WAIT_L(8); PG8_BAR; PG8_WAIT_L(0); PG8_MMA(0, 0, At, B0); PG8_BAR; PG8_SCHED;
            PG8_LDB(B1, 1, 1); PG8_STAGE(PG8_SB(1, 0), b3, voffA);
            PG8_BAR; PG8_WAIT_L(0); PG8_MMA(0, 1, At, B1); PG8_BAR;
            PG8_LDA(At, 1, 1); PG8_STAGE(PG8_SA(1, 0), a3, voffA);
            PG8_BAR; PG8_WAIT_L(0); PG8_MMA(1, 0, At, B0); PG8_BAR; PG8_SCHED;
            PG8_STAGE(PG8_SB(1, 1), b3 + hstep, voffA);
            PG8_WAIT_V(6); PG8_BAR; PG8_MMA(1, 1, At, B1); PG8_BAR;
        }
        E(acc, cur, wr, wc, fr, fq);
        if (!has_next) break;
#pragma unroll
        for (int a = 0; a < 2; ++a)
#pragma unroll
            for (int b = 0; b < 2; ++b)
#pragma unroll
                for (int m = 0; m < 4; ++m)
#pragma unroll
                    for (int n = 0; n < 2; ++n) acc[a][b][m][n] = (f32x4){0.f, 0.f, 0.f, 0.f};
        cur = nxt; cA = nA; cB = nB; ++ui;
    }
    PG8_WAIT_V(0);
    if (wr == 0) PG8_BAR;
    PG8_BAR;
#undef PG8_SA
#undef PG8_SB
#undef PG8_STAGE
#undef PG8_LDA
#undef PG8_LDB
#undef PG8_MMA
#undef PG8_WAIT_V
#undef PG8_WAIT_L
#undef PG8_BAR
#undef PG8_SCHED
}
}
using pg8::Unit;

struct Epi1 {
    bf16_t* P; float* AB;
    __device__ __forceinline__ void operator()(const f32x4 (&acc)[2][2][4][2], const Unit& u, int wr, int wc, int fr, int fq) const {
        const int row0 = u.pm * 256 + wr * 64 + fr;
        if (u.pn < 22) {
            const int col0 = u.pn * 256 + wc * 32 + 4 * fq;
#pragma unroll
            for (int ai = 0; ai < 2; ++ai)
#pragma unroll
                for (int m = 0; m < 4; ++m) { bf16_t* rowp = P + (size_t)(row0 + ai * 128 + m * 16) * NPROJ + col0;
#pragma unroll
                    for (int bj = 0; bj < 2; ++bj)
#pragma unroll
                        for (int n = 0; n < 2; ++n) { const f32x4 a = acc[ai][bj][m][n]; u32x2 w; w.x = cvt_pk_bf16(a[0], a[1]); w.y = cvt_pk_bf16(a[2], a[3]); *(u32x2*)(rowp + bj * 128 + n * 16) = w; } }
        } else if (wc == 0) {
#pragma unroll
            for (int ai = 0; ai < 2; ++ai)
#pragma unroll
                for (int m = 0; m < 4; ++m) *(f32x4*)(AB + (size_t)(row0 + ai * 128 + m * 16) * 16 + 4 * fq) = acc[ai][0][m][0];
        }
    }
};
struct EpiRes {
    const float* xa; const float* xb; float* out; const float* mod; int gi;
    __device__ __forceinline__ void operator()(const f32x4 (&acc)[2][2][4][2], const Unit& u, int wr, int wc, int fr, int fq) const {
        const int row0 = u.pm * 256 + wr * 64 + fr, col0 = u.pn * 256 + wc * 32 + 4 * fq;
        const float* gr = mod + (size_t)cond_of_row(u.pm * 256) * NMODW + gi * D + col0;
        f32x4 g4[2][2];
#pragma unroll
        for (int bj = 0; bj < 2; ++bj)
#pragma unroll
            for (int n = 0; n < 2; ++n) g4[bj][n] = *(const f32x4*)(gr + bj * 128 + n * 16);
#pragma unroll
        for (int ai = 0; ai < 2; ++ai) {
            f32x4 xv[4][2][2];
#pragma unroll
            for (int m = 0; m < 4; ++m) { const float* xr = xa + (size_t)(row0 + ai * 128 + m * 16) * D + col0;
#pragma unroll
                for (int bj = 0; bj < 2; ++bj)
#pragma unroll
                    for (int n = 0; n < 2; ++n) xv[m][bj][n] = *(const f32x4*)(xr + bj * 128 + n * 16); }
            __builtin_amdgcn_sched_barrier(0);
#pragma unroll
            for (int m = 0; m < 4; ++m) { float* orow = out + (size_t)(row0 + ai * 128 + m * 16) * D + col0;
#pragma unroll
                for (int bj = 0; bj < 2; ++bj)
#pragma unroll
                    for (int n = 0; n < 2; ++n) *(f32x4*)(orow + bj * 128 + n * 16) = xv[m][bj][n] + g4[bj][n] * acc[ai][bj][m][n]; }
        }
    }
};
struct EpiPart {
    float* part;
    __device__ __forceinline__ void operator()(const f32x4 (&acc)[2][2][4][2], const Unit& u, int wr, int wc, int fr, int fq) const {
        const int row0 = u.pm * 256 + wr * 64 + fr, col0 = u.pn * 256 + wc * 32 + 4 * fq;
        float* base = part + (size_t)u.ks * MS * D;
#pragma unroll
        for (int ai = 0; ai < 2; ++ai)
#pragma unroll
            for (int m = 0; m < 4; ++m) { float* orow = base + (size_t)(row0 + ai * 128 + m * 16) * D + col0;
#pragma unroll
                for (int bj = 0; bj < 2; ++bj)
#pragma unroll
                    for (int n = 0; n < 2; ++n) *(f32x4*)(orow + bj * 128 + n * 16) = acc[ai][bj][m][n]; }
    }
};
struct Epi3 {
    bf16_t* ACT; float* HEAD; float* HALO; float* US; const float* cw; const float* cb;
    __device__ __forceinline__ void operator()(const f32x4 (&acc)[2][2][4][2], const Unit& u, int wr, int wc, int fr, int fq) const {
        const int cg0 = u.pn * 128 + wc * 32 + 4 * fq;
        if (u.pm >= 64) {
            const int row0 = (u.pm - 64) * 256 + wr * 64 + fr;
#pragma unroll
            for (int ai = 0; ai < 2; ++ai)
#pragma unroll
                for (int m = 0; m < 4; ++m) { float* rp = US + (size_t)(row0 + ai * 128 + m * 16) * FF2 + cg0;
#pragma unroll
                    for (int bj = 0; bj < 2; ++bj)
#pragma unroll
                        for (int n = 0; n < 2; ++n) *(f32x4*)(rp + bj * FF + n * 16) = acc[ai][bj][m][n]; }
            return;
        }
#pragma unroll
        for (int n = 0; n < 2; ++n) {
            const int cg = cg0 + n * 16;
            f32x4 w0[2], w1[2], w2[2], bb[2];
#pragma unroll
            for (int bj = 0; bj < 2; ++bj) { const int c = cg + bj * FF; w0[bj] = *(const f32x4*)(cw + c); w1[bj] = *(const f32x4*)(cw + FF2 + c); w2[bj] = *(const f32x4*)(cw + 2 * FF2 + c); bb[bj] = *(const f32x4*)(cb + c); }
#pragma unroll
            for (int ai = 0; ai < 2; ++ai) {
                const int blk = u.pm * 4 + ai * 2 + wr;
                const int rowb = blk * 64;
                f32x4 p15[2] = {{0.f, 0.f, 0.f, 0.f}, {0.f, 0.f, 0.f, 0.f}}, p14[2] = {{0.f, 0.f, 0.f, 0.f}, {0.f, 0.f, 0.f, 0.f}};
#pragma unroll
                for (int m = 0; m < 4; ++m) {
                    f32x4 uc[2];
#pragma unroll
                    for (int bj = 0; bj < 2; ++bj) { const f32x4 cur = acc[ai][bj][m][n]; f32x4 pr1, pr2, n15, n14;
#pragma unroll
                        for (int j = 0; j < 4; ++j) { pr1[j] = dpp0<0x111>(cur[j]) + p15[bj][j]; pr2[j] = dpp0<0x112>(cur[j]) + p14[bj][j]; n15[j] = dpp0<0x10F>(cur[j]); n14[j] = dpp0<0x10E>(cur[j]); }
                        p15[bj] = n15; p14[bj] = n14;
                        uc[bj] = w2[bj] * cur + w1[bj] * pr1 + w0[bj] * pr2 + bb[bj];
                        if (m == 0 && fr < 2) *(f32x4*)(HEAD + (size_t)(blk * 2 + fr) * FF2 + cg + bj * FF) = cur;
                        if (m == 3 && fr >= 14) *(f32x4*)(HALO + (size_t)(blk * 2 + fr - 14) * FF2 + cg + bj * FF) = cur;
                    }
                    if (m > 0 || fr >= 2) { u32x2 w; w.x = cvt_pk_bf16(silu_f(uc[0][0]) * uc[1][0], silu_f(uc[0][1]) * uc[1][1]); w.y = cvt_pk_bf16(silu_f(uc[0][2]) * uc[1][2], silu_f(uc[0][3]) * uc[1][3]);
                        *(u32x2*)(ACT + (size_t)(rowb + m * 16 + fr) * FF + cg) = w; }
                }
            }
        }
    }
};

struct TileDesc { const float* W; bf16_t* Wt; int K, N, k0, n0, sc0, nv; };
struct ConvPtrs { const float* up; const float* dn; const float* in; const float* o; unsigned char* ws; };
__device__ __forceinline__ ConvPtrs conv_ptrs(PP p) { ConvPtrs c; c.up = p->in[22]; c.dn = p->in[25]; c.in = p->in[13]; c.o = p->in[21]; c.ws = p->ws; return c; }
__device__ __forceinline__ TileDesc tile_desc(const float* up, const float* dn, const float* win, const float* wo, unsigned char* ws, int t) {
    constexpr int T_UP = 32 * 88, T_DN = 88 * 16, T_IN = 32 * 46;
    const int cls = t < T_UP ? 0 : t < T_UP + T_DN ? 1 : t < T_UP + T_DN + T_IN ? 2 : 3;
    const int u = t - (cls == 0 ? 0 : cls == 1 ? T_UP : cls == 2 ? T_UP + T_DN : T_UP + T_DN + T_IN);
    const int NTn = cls == 0 ? 88 : cls == 2 ? 46 : 16; const int q4 = u >> 2; const int nt = q4 % NTn, kt = (q4 / NTn) * 4 + (u & 3), n0 = nt * 128;
    TileDesc d;
    d.W = cls == 0 ? up : cls == 1 ? dn : cls == 2 ? win : wo;
    d.Wt = (bf16_t*)(ws + (cls == 0 ? WS_WUP : cls == 1 ? WS_WDN : cls == 2 ? WS_WIN : WS_WO));
    d.K = cls == 1 ? FF : D; d.N = cls == 0 ? FF2 : cls == 2 ? INW : D; d.k0 = kt * 64; d.n0 = n0;
    const int pn = n0 >> 8;
    d.sc0 = cls == 0 ? ((n0 & 255) < 128 ? 128 * pn : FF + 128 * pn) : cls == 2 ? (n0 < 4096 ? n0 : (n0 < NPROJ ? n0 + 16 : 4096)) : n0;
    d.nv = cls == 2 ? (n0 < NPROJ ? 128 : (n0 == NPROJ ? 16 : 0)) : 128;
    return d;
}
__device__ __forceinline__ void tile_load(const TileDesc& d, f32x4 (&v)[4]) {
    const int tx = threadIdx.x & 31, ty = threadIdx.x >> 5;
#pragma unroll
    for (int ps = 0; ps < 4; ++ps) v[ps] = (4 * tx < d.nv) ? *(const f32x4*)(d.W + (size_t)(d.k0 + ps * 16 + ty) * d.N + d.sc0 + 4 * tx) : (f32x4){0.f, 0.f, 0.f, 0.f};
}
__device__ __forceinline__ void tile_to_lds(const f32x4 (&v)[4], float* tile) {
    const int tx = threadIdx.x & 31, ty = threadIdx.x >> 5;
#pragma unroll
    for (int ps = 0; ps < 4; ++ps) *(f32x4*)(tile + (ps * 16 + ty) * 132 + ((4 * tx + 8 * ps) & 127)) = v[ps];
}
__device__ __forceinline__ void tile_store(const TileDesc& d, const float* tile) {
    const int n = threadIdx.x >> 2, ks = threadIdx.x & 3; float v[16];
#pragma unroll
    for (int j = 0; j < 16; ++j) v[j] = tile[(ks * 16 + j) * 132 + ((n + 8 * ks) & 127)];
    u32x4 w0, w1; w0.x = cvt_pk_bf16(v[0], v[1]); w0.y = cvt_pk_bf16(v[2], v[3]); w0.z = cvt_pk_bf16(v[4], v[5]); w0.w = cvt_pk_bf16(v[6], v[7]);
    w1.x = cvt_pk_bf16(v[8], v[9]); w1.y = cvt_pk_bf16(v[10], v[11]); w1.z = cvt_pk_bf16(v[12], v[13]); w1.w = cvt_pk_bf16(v[14], v[15]);
    bf16_t* dst = d.Wt + (size_t)(d.n0 + n) * d.K + d.k0 + ks * 16; *(u32x4*)dst = w0; *(u32x4*)(dst + 8) = w1;
}
__device__ __forceinline__ void convert_seq(const ConvPtrs p, int n_extra, int first, int base, int stride, int t_all, int split, int shift, float* tile) {
    const int cnt = n_extra + (base < t_all ? (t_all - base + stride - 1) / stride : 0);
    auto tid_of = [&](int i) { const int v = i < n_extra ? first + 64 * i : base + stride * (i - n_extra); return v < split ? v : v + shift; };
    f32x4 ra[4], rb[4];
    if (cnt > 0) tile_load(tile_desc(p.up, p.dn, p.in, p.o, p.ws, tid_of(0)), ra);
    if (cnt > 1) tile_load(tile_desc(p.up, p.dn, p.in, p.o, p.ws, tid_of(1)), rb);
    for (int i = 0; i < cnt; i += 2) {
        { const TileDesc d = tile_desc(p.up, p.dn, p.in, p.o, p.ws, tid_of(i));
          tile_to_lds(ra, tile); if (i + 2 < cnt) tile_load(tile_desc(p.up, p.dn, p.in, p.o, p.ws, tid_of(i + 2)), ra);
          __syncthreads(); tile_store(d, tile); __syncthreads(); }
        if (i + 1 < cnt) { const TileDesc d = tile_desc(p.up, p.dn, p.in, p.o, p.ws, tid_of(i + 1));
          tile_to_lds(rb, tile); if (i + 3 < cnt) tile_load(tile_desc(p.up, p.dn, p.in, p.o, p.ws, tid_of(i + 3)), rb);
          __syncthreads(); tile_store(d, tile); __syncthreads(); }
    }
}
__device__ __forceinline__ void adaln_strip(PP p, int strip, float* lds) {
    const float* cpr = p->in[7]; const float* csm = p->in[8]; const float* aw = p->in[9]; const float* ab = p->in[10];
    float* mod = (float*)(p->ws + WS_MOD);
    const int tid = threadIdx.x, col4 = tid & 15, kg = (tid >> 4) & 15, rh = tid >> 8;
    float* sc = lds;
    float* red = lds + 36 * 256;
    f32x4 acc[18];
#pragma unroll
    for (int i = 0; i < 18; ++i) acc[i] = (f32x4){0.f, 0.f, 0.f, 0.f};
    const int n0 = strip * 64 + col4 * 4;
    f32x4 w[4], wn[4], wm[4];
#pragma unroll
    for (int q = 0; q < 4; ++q) { w[q] = *(const f32x4*)(aw + (size_t)(kg * 4 + q) * NMODW + n0); wn[q] = *(const f32x4*)(aw + (size_t)(64 + kg * 4 + q) * NMODW + n0); }
#pragma unroll 1
    for (int step = 0; step < 32; ++step) {
        const int kc = (step >> 2) * 256, kl = (step & 3) * 64 + kg * 4;
        if (step + 2 < 32) { const int kn = ((step + 2) >> 2) * 256 + ((step + 2) & 3) * 64 + kg * 4;
#pragma unroll
            for (int q = 0; q < 4; ++q) wm[q] = *(const f32x4*)(aw + (size_t)(kn + q) * NMODW + n0); }
        if ((step & 3) == 0) {
            __syncthreads();
#pragma unroll 1
            for (int hb = 0; hb < 2; ++hb) {
                float cv[9];
#pragma unroll
                for (int it2 = 0; it2 < 9; ++it2) { const int e = tid + (hb * 9 + it2) * NTHR, i = e >> 8, k = e & 255; cv[it2] = i < 4 ? cpr[i * D + kc + k] : csm[(i - 4) * D + kc + k]; }
#pragma unroll
                for (int it2 = 0; it2 < 9; ++it2) sc[tid + (hb * 9 + it2) * NTHR] = silu_f(cv[it2]);
            }
            __syncthreads();
        }
#pragma unroll
        for (int i = 0; i < 18; ++i) { const f32x4 s4 = *(const f32x4*)(sc + (rh * 18 + i) * 256 + kl);
            acc[i] += w[0] * s4[0]; acc[i] += w[1] * s4[1]; acc[i] += w[2] * s4[2]; acc[i] += w[3] * s4[3]; }
#pragma unroll
        for (int q = 0; q < 4; ++q) { w[q] = wn[q]; wn[q] = wm[q]; }
    }
    __syncthreads();
    for (int g = 0; g < 16; ++g) {
        if (kg == g) {
#pragma unroll
            for (int i = 0; i < 18; ++i) { float* rp = red + (rh * 18 + i) * 64 + col4 * 4;
#pragma unroll
                for (int j = 0; j < 4; ++j) rp[j] = (g == 0 ? 0.f : rp[j]) + acc[i][j]; }
        }
        __syncthreads();
    }
    for (int e = tid; e < 36 * 64; e += NTHR) { const int i = e >> 6, c = e & 63; mod[(size_t)i * NMODW + strip * 64 + c] = red[e] + ab[strip * 64 + c]; }
    __syncthreads();
}
__device__ __forceinline__ void phase0(PP p, unsigned char* smem) {
    float* lds = (float*)smem;
    const int bid = blockIdx.x, G = gridDim.x;
    constexpr int T_ALL = 32 * 88 + 88 * 16 + 32 * 46 + 32 * 16;
    if (G == 256) {
        if (bid < 192) adaln_strip(p, bid, lds);
        const ConvPtrs cp = conv_ptrs(p);
        if (bid < 192) convert_seq(cp, 0, 0, 832 + bid, 256, T_ALL - 512, 3712, 512, lds);
        else convert_seq(cp, 13, bid - 192, 832 + bid, 256, T_ALL - 512, 3712, 512, lds);
    } else {
        for (int s2 = bid; s2 < 192; s2 += G) adaln_strip(p, s2, lds);
        const ConvPtrs cp = conv_ptrs(p); convert_seq(cp, 0, 0, bid, G, T_ALL, T_ALL, 0, lds);
    }
}

__device__ __forceinline__ void norm_phase(PP p, const float* xa, const float* xb, const float* nw, int si, bool reduce_parts) {
    const float* mod = (const float*)(p->ws + WS_MOD); bf16_t* H = (bf16_t*)(p->ws + WS_H); float* outp = p->out; const float* parts = (const float*)(p->ws + WS_GDN);
    const int wave = threadIdx.x >> 6, lane = threadIdx.x & 63;
    const int stride = gridDim.x * 8;
    int m = blockIdx.x * 8 + wave;
    f32x4 wv[8];
#pragma unroll
    for (int i = 0; i < 8; ++i) wv[i] = *(const f32x4*)(nw + i * 256 + lane * 4);
    f32x4 v[8], vn[8];
    if (m < MT) { const float* xr = m < MP ? xa + (size_t)m * D : xb + (size_t)(m - MP) * D;
#pragma unroll
        for (int i = 0; i < 8; ++i) v[i] = *(const f32x4*)(xr + i * 256 + lane * 4); }
    while (m < MT) {
        const int mn = m + stride;
        const float* mr = mod + (size_t)cond_of_row(m) * NMODW + si * D;
        f32x4 sh[8], scl[8];
#pragma unroll
        for (int i = 0; i < 8; ++i) { sh[i] = *(const f32x4*)(mr + i * 256 + lane * 4); scl[i] = *(const f32x4*)(mr + D + i * 256 + lane * 4); }
        if (mn < MT) { const float* xr = mn < MP ? xa + (size_t)mn * D : xb + (size_t)(mn - MP) * D;
#pragma unroll
            for (int i = 0; i < 8; ++i) vn[i] = *(const f32x4*)(xr + i * 256 + lane * 4); }
        if (reduce_parts && m >= MP) {
            const float* part = parts + (size_t)(m - MP) * D; const float* g1 = mod + (size_t)cond_of_row(m) * NMODW + 2 * D;
#pragma unroll
            for (int i = 0; i < 8; ++i) { f32x4 a = {0.f, 0.f, 0.f, 0.f};
#pragma unroll
                for (int sp = 0; sp < 8; ++sp) a += *(const f32x4*)(part + (size_t)sp * MS * D + i * 256 + lane * 4);
                v[i] += *(const f32x4*)(g1 + i * 256 + lane * 4) * a; *(f32x4*)(outp + (size_t)m * D + i * 256 + lane * 4) = v[i]; }
        }
        float ss = 0.f;
#pragma unroll
        for (int i = 0; i < 8; ++i) ss += v[i][0] * v[i][0] + v[i][1] * v[i][1] + v[i][2] * v[i][2] + v[i][3] * v[i][3];
#pragma unroll
        for (int o = 32; o >= 1; o >>= 1) ss += __shfl_xor(ss, o);
        const float rstd = rsqrtf(ss * (1.0f / D) + EPS);
#pragma unroll
        for (int i = 0; i < 8; ++i) { const int c = i * 256 + lane * 4;
            const f32x4 h = (v[i] * rstd * wv[i]) * (scl[i] + 1.0f) + sh[i]; u32x2 o; o.x = cvt_pk_bf16(h[0], h[1]); o.y = cvt_pk_bf16(h[2], h[3]); *(u32x2*)(H + (size_t)m * D + c) = o; }
#pragma unroll
        for (int i = 0; i < 8; ++i) v[i] = vn[i];
        m = mn;
    }
}

__device__ __forceinline__ void team_bar(unsigned* cnt, unsigned& target) {
    target += 4u;
    __builtin_amdgcn_fence(__ATOMIC_RELEASE, "workgroup");
    if ((threadIdx.x & 63) == 0) (void)__hip_atomic_fetch_add(cnt, 1u, __ATOMIC_RELAXED, __HIP_MEMORY_SCOPE_WORKGROUP);
    while (__hip_atomic_load(cnt, __ATOMIC_RELAXED, __HIP_MEMORY_SCOPE_WORKGROUP) < target) __builtin_amdgcn_s_sleep(1);
    __builtin_amdgcn_fence(__ATOMIC_ACQUIRE, "workgroup");
}
constexpr int TEAM_LDS = 81920;
__device__ __forceinline__ void gdn_prep(PP p, int item, unsigned char* tl  , unsigned* cnt, unsigned& bt) {
    const int b = item >> 9, h = (item >> 6) & 7, n = item & 63;
    int lt_ = threadIdx.x & 255; asm volatile("" : "+v"(lt_));
    const int lt = lt_, lane = lt & 63, lw = __builtin_amdgcn_readfirstlane(lt >> 6);
    const bf16_t* PROJ = (const bf16_t*)(p->ws + WS_PROJ); const float* AB = (const float*)(p->ws + WS_AB);
    unsigned char* rec = p->ws + WS_GDN + (size_t)item * CH_BYTES;
    const int m0 = b * LP + n * 64;
    bf16_t* QH = (bf16_t*)tl;
    bf16_t* KH = QH + 64 * 136;
    float* GC = (float*)(tl + 34816);
    float* BETA = GC + 64; float* EG = GC + 128; float* BEG = GC + 192;
    bf16_t* QKF = (bf16_t*)(tl + 36864);
    bf16_t* VH = (bf16_t*)(tl + 45056);
    float* AM = (float*)(tl + 62464);
    bf16_t* XS = (bf16_t*)(tl + 45056);
    team_bar(cnt, bt);
    if (lw == 0) {
        const float a = AB[(size_t)(m0 + lane) * 16 + h], bb = AB[(size_t)(m0 + lane) * 16 + 8 + h];
        float g = -__expf(p->in[15][h]) * softplus_f(a + p->in[16][h]);
        float gc = g;
#pragma unroll
        for (int o = 1; o < 64; o <<= 1) { const float t = __shfl_up(gc, o); if (lane >= o) gc += t; }
        const float be = sigmoid_f(bb), eg = __expf(gc);
        GC[lane] = gc; BETA[lane] = be; EG[lane] = eg; BEG[lane] = be * eg;
        if (lane == 63) *(float*)(rec + CH_GL) = eg;
    }
    {
        const float* cw = p->in[14];
#pragma unroll 1
        for (int pass = 0; pass < 2; ++pass) {
            const int slot = pass * 256 + lt, r = slot >> 3, cg = slot & 7; const int t = n * 64 + r;
            u32x4 raw[3][4][2];
#pragma unroll
            for (int which = 0; which < 3; ++which)
#pragma unroll
                for (int i = 0; i < 4; ++i) { const int dr = (t - 3 + i >= 0) ? (r - 3 + i) : r; const bf16_t* src = PROJ + (size_t)(m0 + dr) * NPROJ + which * 1024 + h * 128 + cg * 16;
                    raw[which][i][0] = *(const u32x4*)src; raw[which][i][1] = *(const u32x4*)(src + 8); }
#pragma unroll
            for (int which = 0; which < 3; ++which) {
                const int col = which * 1024 + h * 128 + cg * 16;
                float y[16];
#pragma unroll
                for (int j = 0; j < 16; ++j) y[j] = 0.f;
#pragma unroll
                for (int i = 0; i < 4; ++i) {
                    const float keep = (t - 3 + i >= 0) ? 1.0f : 0.0f;
                    float x[16]; unpack8(raw[which][i][0], x); unpack8(raw[which][i][1], x + 8);
#pragma unroll
                    for (int q = 0; q < 4; ++q) { const f32x4 w = *(const f32x4*)(cw + i * 3072 + col + q * 4) * keep;
#pragma unroll
                        for (int j = 0; j < 4; ++j) y[q * 4 + j] += w[j] * x[q * 4 + j]; }
                }
                float ss = 0.f;
#pragma unroll
                for (int j = 0; j < 16; ++j) { y[j] = silu_f(y[j]); ss += y[j] * y[j]; }
                float rn = 1.0f;
                if (which < 2) { ss += __shfl_xor(ss, 1); ss += __shfl_xor(ss, 2); ss += __shfl_xor(ss, 4); rn = rsqrtf(ss + EPS) * (which == 0 ? 0.08838834764831845f : 1.0f); }
                u32x4 w0, w1;
                w0.x = cvt_pk_bf16(y[0] * rn, y[1] * rn); w0.y = cvt_pk_bf16(y[2] * rn, y[3] * rn); w0.z = cvt_pk_bf16(y[4] * rn, y[5] * rn); w0.w = cvt_pk_bf16(y[6] * rn, y[7] * rn);
                w1.x = cvt_pk_bf16(y[8] * rn, y[9] * rn); w1.y = cvt_pk_bf16(y[10] * rn, y[11] * rn); w1.z = cvt_pk_bf16(y[12] * rn, y[13] * rn); w1.w = cvt_pk_bf16(y[14] * rn, y[15] * rn);
                bf16_t* dst = (which == 0 ? QH : which == 1 ? KH : VH) + r * 136 + cg * 16;
                *(u32x4*)dst = w0; *(u32x4*)(dst + 8) = w1;
            }
            if (n == 63 && r >= 61) {
                float* pc = p->out + O_PCONV + (size_t)(b * 3 + (r - 61)) * 3072;
#pragma unroll
                for (int which = 0; which < 3; ++which) { const int col = which * 1024 + h * 128 + cg * 16; float x[16]; unpack8(raw[which][3][0], x); unpack8(raw[which][3][1], x + 8);
#pragma unroll
                    for (int j = 0; j < 16; ++j) pc[col + j] = x[j]; }
            }
        }
    }
    team_bar(cnt, bt);
    {
        const int fr = lane & 15, kq = lane >> 4;
#pragma unroll
        for (int rep = 0; rep < 4; ++rep) {
            const int tt = lw + rep * 4, ti = tt >> 2, tj = tt & 3;
            f32x4 ck = {0.f, 0.f, 0.f, 0.f}, cq = {0.f, 0.f, 0.f, 0.f};
            if (tj <= ti) {
#pragma unroll
                for (int kk = 0; kk < 4; ++kk) {
                    const bf16x8 ak = *(const bf16x8*)(KH + (16 * ti + fr) * 136 + kk * 32 + kq * 8);
                    const bf16x8 aq = *(const bf16x8*)(QH + (16 * ti + fr) * 136 + kk * 32 + kq * 8);
                    const bf16x8 bk = *(const bf16x8*)(KH + (16 * tj + fr) * 136 + kk * 32 + kq * 8);
                    ck = __builtin_amdgcn_mfma_f32_16x16x32_bf16(ak, bk, ck, 0, 0, 0);
                    cq = __builtin_amdgcn_mfma_f32_16x16x32_bf16(aq, bk, cq, 0, 0, 0);
                }
            }
            const int j = 16 * tj + fr; const float gj = GC[j];
            const int cc = 16 * (tj & 1) + fr; const int kqp = (cc & 15) >> 2, jp = (cc & 3) + (cc >= 16 ? 4 : 0), kc = tj >> 1;
#pragma unroll
            for (int r = 0; r < 4; ++r) {
                const int i = 16 * ti + 4 * kq + r; const float dec = __expf(GC[i] - gj);
                AM[i * 68 + j] = (i > j) ? BETA[i] * dec * ck[r] : 0.f;
                const float qv = (i >= j) ? dec * cq[r] : 0.f;
                const int L = (4 * kq + r) + 16 * kqp;
                QKF[((ti * 2 + kc) * 64 + L) * 8 + jp] = (bf16_t)(cvt_pk_bf16(qv, 0.f) & 0xffffu);
            }
        }
    }
    team_bar(cnt, bt);
    float x[64];
    {
        const int c = lt;
        int zv; asm volatile("v_mov_b32 %0, 0" : "=v"(zv));
        const float* AMv = AM + zv; const float* SCL = (c < 128 ? BETA : BEG) + zv; const bf16_t* R = (c < 128 ? VH : KH) + (c & 127);
        f32x4 amc[16], amn[8];
        float rc = bf2f(R[0]) * SCL[0], rn = 0.f;
#pragma unroll
        for (int i = 0; i < 64; ++i) {
            __builtin_amdgcn_sched_barrier(0);
#pragma unroll
            for (int jj = 8; jj < (i + 3) / 4; ++jj) amc[jj] = *(const f32x4*)(AMv + i * 68 + jj * 4);
            if (i + 1 < 64) { rn = bf2f(R[(i + 1) * 136]) * SCL[i + 1];
#pragma unroll
                for (int jj = 0; jj < ((i + 4) / 4 < 8 ? (i + 4) / 4 : 8); ++jj) amn[jj] = *(const f32x4*)(AMv + (i + 1) * 68 + jj * 4); }
            float a = rc;
#pragma unroll
            for (int jj = 0; jj < (i + 3) / 4; ++jj) {
#pragma unroll
                for (int q = 0; q < 4; ++q) if (jj * 4 + q < i) asm("v_fma_f32 %0, -%1, %2, %0" : "+v"(a) : "v"(amc[jj][q]), "v"(x[jj * 4 + q])); }
            x[i] = a;
            rc = rn;
#pragma unroll
            for (int jj = 0; jj < 8; ++jj) amc[jj] = amn[jj];
        }
    }
    team_bar(cnt, bt);
#pragma unroll
    for (int i = 0; i < 64; ++i) XS[i * 264 + lt] = (bf16_t)(cvt_pk_bf16(x[i], 0.f) & 0xffffu);
    team_bar(cnt, bt);
    {
        const int L = lane, mrow = L & 15, kqp = L >> 4;
        const float g63 = GC[63];
#pragma unroll
        for (int rnd = 0; rnd < 4; ++rnd) { const int f = rnd * 4 + lw, mt = f >> 2, kk = f & 3; const int c = 16 * mt + mrow;
            const u32x2 lo = *(const u32x2*)(XS + c * 264 + 128 + 32 * kk + 4 * kqp), hi = *(const u32x2*)(XS + c * 264 + 128 + 32 * kk + 16 + 4 * kqp);
            u32x4 w; w.x = lo.x; w.y = lo.y; w.z = hi.x; w.w = hi.y;
            *(u32x4*)(rec + CH_W + (size_t)f * 1024 + L * 16) = w; }
#pragma unroll
        for (int rnd = 0; rnd < 2; ++rnd) { const int slot = rnd * 256 + lt, dv = slot >> 2, cs = slot & 3; unsigned pk[8];
#pragma unroll
            for (int q = 0; q < 8; ++q) { const unsigned lo = XS[(16 * cs + 2 * q) * 264 + dv], hi = XS[(16 * cs + 2 * q + 1) * 264 + dv]; pk[q] = lo | (hi << 16); }
            u32x4 w0, w1; w0.x = pk[0]; w0.y = pk[1]; w0.z = pk[2]; w0.w = pk[3]; w1.x = pk[4]; w1.y = pk[5]; w1.z = pk[6]; w1.w = pk[7];
            bf16_t* ut = (bf16_t*)(rec + CH_UT) + dv * 64 + cs * 16; *(u32x4*)ut = w0; *(u32x4*)(ut + 8) = w1; }
#pragma unroll
        for (int rnd = 0; rnd < 4; ++rnd) {
            const int f = rnd * 4 + lw, mt = f >> 2, kk = f & 3; const int c = 16 * mt + mrow; const float e = EG[c];
            const u32x2 lo = *(const u32x2*)(QH + c * 136 + 32 * kk + 4 * kqp), hi = *(const u32x2*)(QH + c * 136 + 32 * kk + 16 + 4 * kqp);
            u32x4 w; w.x = cvt_pk_bf16(bf_lo(lo.x) * e, bf_hi(lo.x) * e); w.y = cvt_pk_bf16(bf_lo(lo.y) * e, bf_hi(lo.y) * e); w.z = cvt_pk_bf16(bf_lo(hi.x) * e, bf_hi(hi.x) * e); w.w = cvt_pk_bf16(bf_lo(hi.y) * e, bf_hi(hi.y) * e);
            *(u32x4*)(rec + CH_QG + (size_t)f * 1024 + L * 16) = w;
        }
#pragma unroll
        for (int rnd = 0; rnd < 4; ++rnd) {
            const int f = rnd * 4 + lw, d = f >> 1, kc = f & 1; const int dk = 16 * d + mrow;
            float v[8];
#pragma unroll
            for (int j = 0; j < 8; ++j) { const int c = 32 * kc + (j < 4 ? 4 * kqp + j : 16 + 4 * kqp + (j - 4)); v[j] = bf2f(KH[c * 136 + dk]) * __expf(g63 - GC[c]); }
            u32x4 w; w.x = cvt_pk_bf16(v[0], v[1]); w.y = cvt_pk_bf16(v[2], v[3]); w.z = cvt_pk_bf16(v[4], v[5]); w.w = cvt_pk_bf16(v[6], v[7]);
            *(u32x4*)(rec + CH_KD + (size_t)f * 1024 + L * 16) = w;
        }
#pragma unroll
        for (int rnd = 0; rnd < 2; ++rnd) { const int e = rnd * 256 + lt; *(u32x4*)(rec + CH_QK + (size_t)e * 16) = *(const u32x4*)((const unsigned char*)QKF + e * 16); }
    }
}

__device__ __forceinline__ void gdn_sample(PP p, int item, unsigned char* smem) {
    const int b = item >> 3, h = item & 7;
    const int tid = threadIdx.x;
    const bf16_t* PROJ = (const bf16_t*)(p->ws + WS_PROJ); const float* AB = (const float*)(p->ws + WS_AB);
    bf16_t* OM = (bf16_t*)(p->ws + WS_H);
    const int m0 = MP + b * 16;
    float* Q = (float*)smem; float* K = Q + 16 * 128; float* V = K + 16 * 128; float* O = V + 16 * 128;
    float* RED = O + 16 * 128;
    float* RED2 = RED + 4 * 128;
    float* GG = RED2 + 4 * 128;
    __syncthreads();
    if (tid < 16) { const float a = AB[(size_t)(m0 + tid) * 16 + h], bb = AB[(size_t)(m0 + tid) * 16 + 8 + h];
        GG[tid] = __expf(-__expf(p->in[15][h]) * softplus_f(a + p->in[16][h])); GG[16 + tid] = sigmoid_f(bb); }
    {
        const int r = tid >> 5, cg = tid & 31; const float* cw = p->in[14]; const float* st = p->in[2] + (size_t)b * 3 * 3072;
#pragma unroll
        for (int which = 0; which < 3; ++which) {
            const int col = which * 1024 + h * 128 + cg * 4; float y[4] = {0.f, 0.f, 0.f, 0.f};
#pragma unroll
            for (int i = 0; i < 4; ++i) { const int t = r - 3 + i; float x[4];
                const u32x2 vp = *(const u32x2*)(PROJ + (size_t)(m0 + (t >= 0 ? t : 0)) * NPROJ + col); const f32x4 vs = *(const f32x4*)(st + (size_t)(t >= 0 ? 0 : 3 + t) * 3072 + col);
                x[0] = t >= 0 ? bf_lo(vp.x) : vs[0]; x[1] = t >= 0 ? bf_hi(vp.x) : vs[1]; x[2] = t >= 0 ? bf_lo(vp.y) : vs[2]; x[3] = t >= 0 ? bf_hi(vp.y) : vs[3];
                const f32x4 w = *(const f32x4*)(cw + i * 3072 + col);
#pragma unroll
                for (int j = 0; j < 4; ++j) y[j] += w[j] * x[j]; }
            float ss = 0.f;
#pragma unroll
            for (int j = 0; j < 4; ++j) { y[j] = silu_f(y[j]); ss += y[j] * y[j]; }
            float rn = 1.0f;
            if (which < 2) {
#pragma unroll
                for (int o = 1; o < 32; o <<= 1) ss += __shfl_xor(ss, o);
                rn = rsqrtf(ss + EPS) * (which == 0 ? 0.08838834764831845f : 1.0f); }
            float* dst = (which == 0 ? Q : which == 1 ? K : V) + r * 128 + cg * 4;
#pragma unroll
            for (int j = 0; j < 4; ++j) dst[j] = y[j] * rn;
            if (r >= 13) {
                const u32x2 v = *(const u32x2*)(PROJ + (size_t)(m0 + r) * NPROJ + col);
                *(f32x4*)(p->out + O_SCONV + (size_t)(b * 3 + r - 13) * 3072 + col) = (f32x4){bf_lo(v.x), bf_hi(v.x), bf_lo(v.y), bf_hi(v.y)}; }
        }
    }
    const int dv = tid & 127, kg = tid >> 7;
    float S[32];
    const float* s0 = p->in[3] + ((size_t)(b * 8 + h) * 128 + kg * 32) * 128 + dv;
#pragma unroll
    for (int i = 0; i < 32; ++i) S[i] = s0[(size_t)i * 128];
    __syncthreads();
    for (int t = 0; t < 16; ++t) {
        const float a = GG[t], be = GG[16 + t]; float part = 0.f;
#pragma unroll
        for (int i = 0; i < 32; ++i) { S[i] *= a; part += K[t * 128 + kg * 32 + i] * S[i]; }
        RED[kg * 128 + dv] = part;
        __syncthreads();
        const float ks = RED[dv] + RED[128 + dv] + RED[256 + dv] + RED[384 + dv];
        const float rr = be * (V[t * 128 + dv] - ks); float po = 0.f;
#pragma unroll
        for (int i = 0; i < 32; ++i) { S[i] += K[t * 128 + kg * 32 + i] * rr; po += Q[t * 128 + kg * 32 + i] * S[i]; }
        RED2[kg * 128 + dv] = po;
        __syncthreads();
        if (kg == 0) O[t * 128 + dv] = RED2[dv] + RED2[128 + dv] + RED2[256 + dv] + RED2[384 + dv];
    }
    float* sd = p->out + O_SDELTA + ((size_t)(b * 8 + h) * 128 + kg * 32) * 128 + dv;
#pragma unroll
    for (int i = 0; i < 32; ++i) sd[(size_t)i * 128] = S[i];
    __syncthreads();
    {
        const int r = tid >> 5, cg = tid & 31; const f32x4 o = *(const f32x4*)(O + r * 128 + cg * 4);
        float ss = o[0] * o[0] + o[1] * o[1] + o[2] * o[2] + o[3] * o[3];
#pragma unroll
        for (int of = 1; of < 32; of <<= 1) ss += __shfl_xor(ss, of);
        const float rs = rsqrtf(ss * (1.0f / 128.f) + EPS); const f32x4 w = *(const f32x4*)(p->in[17] + cg * 4);
        const u32x2 zz = *(const u32x2*)(PROJ + (size_t)(m0 + r) * NPROJ + 3072 + h * 128 + cg * 4);
        const float z[4] = {bf_lo(zz.x), bf_hi(zz.x), bf_lo(zz.y), bf_hi(zz.y)};
        u32x2 ow; ow.x = cvt_pk_bf16(o[0] * rs * w[0] * silu_f(z[0]), o[1] * rs * w[1] * silu_f(z[1])); ow.y = cvt_pk_bf16(o[2] * rs * w[2] * silu_f(z[2]), o[3] * rs * w[3] * silu_f(z[3]));
        *(u32x2*)(OM + (size_t)(m0 + r) * D + h * 128 + cg * 4) = ow;
    }
}

template <int NT  , bool SAMPLE>
__device__ __forceinline__ void swa_item(PP p, int b, int n, int hk, unsigned char* smem) {
    constexpr int SPAN = SAMPLE ? 144 : 192, NQ = SAMPLE ? 16 : 64, VP = NT * 16 + 8;
    const int tid = threadIdx.x, lane = tid & 63, wave = tid >> 6, fr = lane & 15, kq = lane >> 4;
    const bf16_t* PROJ = (const bf16_t*)(p->ws + WS_PROJ); bf16_t* OM = (bf16_t*)(p->ws + WS_H);
    bf16_t* KS = (bf16_t*)smem;
    bf16_t* VT = KS + NT * 16 * 136;
    const int mq0 = SAMPLE ? MP + b * 16 : b * LP + n * 64;
    const float* knw = p->in[19];
    __syncthreads();
    u32x4 kraw[3][2], vraw[3][2];
    if (!SAMPLE) {
#pragma unroll
        for (int pass = 0; pass < 3; ++pass) {
            { const int t = n * 64 - 128 + pass * 64 + (tid >> 3); const bf16_t* src = PROJ + (size_t)(b * LP + (t > 0 ? t : 0)) * NPROJ + 5120 + hk * 128 + (tid & 7) * 16; kraw[pass][0] = *(const u32x4*)src; kraw[pass][1] = *(const u32x4*)(src + 8); }
            { const int t = n * 64 - 128 + pass * 64 + lane; const bf16_t* src = PROJ + (size_t)(b * LP + (t > 0 ? t : 0)) * NPROJ + 5376 + hk * 128 + wave * 16; vraw[pass][0] = *(const u32x4*)src; vraw[pass][1] = *(const u32x4*)(src + 8); }
        }
    }
#pragma unroll
    for (int pass = 0; pass < (NT * 16) / 64 + ((NT * 16) % 64 ? 1 : 0); ++pass) {
        const int key = pass * 64 + (tid >> 3), cg = tid & 7;
        if (key < NT * 16) {
            float x[16]; bool valid = key < SPAN; bool fresh = false; int srow = 0;
            if (SAMPLE) { if (key >= 128) { fresh = true; srow = mq0 + key - 128; } }
            else { const int t = n * 64 - 128 + key; valid = valid && t >= 0; fresh = true; srow = b * LP + t; }
            if (!valid) {
#pragma unroll
                for (int j = 0; j < 16; ++j) x[j] = 0.f;
            } else if (fresh) {
                if (SAMPLE) { const bf16_t* src = PROJ + (size_t)srow * NPROJ + 5120 + hk * 128 + cg * 16; unpack8(*(const u32x4*)src, x); unpack8(*(const u32x4*)(src + 8), x + 8); }
                else { unpack8(kraw[pass][0], x); unpack8(kraw[pass][1], x + 8); }
                float ss = 0.f;
#pragma unroll
                for (int j = 0; j < 16; ++j) ss += x[j] * x[j];
                ss += __shfl_xor(ss, 1); ss += __shfl_xor(ss, 2); ss += __shfl_xor(ss, 4);
                const float rs = rsqrtf(ss * (1.0f / 128.f) + EPS);
#pragma unroll
                for (int j = 0; j < 16; ++j) x[j] = x[j] * rs * knw[cg * 16 + j];
            } else {
                const float* src = p->in[4] + ((size_t)(b * 128 + key) * 2 + hk) * 128 + cg * 16;
#pragma unroll
                for (int q = 0; q < 4; ++q) { const f32x4 v = *(const f32x4*)(src + q * 4); x[q * 4] = v[0]; x[q * 4 + 1] = v[1]; x[q * 4 + 2] = v[2]; x[q * 4 + 3] = v[3]; }
            }
            u32x4 w0, w1;
            w0.x = cvt_pk_bf16(x[0], x[1]); w0.y = cvt_pk_bf16(x[2], x[3]); w0.z = cvt_pk_bf16(x[4], x[5]); w0.w = cvt_pk_bf16(x[6], x[7]);
            w1.x = cvt_pk_bf16(x[8], x[9]); w1.y = cvt_pk_bf16(x[10], x[11]); w1.z = cvt_pk_bf16(x[12], x[13]); w1.w = cvt_pk_bf16(x[14], x[15]);
            *(u32x4*)(KS + key * 136 + cg * 16) = w0; *(u32x4*)(KS + key * 136 + cg * 16 + 8) = w1;
            float* dst = nullptr;
            if (SAMPLE) { if (key >= 16 && key < 144) dst = p->out + O_SK + ((size_t)(b * 128 + key - 16) * 2 + hk) * 128 + cg * 16; }
            else { if (n >= 62 && key >= 128) dst = p->out + O_PK + ((size_t)(b * 128 + (n - 62) * 64 + key - 128) * 2 + hk) * 128 + cg * 16; }
            if (dst) {
#pragma unroll
                for (int q = 0; q < 4; ++q) *(f32x4*)(dst + q * 4) = (f32x4){x[q * 4], x[q * 4 + 1], x[q * 4 + 2], x[q * 4 + 3]}; }
        }
    }
#pragma unroll
    for (int pass = 0; pass < (NT * 16) / 64 + ((NT * 16) % 64 ? 1 : 0); ++pass) {
        const int key = pass * 64 + lane, cg = wave;
        if (key < NT * 16) {
            float x[16]; bool valid = key < SPAN; bool fresh = false; int srow = 0;
            if (SAMPLE) { if (key >= 128) { fresh = true; srow = mq0 + key - 128; } }
            else { const int t = n * 64 - 128 + key; valid = valid && t >= 0; fresh = true; srow = b * LP + t; }
            if (!valid) {
#pragma unroll
                for (int j = 0; j < 16; ++j) x[j] = 0.f;
            } else if (fresh) { if (SAMPLE) { const bf16_t* src = PROJ + (size_t)srow * NPROJ + 5376 + hk * 128 + cg * 16; unpack8(*(const u32x4*)src, x); unpack8(*(const u32x4*)(src + 8), x + 8); } else { unpack8(vraw[pass][0], x); unpack8(vraw[pass][1], x + 8); } }
            else { const float* src = p->in[5] + ((size_t)(b * 128 + key) * 2 + hk) * 128 + cg * 16;
#pragma unroll
                for (int q = 0; q < 4; ++q) { const f32x4 v = *(const f32x4*)(src + q * 4); x[q * 4] = v[0]; x[q * 4 + 1] = v[1]; x[q * 4 + 2] = v[2]; x[q * 4 + 3] = v[3]; } }
#pragma unroll
            for (int j = 0; j < 16; ++j) VT[(cg * 16 + j) * VP + key] = (bf16_t)(cvt_pk_bf16(x[j], 0.f) & 0xffffu);
            float* dst = nullptr;
            if (SAMPLE) { if (key >= 16 && key < 144) dst = p->out + O_SV + ((size_t)(b * 128 + key - 16) * 2 + hk) * 128 + cg * 16; }
            else { if (n >= 62 && key >= 128) dst = p->out + O_PV + ((size_t)(b * 128 + (n - 62) * 64 + key - 128) * 2 + hk) * 128 + cg * 16; }
            if (dst) {
#pragma unroll
                for (int q = 0; q < 4; ++q) *(f32x4*)(dst + q * 4) = (f32x4){x[q * 4], x[q * 4 + 1], x[q * 4 + 2], x[q * 4 + 3]}; }
        }
    }
    __syncthreads();
    if (wave * 32 < NQ * 4) {
        const float* qnw = p->in[18];
        int hq[2], mrow[2], iq[2]; float slope[2], sink[2];
        bf16x8 QF[2][4];
#pragma unroll
        for (int nt2 = 0; nt2 < 2; ++nt2) {
            const int rho = wave * 32 + nt2 * 16 + fr; const int g = rho / NQ; iq[nt2] = rho % NQ; hq[nt2] = hk * 4 + g; mrow[nt2] = mq0 + iq[nt2];
            slope[nt2] = exp2f(-(float)(hq[nt2] + 1)); sink[nt2] = p->in[20][hq[nt2]];
        }
        { u32x4 qr[2][4];
#pragma unroll
          for (int nt2 = 0; nt2 < 2; ++nt2)
#pragma unroll
              for (int kk = 0; kk < 4; ++kk) qr[nt2][kk] = *(const u32x4*)(PROJ + (size_t)mrow[nt2] * NPROJ + 4096 + hq[nt2] * 128 + kk * 32 + kq * 8);
#pragma unroll
          for (int nt2 = 0; nt2 < 2; ++nt2) { float qx[4][8]; float ss = 0.f;
#pragma unroll
              for (int kk = 0; kk < 4; ++kk) { unpack8(qr[nt2][kk], qx[kk]);
#pragma unroll
                  for (int j = 0; j < 8; ++j) ss += qx[kk][j] * qx[kk][j]; }
              ss += __shfl_xor(ss, 16); ss += __shfl_xor(ss, 32);
              const float sc = rsqrtf(ss * (1.0f / 128.f) + EPS) * 0.08838834764831845f;
#pragma unroll
              for (int kk = 0; kk < 4; ++kk) { float w[8];
#pragma unroll
                  for (int j = 0; j < 8; ++j) w[j] = qx[kk][j] * sc * qnw[kk * 32 + kq * 8 + j];
                  u32x4 pk; pk.x = cvt_pk_bf16(w[0], w[1]); pk.y = cvt_pk_bf16(w[2], w[3]); pk.z = cvt_pk_bf16(w[4], w[5]); pk.w = cvt_pk_bf16(w[6], w[7]); QF[nt2][kk] = as_bf16x8(pk); } } }
        bf16x8 PB[2][NT / 2];
#pragma unroll
        for (int nt2 = 0; nt2 < 2; ++nt2) {
            f32x4 st[NT]; float mx = sink[nt2];
#pragma unroll
            for (int mt = 0; mt < NT; mt += 2) {
                __builtin_amdgcn_sched_barrier(0);
                f32x4 a0 = {0.f, 0.f, 0.f, 0.f}, a1 = {0.f, 0.f, 0.f, 0.f};
#pragma unroll
                for (int kk = 0; kk < 4; ++kk) { const bf16x8 k0 = *(const bf16x8*)(KS + (16 * mt + fr) * 136 + kk * 32 + kq * 8), k1 = *(const bf16x8*)(KS + (16 * mt + 16 + fr) * 136 + kk * 32 + kq * 8);
                    a0 = __builtin_amdgcn_mfma_f32_16x16x32_bf16(k0, QF[nt2][kk], a0, 0, 0, 0); a1 = __builtin_amdgcn_mfma_f32_16x16x32_bf16(k1, QF[nt2][kk], a1, 0, 0, 0); }
                int ib = iq[nt2] + 128 - 4 * kq; asm volatile("" : "+v"(ib));
#pragma unroll
                for (int r = 0; r < 4; ++r) { const int key = 16 * mt + 4 * kq + r; bool v0 = key < SPAN, v1 = key + 16 < SPAN; if (!SAMPLE) { v0 = v0 && (n * 64 - 128 + key >= 0); v1 = v1 && (n * 64 - 112 + key >= 0); }
                    const float s0 = v0 ? a0[r] - slope[nt2] * fabsf((float)(ib - (16 * mt + r))) : -INFINITY, s1 = v1 ? a1[r] - slope[nt2] * fabsf((float)(ib - (16 * mt + 16 + r))) : -INFINITY;
                    a0[r] = s0; a1[r] = s1; mx = fmaxf(mx, fmaxf(s0, s1)); }
                st[mt] = a0; st[mt + 1] = a1;
            }
            __builtin_amdgcn_sched_barrier(0);
            mx = fmaxf(mx, __shfl_xor(mx, 16)); mx = fmaxf(mx, __shfl_xor(mx, 32));
            float sum = 0.f;
#pragma unroll
            for (int mt = 0; mt < NT; ++mt)
#pragma unroll
                for (int r = 0; r < 4; ++r) { const float e = __expf(st[mt][r] - mx); st[mt][r] = e; sum += e; }
            sum += __shfl_xor(sum, 16); sum += __shfl_xor(sum, 32);
            const float inv = __builtin_amdgcn_rcpf(sum + __expf(sink[nt2] - mx));
#pragma unroll
            for (int kc = 0; kc < NT / 2; ++kc) { u32x4 pk; pk.x = cvt_pk_bf16(st[2 * kc][0] * inv, st[2 * kc][1] * inv); pk.y = cvt_pk_bf16(st[2 * kc][2] * inv, st[2 * kc][3] * inv);
                pk.z = cvt_pk_bf16(st[2 * kc + 1][0] * inv, st[2 * kc + 1][1] * inv); pk.w = cvt_pk_bf16(st[2 * kc + 1][2] * inv, st[2 * kc + 1][3] * inv); PB[nt2][kc] = as_bf16x8(pk); }
        }
#pragma unroll
        for (int dt = 0; dt < 8; ++dt) {
            __builtin_amdgcn_sched_barrier(0);
            f32x4 o0 = {0.f, 0.f, 0.f, 0.f}, o1 = {0.f, 0.f, 0.f, 0.f};
#pragma unroll
            for (int kc = 0; kc < NT / 2; ++kc) { const u32x2 lo = *(const u32x2*)(VT + (16 * dt + fr) * VP + 32 * kc + 4 * kq), hi = *(const u32x2*)(VT + (16 * dt + fr) * VP + 32 * kc + 16 + 4 * kq);
                u32x4 va; va.x = lo.x; va.y = lo.y; va.z = hi.x; va.w = hi.y;
                o0 = __builtin_amdgcn_mfma_f32_16x16x32_bf16(as_bf16x8(va), PB[0][kc], o0, 0, 0, 0); o1 = __builtin_amdgcn_mfma_f32_16x16x32_bf16(as_bf16x8(va), PB[1][kc], o1, 0, 0, 0); }
            u32x2 ow; ow.x = cvt_pk_bf16(o0[0], o0[1]); ow.y = cvt_pk_bf16(o0[2], o0[3]);
            *(u32x2*)(OM + (size_t)mrow[0] * D + 1024 + hq[0] * 128 + 16 * dt + 4 * kq) = ow;
            ow.x = cvt_pk_bf16(o1[0], o1[1]); ow.y = cvt_pk_bf16(o1[2], o1[3]);
            *(u32x2*)(OM + (size_t)mrow[1] * D + 1024 + hq[1] * 128 + 16 * dt + 4 * kq) = ow;
        }
    }
}

__device__ __forceinline__ void phase3(PP p, unsigned char* smem) {
#ifndef P3_MASK
#define P3_MASK 15
#endif
    const int bid = blockIdx.x, G = gridDim.x;
#ifndef P3_REP
#define P3_REP 0
#endif
    if (P3_MASK & 1) {
        unsigned* cnt = (unsigned*)(smem + 36352) ;
        if (threadIdx.x < 2) cnt[threadIdx.x] = 0u;
        __syncthreads();
        const int team = threadIdx.x >> 8; unsigned bt = 0u;
        for (int r_ = 0; r_ < 1 + (P3_REP & 1); ++r_) for (int it = bid + G * team; it < 2048; it += 2 * G) gdn_prep(p, it, smem + team * TEAM_LDS, cnt + team, bt);
        __syncthreads();
    }
    if (P3_MASK & 2) for (int r_ = 0; r_ < 1 + ((P3_REP >> 1) & 1); ++r_) for (int v = bid; v < 512; v += G) { const int u = (G == 256) ? (v & 7) * 64 + ((v >> 3) & 31) + 32 * (v >> 8) : v;
        swa_item<12, false>(p, u >> 7, (u >> 1) & 63, u & 1, smem); }
    if ((P3_MASK & 4) && G != 256) for (int u = bid; u < 256; u += G) gdn_sample(p, u, smem);
    if (P3_MASK & 8) for (int u = G - 1 - bid; u < 64; u += G) swa_item<10, true>(p, u >> 1, 0, u & 1, smem);
}

__device__ __forceinline__ void scan_chunk(f32x4 (&S)[8], const unsigned char* cur, float gl, bf16_t* op0, int lane, int fr, int kq, int wave) {
#define FRAG(off, f) (*(const bf16x8*)(cur + (off) + (f) * 1024 + lane * 16))
    bf16x8 sB[4];
#pragma unroll
    for (int kk = 0; kk < 4; ++kk) { u32x4 pk; pk.x = cvt_pk_bf16(S[2 * kk][0], S[2 * kk][1]); pk.y = cvt_pk_bf16(S[2 * kk][2], S[2 * kk][3]); pk.z = cvt_pk_bf16(S[2 * kk + 1][0], S[2 * kk + 1][1]); pk.w = cvt_pk_bf16(S[2 * kk + 1][2], S[2 * kk + 1][3]); sB[kk] = as_bf16x8(pk); }
    bf16x8 Wf[16]; u32x2 uu[4];
#pragma unroll
    for (int f = 0; f < 16; ++f) Wf[f] = FRAG(CH_W, f);
#pragma unroll
    for (int mt = 0; mt < 4; ++mt) uu[mt] = *(const u32x2*)(cur + 57344 + (wave * 16 + fr) * 128 + (16 * mt + 4 * kq) * 2);
    __builtin_amdgcn_sched_barrier(0);
    f32x4 P[4], O[4];
#pragma unroll
    for (int mt = 0; mt < 4; ++mt) { P[mt] = (f32x4){0.f, 0.f, 0.f, 0.f}; O[mt] = (f32x4){0.f, 0.f, 0.f, 0.f}; }
    bf16x8 Gf[16];
#pragma unroll
    for (int kk = 0; kk < 4; ++kk) {
#pragma unroll
        for (int mt = 0; mt < 4; ++mt) { P[mt] = __builtin_amdgcn_mfma_f32_16x16x32_bf16(Wf[mt * 4 + kk], sB[kk], P[mt], 0, 0, 0); Gf[kk * 4 + mt] = FRAG(CH_QG, mt * 4 + kk); }
    }
    __builtin_amdgcn_sched_barrier(0);
    bf16x8 Kf[8], Df[16];
#pragma unroll
    for (int kk = 0; kk < 4; ++kk) {
#pragma unroll
        for (int mt = 0; mt < 4; ++mt) { O[mt] = __builtin_amdgcn_mfma_f32_16x16x32_bf16(Gf[kk * 4 + mt], sB[kk], O[mt], 0, 0, 0); if (kk < 2) Kf[kk * 4 + mt] = FRAG(CH_QK, mt * 2 + kk); else Df[(kk - 2) * 4 + mt] = FRAG(CH_KD, (kk - 2) * 4 + mt); }
    }
    f32x4 vn[4];
#pragma unroll
    for (int mt = 0; mt < 4; ++mt) vn[mt] = (f32x4){bf_lo(uu[mt].x) - P[mt][0], bf_hi(uu[mt].x) - P[mt][1], bf_lo(uu[mt].y) - P[mt][2], bf_hi(uu[mt].y) - P[mt][3]};
    bf16x8 vB[2];
#pragma unroll
    for (int kc = 0; kc < 2; ++kc) { u32x4 pk; pk.x = cvt_pk_bf16(vn[2 * kc][0], vn[2 * kc][1]); pk.y = cvt_pk_bf16(vn[2 * kc][2], vn[2 * kc][3]); pk.z = cvt_pk_bf16(vn[2 * kc + 1][0], vn[2 * kc + 1][1]); pk.w = cvt_pk_bf16(vn[2 * kc + 1][2], vn[2 * kc + 1][3]); vB[kc] = as_bf16x8(pk); }
    __builtin_amdgcn_sched_barrier(0);
#pragma unroll
    for (int kc = 0; kc < 2; ++kc) {
#pragma unroll
        for (int mt = 0; mt < 4; ++mt) { O[mt] = __builtin_amdgcn_mfma_f32_16x16x32_bf16(Kf[kc * 4 + mt], vB[kc], O[mt], 0, 0, 0); Df[8 + kc * 4 + mt] = FRAG(CH_KD, 8 + kc * 4 + mt); }
    }
#pragma unroll
    for (int d = 0; d < 8; ++d) S[d] = S[d] * gl;
    __builtin_amdgcn_sched_barrier(0);
#pragma unroll
    for (int kc = 0; kc < 2; ++kc) {
#pragma unroll
        for (int d = 0; d < 8; ++d) S[d] = __builtin_amdgcn_mfma_f32_16x16x32_bf16(Df[d * 2 + kc], vB[kc], S[d], 0, 0, 0);
    }
#pragma unroll
    for (int mt = 0; mt < 4; ++mt) { bf16_t* op = op0 + (size_t)(16 * mt) * D;
#pragma unroll
        for (int r = 0; r < 4; ++r) op[(size_t)r * D] = (bf16_t)(cvt_pk_bf16(O[mt][r], 0.f) & 0xffffu); }
#undef FRAG
}
__device__ __forceinline__ void phase4(PP p, unsigned char* smem) {
    const int tid = threadIdx.x, lane = tid & 63, wave = tid >> 6, fr = lane & 15, kq = lane >> 4;
    bf16_t* OM = (bf16_t*)(p->ws + WS_H);
    constexpr int NCW = 2, NS = 8 / NCW, USL = 2048 * NCW, BUF = 57344 + USL;
    if (gridDim.x == 256 && blockIdx.x >= 128) { const ConvPtrs cp = conv_ptrs(p); gdn_sample(p, (int)blockIdx.x - 128, smem); gdn_sample(p, (int)blockIdx.x, smem); __syncthreads(); convert_seq(cp, 0, 0, (int)blockIdx.x - 128, 128, 512, 0, 3712, (float*)smem); return; }
    for (int item = blockIdx.x; item < 32 * NS; item += gridDim.x) {
        const int xcd = item & 7, iw = item >> 3; const int bh = xcd * 4 + iw / NS, ds = iw % NS; const int b = bh >> 3, h = bh & 7, dvb = ds * 16 * NCW, dv0 = dvb + (wave < NCW ? wave : 0) * 16;
        const unsigned char* rec0 = p->ws + WS_GDN + (size_t)(bh * 64) * CH_BYTES;
        f32x4 S[8];
#pragma unroll
        for (int d = 0; d < 8; ++d) S[d] = (f32x4){0.f, 0.f, 0.f, 0.f};
        u32x4 sa[8], sb[8];
#define SC_LOAD(st, c) do { const unsigned char* r_ = rec0 + (size_t)(c) * CH_BYTES; _Pragma("unroll") for (int i = 0; i < 7; ++i) st[i] = *(const u32x4*)(r_ + (size_t)(i * 512 + tid) * 16); \
        if (tid < 128 * NCW) st[7] = *(const u32x4*)(r_ + CH_UT + (size_t)dvb * 128 + tid * 16); } while (0)
#define SC_STORE(st, buf) do { unsigned char* d_ = smem + (buf) * BUF; _Pragma("unroll") for (int i = 0; i < 7; ++i) *(u32x4*)(d_ + (size_t)(i * 512 + tid) * 16) = st[i]; \
        if (tid < 128 * NCW) *(u32x4*)(d_ + 57344 + tid * 16) = st[7]; } while (0)
        __syncthreads();
        const int glv = __builtin_bit_cast(int, *(const float*)(rec0 + (size_t)lane * CH_BYTES + CH_GL));
        SC_LOAD(sa, 0); SC_LOAD(sb, 1);
        SC_STORE(sa, 0);
        __syncthreads();
        bf16_t* opb = OM + (size_t)(b * LP + 4 * kq) * D + h * 128 + dv0 + fr;
        for (int n = 0; n < 64; n += 2) {
            if (n + 2 < 64) SC_LOAD(sa, n + 2);
            if (wave < NCW) scan_chunk(S, smem, __builtin_bit_cast(float, __builtin_amdgcn_readlane(glv, n)), opb + (size_t)(n * 64) * D, lane, fr, kq, wave);
            SC_STORE(sb, 1);
            __syncthreads();
            if (n + 3 < 64) SC_LOAD(sb, n + 3);
            if (wave < NCW) scan_chunk(S, smem + BUF, __builtin_bit_cast(float, __builtin_amdgcn_readlane(glv, n + 1)), opb + (size_t)((n + 1) * 64) * D, lane, fr, kq, wave);
            if (n + 2 < 64) SC_STORE(sa, 0);
            __syncthreads();
        }
#undef SC_LOAD
#undef SC_STORE
        if (wave < NCW) {
            float* pd = p->out + O_PDELTA + (size_t)bh * 128 * 128;
#pragma unroll
            for (int d = 0; d < 8; ++d)
#pragma unroll
                for (int r = 0; r < 4; ++r) pd[(size_t)(16 * d + 4 * kq + r) * 128 + dv0 + fr] = S[d][r];
        }
    }
}

__device__ __forceinline__ void phase5(PP p) {
    const bf16_t* PROJ = (const bf16_t*)(p->ws + WS_PROJ); bf16_t* OM = (bf16_t*)(p->ws + WS_H);
    const int tid = threadIdx.x, sub = tid & 15, grp = tid >> 4;
    const float* gw = p->in[17];
    for (int pr = blockIdx.x * 32 + grp; pr < MP * 8; pr += gridDim.x * 32) {
        const int m = pr >> 3, h = pr & 7;
        bf16_t* op = OM + (size_t)m * D + h * 128 + sub * 8;
        float o[8], z[8]; unpack8(*(const u32x4*)op, o); unpack8(*(const u32x4*)(PROJ + (size_t)m * NPROJ + 3072 + h * 128 + sub * 8), z);
        float ss = 0.f;
#pragma unroll
        for (int j = 0; j < 8; ++j) ss += o[j] * o[j];
        ss += __shfl_xor(ss, 1); ss += __shfl_xor(ss, 2); ss += __shfl_xor(ss, 4); ss += __shfl_xor(ss, 8);
        const float rs = rsqrtf(ss * (1.0f / 128.f) + EPS);
        float w[8];
#pragma unroll
        for (int j = 0; j < 8; ++j) w[j] = o[j] * rs * gw[sub * 8 + j] * silu_f(z[j]);
        u32x4 pk; pk.x = cvt_pk_bf16(w[0], w[1]); pk.y = cvt_pk_bf16(w[2], w[3]); pk.z = cvt_pk_bf16(w[4], w[5]); pk.w = cvt_pk_bf16(w[6], w[7]);
        *(u32x4*)op = pk;
    }
}

__device__ __forceinline__ void phase9(PP p) {
    const float* HEAD = (const float*)(p->ws + WS_HEAD); const float* HALO = (const float*)(p->ws + WS_HALO); const float* US = (const float*)(p->ws + WS_US);
    bf16_t* ACT = (bf16_t*)(p->ws + WS_PROJ); const float* cw = p->in[23]; const float* cb = p->in[24]; const float* st = p->in[6]; float* outp = p->out;
    const int gt = blockIdx.x * NTHR + threadIdx.x, gs = gridDim.x * NTHR;
    constexpr int FQ = FF / 4, FQ2 = FF2 / 4;
    const f32x4 z4 = {0.f, 0.f, 0.f, 0.f};
    for (int e = gt; e < 256 * 2 * FQ; e += gs) {
        const int c = (e % FQ) * 4, rr = (e / FQ) & 1, blk = e / (2 * FQ);
        const bool first = (blk & 63) == 0;
        f32x4 uc[2];
#pragma unroll
        for (int s = 0; s < 2; ++s) { const int cu = c + s * FF;
            const f32x4 u0 = *(const f32x4*)(HEAD + (size_t)(blk * 2 + rr) * FF2 + cu);
            const float* h1 = first ? HEAD : HALO + (size_t)((blk - 1) * 2 + 1) * FF2; const float* h0 = first ? HEAD : HALO + (size_t)((blk - 1) * 2) * FF2;
            const f32x4 a1 = *(const f32x4*)(h1 + cu), a0 = *(const f32x4*)(h0 + cu), hd0 = *(const f32x4*)(HEAD + (size_t)(blk * 2) * FF2 + cu);
            const f32x4 u1 = rr == 0 ? (first ? z4 : a1) : hd0;
            const f32x4 u2 = rr == 0 ? (first ? z4 : a0) : (first ? z4 : a1);
            uc[s] = *(const f32x4*)(cw + 2 * FF2 + cu) * u0 + *(const f32x4*)(cw + FF2 + cu) * u1 + *(const f32x4*)(cw + cu) * u2 + *(const f32x4*)(cb + cu); }
        u32x2 w; w.x = cvt_pk_bf16(silu_f(uc[0][0]) * uc[1][0], silu_f(uc[0][1]) * uc[1][1]); w.y = cvt_pk_bf16(silu_f(uc[0][2]) * uc[1][2], silu_f(uc[0][3]) * uc[1][3]);
        *(u32x2*)(ACT + (size_t)(blk * 64 + rr) * FF + c) = w;
    }
    for (int e = gt; e < MS * FQ; e += gs) {
        const int c = (e % FQ) * 4, row = e / FQ, b = row >> 4, t = row & 15;
        f32x4 uc[2];
#pragma unroll
        for (int s = 0; s < 2; ++s) { const int cu = c + s * FF;
            const f32x4 u0 = *(const f32x4*)(US + (size_t)row * FF2 + cu);
            const f32x4 u1 = *(const f32x4*)((t >= 1 ? US + (size_t)(row - 1) * FF2 : st + (size_t)(b * 2 + 1) * FF2) + cu);
            const f32x4 u2 = *(const f32x4*)((t >= 2 ? US + (size_t)(row - 2) * FF2 : st + (size_t)(b * 2 + t) * FF2) + cu);
            uc[s] = *(const f32x4*)(cw + 2 * FF2 + cu) * u0 + *(const f32x4*)(cw + FF2 + cu) * u1 + *(const f32x4*)(cw + cu) * u2 + *(const f32x4*)(cb + cu); }
        u32x2 w; w.x = cvt_pk_bf16(silu_f(uc[0][0]) * uc[1][0], silu_f(uc[0][1]) * uc[1][1]); w.y = cvt_pk_bf16(silu_f(uc[0][2]) * uc[1][2], silu_f(uc[0][3]) * uc[1][3]);
        *(u32x2*)(ACT + (size_t)(MP + row) * FF + c) = w;
    }
    for (int e = gt; e < 4 * 2 * FQ2; e += gs) { const int cu = (e % FQ2) * 4, rr = (e / FQ2) & 1, b = e / (2 * FQ2); *(f32x4*)(outp + O_PFFN + (size_t)e * 4) = *(const f32x4*)(HALO + (size_t)((b * 64 + 63) * 2 + rr) * FF2 + cu); }
    for (int e = gt; e < 32 * 2 * FQ2; e += gs) { const int cu = (e % FQ2) * 4, rr = (e / FQ2) & 1, b = e / (2 * FQ2); *(f32x4*)(outp + O_SFFN + (size_t)e * 4) = *(const f32x4*)(US + (size_t)(b * 16 + 14 + rr) * FF2 + cu); }
}

#define XB_TMO      128
#define XB_XCNT(j)  (256  + 64 * (j))
#define XB_XSUB(j)  (1280 + 64 * (j))
#define XB_XGEN(j)  (2304 + 64 * (j))
#define XB_TOP      3328
#define XB_TOPGEN   3392
#define XCD_BAR_WORDS 3456
#define XB_SPIN_CAP (1u << 18)
__device__ __forceinline__ unsigned xb_ld(unsigned* p)              { return __hip_atomic_load(p, __ATOMIC_RELAXED, __HIP_MEMORY_SCOPE_AGENT); }
__device__ __forceinline__ unsigned xb_add(unsigned* p, unsigned v) { return __hip_atomic_fetch_add(p, v, __ATOMIC_RELAXED, __HIP_MEMORY_SCOPE_AGENT); }
__device__ __forceinline__ unsigned xb_xcc_id() { return (unsigned)__builtin_amdgcn_s_getreg((3 << 11) | 20) & 0xFu; }
#define XB_SPIN(cond, bar) do { unsigned _sp = 0; while (cond) { __builtin_amdgcn_s_sleep(1); \
    if ((++_sp & 255u) == 0u) { if (xb_ld(&(bar)[XB_TMO])) break; if (_sp > XB_SPIN_CAP) { atomicAdd(&(bar)[XB_TMO], 1u); break; } } } } while (0)
struct XcdBarrier { unsigned* bar; unsigned x; volatile LAS unsigned* st; };
__device__ __forceinline__ bool sum_ok(unsigned* bar) { return xb_ld(&bar[XB_TMO]) == 0u; }
__device__ __forceinline__ XcdBarrier xcd_barrier_post(unsigned* bar, volatile LAS unsigned* st) {
    XcdBarrier b; b.bar = bar; b.x = xb_xcc_id(); b.st = st;
    if (threadIdx.x == 0) st[2] = xb_add(&bar[XB_XCNT(b.x)], 1u);
    return b;
}
__device__ __forceinline__ void xcd_barrier_complete(unsigned* bar, unsigned x, unsigned& nloc, unsigned& nx, unsigned& all32) {
    const unsigned G = gridDim.x * gridDim.y * gridDim.z;
    unsigned sum, cnt, mine, sp = 0u;
    for (;;) {
        sum = 0u; cnt = 0u; mine = 0u; all32 = 1u;
#pragma unroll
        for (unsigned j = 0; j < 16; ++j) { const unsigned c = xb_ld(&bar[XB_XCNT(j)]); sum += c; cnt += (c > 0u) ? 1u : 0u; mine = (j == x) ? c : mine; if (c != 0u && c != 32u) all32 = 0u; }
        if (sum == G) break;
        __builtin_amdgcn_s_sleep(1);
        if ((++sp & 255u) == 0u) { if (xb_ld(&bar[XB_TMO])) break; if (sp > XB_SPIN_CAP) { atomicAdd(&bar[XB_TMO], 1u); break; } }
    }
    nloc = mine > 0u ? mine : 1u; nx = cnt > 0u ? cnt : 1u;
}
__device__ __forceinline__ void xcd_barrier(const XcdBarrier& b) {
    asm volatile("s_waitcnt vmcnt(0)" ::: "memory");
    __syncthreads();
    if (threadIdx.x == 0) {
        unsigned* bar = b.bar;
        __builtin_amdgcn_s_waitcnt(0);
        unsigned nloc = b.st[0], nx = b.st[1];
        if (nloc == 0u) { unsigned all32 = 0u; xcd_barrier_complete(bar, b.x, nloc, nx, all32); b.st[0] = nloc; b.st[1] = nx; b.st[3] = (all32 != 0u && nx == 8u && sum_ok(bar)) ? 1u : 0u; }
        const unsigned old = xb_add(&bar[XB_XSUB(b.x)], 1u);
        const unsigned gen = old / nloc;
        if (old + 1u == (gen + 1u) * nloc) {
            __builtin_amdgcn_fence(__ATOMIC_RELEASE, "agent");
            asm volatile("s_waitcnt vmcnt(0)" ::: "memory");
            const unsigned og = xb_add(&bar[XB_TOP], 1u);
            const unsigned tg = og / nx;
            if (og + 1u == (tg + 1u) * nx) xb_add(&bar[XB_TOPGEN], 1u);
            else XB_SPIN(xb_ld(&bar[XB_TOPGEN]) == tg, bar);
            __builtin_amdgcn_fence(__ATOMIC_ACQUIRE, "agent");
            xb_add(&bar[XB_XGEN(b.x)], 1u);
            asm volatile("s_waitcnt vmcnt(0)" ::: "memory");
        } else {
            XB_SPIN(xb_ld(&bar[XB_XGEN(b.x)]) == gen, bar);
            __builtin_amdgcn_fence(__ATOMIC_ACQUIRE, "agent");
            asm volatile("s_waitcnt vmcnt(0)" ::: "memory");
        }
    }
    __syncthreads();
}

constexpr int N_PHASES = 12;
__global__ void __launch_bounds__(NTHR, 2) hybrid_fwd(Params p_) {
    extern __shared__ __attribute__((aligned(16))) unsigned char smem[];
    PP p = (PP)__builtin_amdgcn_kernarg_segment_ptr();
    const int lo = p->ph_lo, hi = p->ph_hi;
    const int G = gridDim.x;
    volatile LAS unsigned* bst = (volatile LAS unsigned*)((LAS unsigned char*)smem + LDS_BYTES - 16);
    XcdBarrier xbar; xbar.bar = (unsigned*)(p->ws + WS_BAR); xbar.x = 0; xbar.st = bst;
    if (hi - lo > 1) { if (threadIdx.x < 4) bst[threadIdx.x] = 0u; __syncthreads(); xbar = xcd_barrier_post((unsigned*)(p->ws + WS_BAR), bst); }
#ifndef PH_MASK
#define PH_MASK 0xfff
#endif
#define IN(k) (((PH_MASK >> (k)) & 1) && lo <= (k) && (k) < hi)
#ifndef REP_MASK
#define REP_MASK 0
#endif
#define VCU() ((bst[3] == 1u && (hi - lo > 1)) ? (int)(xbar.x + 8u * bst[2]) : (int)blockIdx.x)
#define LAUNDER() asm volatile("" : "+s"(p))
#define REP(k) for (int rep_ = 0; rep_ < 1 + ((REP_MASK >> (k)) & 1); ++rep_)
#define SEAM(k) do { if (IN(k) && IN((k) + 1)) { xcd_barrier(xbar); } } while (0)
    if (hi == 0x7fffffff) cg::this_grid().sync();
    LAUNDER();
    if (IN(0)) REP(0) phase0(p, smem);
    SEAM(0);
    LAUNDER();
    if (IN(1)) REP(1) norm_phase(p, p->in[0], p->in[1], p->in[11], 0, false);
    SEAM(1);
    LAUNDER();
    if (IN(2)) REP(2) { pg8::Gemm g{(const bf16_t*)(p->ws + WS_H), (const bf16_t*)(p->ws + WS_WIN), MT, NIN_PAD, D, D}; pg8::StaticOrder S; S.init(MT, NIN_PAD, G, VCU());
        Epi1 E{(bf16_t*)(p->ws + WS_PROJ), (float*)(p->ws + WS_AB)}; pg8::gemm_phase<Epi1, pg8::StaticOrder>((LAS unsigned char*)smem, g, S, E); }
    SEAM(2);
    LAUNDER();
    if (IN(3)) REP(3) phase3(p, smem);
    SEAM(3);
    LAUNDER();
    if (IN(4)) REP(4) phase4(p, smem);
    SEAM(4);
    LAUNDER();
    if (IN(5)) phase5(p);
    SEAM(5);
    LAUNDER();
    if (IN(6)) REP(6) { pg8::Gemm g{(const bf16_t*)(p->ws + WS_H), (const bf16_t*)(p->ws + WS_WO), MP, D, D, D}; pg8::StaticOrder S; S.init(MP, D, G, VCU());
        EpiRes E{p->in[0], p->in[1], p->out, (const float*)(p->ws + WS_MOD), 2}; pg8::gemm_phase<EpiRes, pg8::StaticOrder>((LAS unsigned char*)smem, g, S, E);
        pg8::Gemm g2{(const bf16_t*)(p->ws + WS_H) + (size_t)MP * D, (const bf16_t*)(p->ws + WS_WO), MS, D, 256, D}; pg8::SplitOrder S2; S2.init(MS, D, D / 256, G, VCU());
        EpiPart E2{(float*)(p->ws + WS_GDN)}; pg8::gemm_phase<EpiPart, pg8::SplitOrder>((LAS unsigned char*)smem, g2, S2, E2); }
    SEAM(6);
    LAUNDER();
    if (IN(7)) REP(7) norm_phase(p, p->out, p->in[1], p->in[12], 3, true);
    SEAM(7);
    LAUNDER();
    if (IN(8)) REP(8) { pg8::Gemm g{(const bf16_t*)(p->ws + WS_H), (const bf16_t*)(p->ws + WS_WUP), MT, FF2, D, D}; pg8::StaticOrder S; S.init(MT, FF2, G, VCU());
        Epi3 E{(bf16_t*)(p->ws + WS_PROJ), (float*)(p->ws + WS_HEAD), (float*)(p->ws + WS_HALO), (float*)(p->ws + WS_US), p->in[23], p->in[24]}; pg8::gemm_phase<Epi3, pg8::StaticOrder>((LAS unsigned char*)smem, g, S, E); }
    SEAM(8);
    LAUNDER();
    if (IN(9)) REP(9) phase9(p);
    SEAM(9);
    LAUNDER();
    if (IN(10)) { pg8::Gemm g{(const bf16_t*)(p->ws + WS_PROJ), (const bf16_t*)(p->ws + WS_WDN), MP, D, FF, FF}; pg8::StaticOrder S; S.init(MP, D, G, VCU());
        EpiRes E{p->out, p->out + (size_t)MP * D, p->out, (const float*)(p->ws + WS_MOD), 5}; pg8::gemm_phase<EpiRes, pg8::StaticOrder>((LAS unsigned char*)smem, g, S, E);
        pg8::Gemm g2{(const bf16_t*)(p->ws + WS_PROJ) + (size_t)MP * FF, (const bf16_t*)(p->ws + WS_WDN), MS, D, 512, FF}; pg8::SplitOrder S2; S2.init(MS, D, FF / 512, G, VCU());
        EpiPart E2{(float*)(p->ws + WS_GDN)}; pg8::gemm_phase<EpiPart, pg8::SplitOrder>((LAS unsigned char*)smem, g2, S2, E2); }
    SEAM(10);
    LAUNDER();
    if (IN(11)) {
        const float* part = (const float*)(p->ws + WS_GDN); const float* mod = (const float*)(p->ws + WS_MOD);
        for (int e = blockIdx.x * NTHR + threadIdx.x; e < MS * D / 4; e += G * NTHR) { const int row = e >> 9, c = (e & 511) * 4; f32x4 a = {0.f, 0.f, 0.f, 0.f};
#pragma unroll
            for (int sp = 0; sp < 11; ++sp) a += *(const f32x4*)(part + (size_t)sp * MS * D + (size_t)row * D + c);
            float* o = p->out + (size_t)(MP + row) * D + c; *(f32x4*)o = *(const f32x4*)o + *(const f32x4*)(mod + (size_t)(4 + (row >> 4)) * NMODW + 5 * D + c) * a; } }
#undef IN
#undef SEAM
}

extern "C" void kernel_launch(void* const* d_in, const int* in_sizes, int n_in, void* d_out, int out_size, void* d_ws, size_t ws_size, hipStream_t stream) {
    static int grid = 0;
    if (grid == 0) {
        if (n_in != 26 || (size_t)out_size != O_END || ws_size < WS_ALL) { fprintf(stderr, "kernel_launch: unexpected shapes (n_in %d out %d ws %zu)\n", n_in, out_size, ws_size); grid = -1; return; }
        int dev = 0, cus = 0, per_cu = 0;
        hipGetDevice(&dev); hipDeviceGetAttribute(&cus, hipDeviceAttributeMultiprocessorCount, dev);
        if (hipFuncSetAttribute((const void*)hybrid_fwd, hipFuncAttributeMaxDynamicSharedMemorySize, LDS_BYTES) != hipSuccess) { fprintf(stderr, "kernel_launch: hipFuncSetAttribute failed\n"); grid = -1; return; }
        if (hipOccupancyMaxActiveBlocksPerMultiprocessor(&per_cu, (const void*)hybrid_fwd, NTHR, LDS_BYTES) != hipSuccess || per_cu < 1) { fprintf(stderr, "kernel_launch: occupancy query says %d\n", per_cu); per_cu = 1; }
        (void)hipGetLastError();
        grid = cus * 1;
    }
    if (grid < 0) return;
    Params p{};
    for (int i = 0; i < 26; ++i) p.in[i] = (const float*)d_in[i];
    p.out = (float*)d_out; p.ws = (unsigned char*)d_ws;
#if N_LAUNCH_MODE == 1
    if (hipMemsetAsync((char*)d_ws + WS_BAR, 0, 16384, stream) != hipSuccess) { fprintf(stderr, "kernel_launch: memset failed\n"); return; }
    p.ph_lo = 0; p.ph_hi = N_PHASES;
    void* args[] = {&p};
    hipError_t e = hipLaunchCooperativeKernel((const void*)hybrid_fwd, dim3(grid), dim3(NTHR), args, LDS_BYTES, stream);
    if (e != hipSuccess) fprintf(stderr, "cooperative launch failed: %s (grid %d)\n", hipGetErrorString(e), grid);
#else
    for (int ph = 0; ph < N_PHASES; ++ph) { p.ph_lo = ph; p.ph_hi = ph + 1; hipLaunchKernelGGL(hybrid_fwd, dim3(grid), dim3(NTHR), LDS_BYTES, stream, p); }
#endif
}
```

```cpp
#include <hip/hip_runtime.h>
#include <hip/hip_cooperative_groups.h>
#include <cstdio>
#include <cstdint>
namespace cg = cooperative_groups;

#ifndef N_LAUNCH_MODE
#define N_LAUNCH_MODE 1
#endif

#define LAS __attribute__((address_space(3)))
typedef unsigned short bf16_t;
typedef short bf16x8 __attribute__((ext_vector_type(8)));
typedef float f32x4 __attribute__((ext_vector_type(4)));
typedef float f32x2 __attribute__((ext_vector_type(2)));
typedef unsigned u32x4 __attribute__((ext_vector_type(4)));
typedef unsigned u32x2 __attribute__((ext_vector_type(2)));

constexpr int D = 2048, MP = 16384, MS = 512, MT = MP + MS, LP = 4096, LS = 16, NBP = 4, NBS = 32;
constexpr int NPROJ = 5632, NIN_PAD = 5888, INW = 5648, FF = 5632, FF2 = 11264;
constexpr int NMODW = 12288;
constexpr float EPS = 1e-6f;
constexpr int NTHR = 512;
constexpr int LDS_BYTES = 163840;

constexpr size_t O_YP = 0, O_YS = O_YP + (size_t)MP * D, O_PCONV = O_YS + (size_t)MS * D, O_PDELTA = O_PCONV + 4 * 3 * 3072,
                 O_PK = O_PDELTA + (size_t)4 * 8 * 128 * 128, O_PV = O_PK + 4 * 128 * 2 * 128, O_PFFN = O_PV + 4 * 128 * 2 * 128,
                 O_SCONV = O_PFFN + 4 * 2 * FF2, O_SDELTA = O_SCONV + 32 * 3 * 3072, O_SK = O_SDELTA + (size_t)32 * 8 * 128 * 128,
                 O_SV = O_SK + 32 * 128 * 2 * 128, O_SFFN = O_SV + 32 * 128 * 2 * 128, O_END = O_SFFN + 32 * 2 * FF2;

constexpr size_t WS_WUP = 0, WS_WDN = WS_WUP + (size_t)FF2 * D * 2, WS_WIN = WS_WDN + (size_t)D * FF * 2, WS_WO = WS_WIN + (size_t)NIN_PAD * D * 2,
                 WS_MOD = WS_WO + (size_t)D * D * 2, WS_AB = WS_MOD + (size_t)36 * NMODW * 4, WS_H = WS_AB + (size_t)MT * 16 * 4,
                 WS_PROJ = WS_H + (size_t)MT * D * 2, WS_GDN = WS_PROJ + (size_t)MT * NPROJ * 2;
constexpr size_t CH_BYTES = 73984, CH_W = 0, CH_QG = 16384, CH_QK = 32768, CH_KD = 40960, CH_UT = 57344, CH_GL = 73728;
constexpr size_t WS_END = WS_GDN + (size_t)2048 * CH_BYTES;
constexpr size_t WS_HEAD = WS_GDN, WS_HALO = WS_HEAD + (size_t)256 * 2 * FF2 * 4, WS_US = WS_HALO + (size_t)256 * 2 * FF2 * 4;
static_assert(WS_US + (size_t)MS * FF2 * 4 <= WS_END, "ffn side buffers");
constexpr size_t WS_BAR = WS_END, WS_ALL = WS_BAR + 16384;
static_assert(WS_ALL <= (size_t)536870912, "workspace");

struct Params { const float* in[26]; float* out; unsigned char* ws; int ph_lo, ph_hi; };
typedef const __attribute__((address_space(4))) Params* PP;

typedef __bf16 bf16x2_t __attribute__((ext_vector_type(2)));
__device__ __forceinline__ unsigned cvt_pk_bf16(float lo, float hi) { f32x2 f = {lo, hi}; bf16x2_t v = __builtin_convertvector(f, bf16x2_t); return __builtin_bit_cast(unsigned, v); }
__device__ __forceinline__ float bf_lo(unsigned u) { return __uint_as_float(u << 16); }
__device__ __forceinline__ float bf_hi(unsigned u) { return __uint_as_float(u & 0xffff0000u); }
__device__ __forceinline__ float bf2f(bf16_t b) { return __uint_as_float(((unsigned)b) << 16); }
__device__ __forceinline__ float silu_f(float x) { return x * __builtin_amdgcn_rcpf(1.0f + __expf(-x)); }
__device__ __forceinline__ float sigmoid_f(float x) { return __builtin_amdgcn_rcpf(1.0f + __expf(-x)); }
__device__ __forceinline__ float softplus_f(float x) { return x > 20.f ? x : log1pf(__expf(x)); }
template <int CTRL> __device__ __forceinline__ float dpp0(float v) { return __builtin_bit_cast(float, __builtin_amdgcn_update_dpp(0, __builtin_bit_cast(int, v), CTRL, 0xf, 0xf, true)); }
__device__ __forceinline__ int cond_of_row(int m) { return m < MP ? (m >> 12) : 4 + ((m - MP) >> 4); }
__device__ __forceinline__ void unpack8(u32x4 v, float* f) { f[0] = bf_lo(v.x); f[1] = bf_hi(v.x); f[2] = bf_lo(v.y); f[3] = bf_hi(v.y); f[4] = bf_lo(v.z); f[5] = bf_hi(v.z); f[6] = bf_lo(v.w); f[7] = bf_hi(v.w); }
__device__ __forceinline__ bf16x8 as_bf16x8(u32x4 v) { return __builtin_bit_cast(bf16x8, v); }

namespace pg8 {
constexpr int BM = 256, BK = 64, HALF = 128, HTB = HALF * BK * 2, STAGE_BYTES = 8 * HTB, NXCD = 8, WGM = 2;
__host__ __device__ __forceinline__ int lds_byte(int r, int c) { const int st = (r >> 4) * 2 + (c >> 5), rr = r & 15, cc = c & 31, ob = rr * 64 + cc * 2; return st * 1024 + (ob ^ (((ob >> 9) & 1) << 5)); }
__host__ __device__ __forceinline__ void stage_rc(int b, int& R, int& C) { const int st = b / 1024, sb = b % 1024, swz = sb ^ (((sb >> 9) & 1) << 5); R = (st >> 1) * 16 + swz / 64; C = (st & 1) * 32 + (swz % 64) / 2; }
struct Unit { int pm, pn, ks; };
struct Gemm { const bf16_t* A; const bf16_t* Bt; int M, N, K, ldk; };
struct StaticOrder {
    int nM, nN, nwg, G, c;
    __host__ __device__ __forceinline__ void init(int M, int N, int G_, int c_) { nM = M / BM; nN = N / BM; nwg = nM * nN; G = G_; c = c_; }
    __host__ __device__ bool next(int i, Unit& u) const {
        const long L = (long)i * G + c; if (L >= nwg) return false;
        int wgid = (int)L; { const int q = nwg / NXCD, r = nwg % NXCD, xcd = wgid % NXCD, off = wgid / NXCD; wgid = (xcd < r ? xcd * (q + 1) : r * (q + 1) + (xcd - r) * q) + off; }
        const int nig = WGM * nN, gid = wgid / nig, fm = gid * WGM, gsz = (nM - fm) < WGM ? (nM - fm) : WGM;
        u.pm = fm + ((wgid % nig) % gsz); u.pn = (wgid % nig) / gsz; u.ks = 0; return true;
    }
};
struct SplitOrder {
    int nM, nN, nS, nwg, G, c;
    __host__ __device__ __forceinline__ void init(int M, int N, int nS_, int G_, int c_) { nM = M / BM; nN = N / BM; nS = nS_; nwg = nM * nN * nS; G = G_; c = c_; }
    __host__ __device__ bool next(int i, Unit& u) const {
        const long L = (long)i * G + c; if (L >= nwg) return false;
        const int l = (int)L; u.ks = l % nS; const int t = l / nS; u.pn = t % nN; u.pm = t / nN; return true;
    }
};

template <class Epi, class Sched>
__device__ __forceinline__ void gemm_phase(LAS unsigned char* lds, const Gemm g, const Sched& S, const Epi& E) {
    const int tid = threadIdx.x, wid = __builtin_amdgcn_readfirstlane(tid >> 6), lane = tid & 63, wr = wid >> 2, wc = wid & 3, fr = lane & 15, fq = lane >> 4;
    const int K = g.ldk, nt = g.K / BK;
    const size_t sstep = (size_t)g.K * 2;
    unsigned voffA[2];
#pragma unroll
    for (int i = 0; i < 2; ++i) { int R, C; stage_rc(tid * 16 + i * 8192, R, C); voffA[i] = (unsigned)(R * K + C) * 2u; }
    const size_t kstep = (size_t)(BK * 2);
    const size_t hstep = (size_t)HALF * K * 2;
    const size_t tstep = 2 * hstep;
    const unsigned ldsw = (unsigned)wid * 1024u;
    const int aoff = lds_byte(wr * 64 + fr, fq * 8), boff = lds_byte(wc * 32 + fr, fq * 8);
#define PG8_SA(b, h) (((b) * 2 + (h)) * HTB)
#define PG8_SB(b, h) ((4 + (b) * 2 + (h)) * HTB)
#define PG8_STAGE(bufoff, gbase, voff) do { _Pragma("unroll") for (int _i = 0; _i < 2; ++_i) \
        __builtin_amdgcn_global_load_lds((const unsigned*)((const char*)(gbase) + (voff)[_i]), (LAS unsigned*)(lds + (bufoff) + ldsw + _i * 8192), 16, 0, 0); } while (0)
#define PG8_LDA(dst, b, h) do { _Pragma("unroll") for (int m = 0; m < 4; ++m) _Pragma("unroll") for (int k = 0; k < 2; ++k) dst[m][k] = *(const LAS bf16x8*)(lds + PG8_SA(b, h) + aoff + m * 2048 + k * 1024); } while (0)
#define PG8_LDB(dst, b, h) do { _Pragma("unroll") for (int n = 0; n < 2; ++n) _Pragma("unroll") for (int k = 0; k < 2; ++k) dst[n][k] = *(const LAS bf16x8*)(lds + PG8_SB(b, h) + boff + n * 2048 + k * 1024); } while (0)
#define PG8_MMA(ai, bj, At, Bt) do { __builtin_amdgcn_s_setprio(1); _Pragma("unroll") for (int m = 0; m < 4; ++m) _Pragma("unroll") for (int n = 0; n < 2; ++n) _Pragma("unroll") for (int k = 0; k < 2; ++k) \
        acc[ai][bj][m][n] = __builtin_amdgcn_mfma_f32_16x16x32_bf16(Bt[n][k], At[m][k], acc[ai][bj][m][n], 0, 0, 0); __builtin_amdgcn_s_setprio(0); } while (0)
#define PG8_WAIT_V(n) asm volatile("s_waitcnt vmcnt(" #n ")" ::: "memory")
#define PG8_WAIT_L(n) asm volatile("s_waitcnt lgkmcnt(" #n ")" ::: "memory")
#define PG8_BAR __builtin_amdgcn_s_barrier()
#define PG8_SCHED __builtin_amdgcn_sched_barrier(0)
    Unit cur, nxt; int ui = 0;
    if (!S.next(0, cur)) return;
    f32x4 acc[2][2][4][2];
#pragma unroll
    for (int a = 0; a < 2; ++a)
#pragma unroll
        for (int b = 0; b < 2; ++b)
#pragma unroll
            for (int m = 0; m < 4; ++m)
#pragma unroll
                for (int n = 0; n < 2; ++n) acc[a][b][m][n] = (f32x4){0.f, 0.f, 0.f, 0.f};
    bf16x8 At[4][2], B0[2][2], B1[2][2];
    const char* cA = (const char*)g.A + (size_t)cur.pm * tstep + cur.ks * sstep; const char* cB = (const char*)g.Bt + (size_t)cur.pn * tstep + cur.ks * sstep;
    PG8_STAGE(PG8_SB(0, 0), cB, voffA); PG8_STAGE(PG8_SA(0, 0), cA, voffA); PG8_STAGE(PG8_SB(0, 1), cB + hstep, voffA); PG8_STAGE(PG8_SA(0, 1), cA + hstep, voffA);
    if (wr == 1) PG8_BAR;
    PG8_WAIT_V(4); PG8_BAR;
    PG8_STAGE(PG8_SB(1, 0), cB + kstep, voffA); PG8_STAGE(PG8_SA(1, 0), cA + kstep, voffA); PG8_STAGE(PG8_SB(1, 1), cB + hstep + kstep, voffA);
    PG8_WAIT_V(6); PG8_BAR;
    for (;;) {
        const bool has_next = S.next(ui + 1, nxt);
        const char* nA = has_next ? (const char*)g.A + (size_t)nxt.pm * tstep + nxt.ks * sstep : cA; const char* nB = has_next ? (const char*)g.Bt + (size_t)nxt.pn * tstep + nxt.ks * sstep : cB;
        for (int t = 0; t < nt; t += 2) {
            const bool last = (t == nt - 2);
            const char* a1 = cA + (size_t)(t + 1) * kstep;
            const char* a2 = last ? nA : cA + (size_t)(t + 2) * kstep; const char* b2 = last ? nB : cB + (size_t)(t + 2) * kstep;
            const char* a3 = a2 + kstep; const char* b3 = b2 + kstep;
            PG8_LDB(B0, 0, 0); PG8_SCHED; PG8_LDA(At, 0, 0); PG8_STAGE(PG8_SA(1, 1), a1 + hstep, voffA);
            PG8_WAIT_L(8); PG8_BAR; PG8_WAIT_L(0); PG8_MMA(0, 0, At, B0); PG8_BAR; PG8_SCHED;
            PG8_LDB(B1, 0, 1); PG8_STAGE(PG8_SB(0, 0), b2, voffA);
            PG8_BAR; PG8_WAIT_L(0); PG8_MMA(0, 1, At, B1); PG8_BAR;
            PG8_LDA(At, 0, 1); PG8_STAGE(PG8_SA(0, 0), a2, voffA);
            PG8_BAR; PG8_WAIT_L(0); PG8_MMA(1, 0, At, B0); PG8_BAR; PG8_SCHED;
            PG8_STAGE(PG8_SB(0, 1), b2 + hstep, voffA);
            PG8_WAIT_V(6); PG8_BAR; PG8_MMA(1, 1, At, B1); PG8_BAR;
            PG8_LDB(B0, 1, 0); PG8_SCHED; PG8_LDA(At, 1, 0); PG8_STAGE(PG8_SA(0, 1), a2 + hstep, voffA);
            PG8_WAIT_L(8); PG8_BAR; PG8_WAIT_L(0); PG8_MMA(0, 0, At, B0); PG8_BAR; PG8_SCHED;
            PG8_LDB(B1, 1, 1); PG8_STAGE(PG8_SB(1, 0), b3, voffA);
            PG8_BAR; PG8_WAIT_L(0); PG8_MMA(0, 1, At, B1); PG8_BAR;
            PG8_LDA(At, 1, 1); PG8_STAGE(PG8_SA(1, 0), a3, voffA);
            PG8_BAR; PG8_WAIT_L(0); PG8_MMA(1, 0, At, B0); PG8_BAR; PG8_SCHED;
            PG8_STAGE(PG8_SB(1, 1), b3 + hstep, voffA);
            PG8_WAIT_V(6); PG8_BAR; PG8_MMA(1, 1, At, B1); PG8_BAR;
        }
        E(acc, cur, wr, wc, fr, fq);
        if (!has_next) break;
#pragma unroll
        for (int a = 0; a < 2; ++a)
#pragma unroll
            for (int b = 0; b < 2; ++b)
#pragma unroll
                for (int m = 0; m < 4; ++m)
#pragma unroll
                    for (int n = 0; n < 2; ++n) acc[a][b][m][n] = (f32x4){0.f, 0.f, 0.f, 0.f};
        cur = nxt; cA = nA; cB = nB; ++ui;
    }
    PG8_WAIT_V(0);
    if (wr == 0) PG8_BAR;
    PG8_BAR;
#undef PG8_SA
#undef PG8_SB
#undef PG8_STAGE
#undef PG8_LDA
#undef PG8_LDB
#undef PG8_MMA
#undef PG8_WAIT_V
#undef PG8_WAIT_L
#undef PG8_BAR
#undef PG8_SCHED
}
}
using pg8::Unit;

struct Epi1 {
    bf16_t* P; float* AB;
    __device__ __forceinline__ void operator()(const f32x4 (&acc)[2][2][4][2], const Unit& u, int wr, int wc, int fr, int fq) const {
        const int row0 = u.pm * 256 + wr * 64 + fr;
        if (u.pn < 22) {
            const int col0 = u.pn * 256 + wc * 32 + 4 * fq;
#pragma unroll
            for (int ai = 0; ai < 2; ++ai)
#pragma unroll
                for (int m = 0; m < 4; ++m) { bf16_t* rowp = P + (size_t)(row0 + ai * 128 + m * 16) * NPROJ + col0;
#pragma unroll
                    for (int bj = 0; bj < 2; ++bj)
#pragma unroll
                        for (int n = 0; n < 2; ++n) { const f32x4 a = acc[ai][bj][m][n]; u32x2 w; w.x = cvt_pk_bf16(a[0], a[1]); w.y = cvt_pk_bf16(a[2], a[3]); *(u32x2*)(rowp + bj * 128 + n * 16) = w; } }
        } else if (wc == 0) {
#pragma unroll
            for (int ai = 0; ai < 2; ++ai)
#pragma unroll
                for (int m = 0; m < 4; ++m) *(f32x4*)(AB + (size_t)(row0 + ai * 128 + m * 16) * 16 + 4 * fq) = acc[ai][0][m][0];
        }
    }
};
struct EpiRes {
    const float* xa; const float* xb; float* out; const float* mod; int gi;
    __device__ __forceinline__ void operator()(const f32x4 (&acc)[2][2][4][2], const Unit& u, int wr, int wc, int fr, int fq) const {
        const int row0 = u.pm * 256 + wr * 64 + fr, col0 = u.pn * 256 + wc * 32 + 4 * fq;
        const float* gr = mod + (size_t)cond_of_row(u.pm * 256) * NMODW + gi * D + col0;
        f32x4 g4[2][2];
#pragma unroll
        for (int bj = 0; bj < 2; ++bj)
#pragma unroll
            for (int n = 0; n < 2; ++n) g4[bj][n] = *(const f32x4*)(gr + bj * 128 + n * 16);
#pragma unroll
        for (int ai = 0; ai < 2; ++ai) {
            f32x4 xv[4][2][2];
#pragma unroll
            for (int m = 0; m < 4; ++m) { const float* xr = xa + (size_t)(row0 + ai * 128 + m * 16) * D + col0;
#pragma unroll
                for (int bj = 0; bj < 2; ++bj)
#pragma unroll
                    for (int n = 0; n < 2; ++n) xv[m][bj][n] = *(const f32x4*)(xr + bj * 128 + n * 16); }
            __builtin_amdgcn_sched_barrier(0);
#pragma unroll
            for (int m = 0; m < 4; ++m) { float* orow = out + (size_t)(row0 + ai * 128 + m * 16) * D + col0;
#pragma unroll
                for (int bj = 0; bj < 2; ++bj)
#pragma unroll
                    for (int n = 0; n < 2; ++n) *(f32x4*)(orow + bj * 128 + n * 16) = xv[m][bj][n] + g4[bj][n] * acc[ai][bj][m][n]; }
        }
    }
};
struct EpiPart {
    float* part;
    __device__ __forceinline__ void operator()(const f32x4 (&acc)[2][2][4][2], const Unit& u, int wr, int wc, int fr, int fq) const {
        const int row0 = u.pm * 256 + wr * 64 + fr, col0 = u.pn * 256 + wc * 32 + 4 * fq;
        float* base = part + (size_t)u.ks * MS * D;
#pragma unroll
        for (int ai = 0; ai < 2; ++ai)
#pragma unroll
            for (int m = 0; m < 4; ++m) { float* orow = base + (size_t)(row0 + ai * 128 + m * 16) * D + col0;
#pragma unroll
                for (int bj = 0; bj < 2; ++bj)
#pragma unroll
                    for (int n = 0; n < 2; ++n) *(f32x4*)(orow + bj * 128 + n * 16) = acc[ai][bj][m][n]; }
    }
};
struct Epi3 {
    bf16_t* ACT; float* HEAD; float* HALO; float* US; const float* cw; const float* cb;
    __device__ __forceinline__ void operator()(const f32x4 (&acc)[2][2][4][2], const Unit& u, int wr, int wc, int fr, int fq) const {
        const int cg0 = u.pn * 128 + wc * 32 + 4 * fq;
        if (u.pm >= 64) {
            const int row0 = (u.pm - 64) * 256 + wr * 64 + fr;
#pragma unroll
            for (int ai = 0; ai < 2; ++ai)
#pragma unroll
                for (int m = 0; m < 4; ++m) { float* rp = US + (size_t)(row0 + ai * 128 + m * 16) * FF2 + cg0;
#pragma unroll
                    for (int bj = 0; bj < 2; ++bj)
#pragma unroll
                        for (int n = 0; n < 2; ++n) *(f32x4*)(rp + bj * FF + n * 16) = acc[ai][bj][m][n]; }
            return;
        }
#pragma unroll
        for (int n = 0; n < 2; ++n) {
            const int cg = cg0 + n * 16;
            f32x4 w0[2], w1[2], w2[2], bb[2];
#pragma unroll
            for (int bj = 0; bj < 2; ++bj) { const int c = cg + bj * FF; w0[bj] = *(const f32x4*)(cw + c); w1[bj] = *(const f32x4*)(cw + FF2 + c); w2[bj] = *(const f32x4*)(cw + 2 * FF2 + c); bb[bj] = *(const f32x4*)(cb + c); }
#pragma unroll
            for (int ai = 0; ai < 2; ++ai) {
                const int blk = u.pm * 4 + ai * 2 + wr;
                const int rowb = blk * 64;
                f32x4 p15[2] = {{0.f, 0.f, 0.f, 0.f}, {0.f, 0.f, 0.f, 0.f}}, p14[2] = {{0.f, 0.f, 0.f, 0.f}, {0.f, 0.f, 0.f, 0.f}};
#pragma unroll
                for (int m = 0; m < 4; ++m) {
                    f32x4 uc[2];
#pragma unroll
                    for (int bj = 0; bj < 2; ++bj) { const f32x4 cur = acc[ai][bj][m][n]; f32x4 pr1, pr2, n15, n14;
#pragma unroll
                        for (int j = 0; j < 4; ++j) { pr1[j] = dpp0<0x111>(cur[j]) + p15[bj][j]; pr2[j] = dpp0<0x112>(cur[j]) + p14[bj][j]; n15[j] = dpp0<0x10F>(cur[j]); n14[j] = dpp0<0x10E>(cur[j]); }
                        p15[bj] = n15; p14[bj] = n14;
                        uc[bj] = w2[bj] * cur + w1[bj] * pr1 + w0[bj] * pr2 + bb[bj];
                        if (m == 0 && fr < 2) *(f32x4*)(HEAD + (size_t)(blk * 2 + fr) * FF2 + cg + bj * FF) = cur;
                        if (m == 3 && fr >= 14) *(f32x4*)(HALO + (size_t)(blk * 2 + fr - 14) * FF2 + cg + bj * FF) = cur;
                    }
                    if (m > 0 || fr >= 2) { u32x2 w; w.x = cvt_pk_bf16(silu_f(uc[0][0]) * uc[1][0], silu_f(uc[0][1]) * uc[1][1]); w.y = cvt_pk_bf16(silu_f(uc[0][2]) * uc[1][2], silu_f(uc[0][3]) * uc[1][3]);
                        *(u32x2*)(ACT + (size_t)(rowb + m * 16 + fr) * FF + cg) = w; }
                }
            }
        }
    }
};

struct TileDesc { const float* W; bf16_t* Wt; int K, N, k0, n0, sc0, nv; };
struct ConvPtrs { const float* up; const float* dn; const float* in; const float* o; unsigned char* ws; };
__device__ __forceinline__ ConvPtrs conv_ptrs(PP p) { ConvPtrs c; c.up = p->in[22]; c.dn = p->in[25]; c.in = p->in[13]; c.o = p->in[21]; c.ws = p->ws; return c; }
__device__ __forceinline__ TileDesc tile_desc(const float* up, const float* dn, const float* win, const float* wo, unsigned char* ws, int t) {
    constexpr int T_UP = 32 * 88, T_DN = 88 * 16, T_IN = 32 * 46;
    const int cls = t < T_UP ? 0 : t < T_UP + T_DN ? 1 : t < T_UP + T_DN + T_IN ? 2 : 3;
    const int u = t - (cls == 0 ? 0 : cls == 1 ? T_UP : cls == 2 ? T_UP + T_DN : T_UP + T_DN + T_IN);
    const int NTn = cls == 0 ? 88 : cls == 2 ? 46 : 16; const int q4 = u >> 2; const int nt = q4 % NTn, kt = (q4 / NTn) * 4 + (u & 3), n0 = nt * 128;
    TileDesc d;
    d.W = cls == 0 ? up : cls == 1 ? dn : cls == 2 ? win : wo;
    d.Wt = (bf16_t*)(ws + (cls == 0 ? WS_WUP : cls == 1 ? WS_WDN : cls == 2 ? WS_WIN : WS_WO));
    d.K = cls == 1 ? FF : D; d.N = cls == 0 ? FF2 : cls == 2 ? INW : D; d.k0 = kt * 64; d.n0 = n0;
    const int pn = n0 >> 8;
    d.sc0 = cls == 0 ? ((n0 & 255) < 128 ? 128 * pn : FF + 128 * pn) : cls == 2 ? (n0 < 4096 ? n0 : (n0 < NPROJ ? n0 + 16 : 4096)) : n0;
    d.nv = cls == 2 ? (n0 < NPROJ ? 128 : (n0 == NPROJ ? 16 : 0)) : 128;
    return d;
}
__device__ __forceinline__ void tile_load(const TileDesc& d, f32x4 (&v)[4]) {
    const int tx = threadIdx.x & 31, ty = threadIdx.x >> 5;
#pragma unroll
    for (int ps = 0; ps < 4; ++ps) v[ps] = (4 * tx < d.nv) ? *(const f32x4*)(d.W + (size_t)(d.k0 + ps * 16 + ty) * d.N + d.sc0 + 4 * tx) : (f32x4){0.f, 0.f, 0.f, 0.f};
}
__device__ __forceinline__ void tile_to_lds(const f32x4 (&v)[4], float* tile) {
    const int tx = threadIdx.x & 31, ty = threadIdx.x >> 5;
#pragma unroll
    for (int ps = 0; ps < 4; ++ps) *(f32x4*)(tile + (ps * 16 + ty) * 132 + ((4 * tx + 8 * ps) & 127)) = v[ps];
}
__device__ __forceinline__ void tile_store(const TileDesc& d, const float* tile) {
    const int n = threadIdx.x >> 2, ks = threadIdx.x & 3; float v[16];
#pragma unroll
    for (int j = 0; j < 16; ++j) v[j] = tile[(ks * 16 + j) * 132 + ((n + 8 * ks) & 127)];
    u32x4 w0, w1; w0.x = cvt_pk_bf16(v[0], v[1]); w0.y = cvt_pk_bf16(v[2], v[3]); w0.z = cvt_pk_bf16(v[4], v[5]); w0.w = cvt_pk_bf16(v[6], v[7]);
    w1.x = cvt_pk_bf16(v[8], v[9]); w1.y = cvt_pk_bf16(v[10], v[11]); w1.z = cvt_pk_bf16(v[12], v[13]); w1.w = cvt_pk_bf16(v[14], v[15]);
    bf16_t* dst = d.Wt + (size_t)(d.n0 + n) * d.K + d.k0 + ks * 16; *(u32x4*)dst = w0; *(u32x4*)(dst + 8) = w1;
}
__device__ __forceinline__ void convert_seq(const ConvPtrs p, int n_extra, int first, int base, int stride, int t_all, int split, int shift, float* tile) {
    const int cnt = n_extra + (base < t_all ? (t_all - base + stride - 1) / stride : 0);
    auto tid_of = [&](int i) { const int v = i < n_extra ? first + 64 * i : base + stride * (i - n_extra); return v < split ? v : v + shift; };
    f32x4 ra[4], rb[4];
    if (cnt > 0) tile_load(tile_desc(p.up, p.dn, p.in, p.o, p.ws, tid_of(0)), ra);
    if (cnt > 1) tile_load(tile_desc(p.up, p.dn, p.in, p.o, p.ws, tid_of(1)), rb);
    for (int i = 0; i < cnt; i += 2) {
        { const TileDesc d = tile_desc(p.up, p.dn, p.in, p.o, p.ws, tid_of(i));
          tile_to_lds(ra, tile); if (i + 2 < cnt) tile_load(tile_desc(p.up, p.dn, p.in, p.o, p.ws, tid_of(i + 2)), ra);
          __syncthreads(); tile_store(d, tile); __syncthreads(); }
        if (i + 1 < cnt) { const TileDesc d = tile_desc(p.up, p.dn, p.in, p.o, p.ws, tid_of(i + 1));
          tile_to_lds(rb, tile); if (i + 3 < cnt) tile_load(tile_desc(p.up, p.dn, p.in, p.o, p.ws, tid_of(i + 3)), rb);
          __syncthreads(); tile_store(d, tile); __syncthreads(); }
    }
}
__device__ __forceinline__ void adaln_strip(PP p, int strip, float* lds) {
    const float* cpr = p->in[7]; const float* csm = p->in[8]; const float* aw = p->in[9]; const float* ab = p->in[10];
    float* mod = (float*)(p->ws + WS_MOD);
    const int tid = threadIdx.x, col4 = tid & 15, kg = (tid >> 4) & 15, rh = tid >> 8;
    float* sc = lds;
    float* red = lds + 36 * 256;
    f32x4 acc[18];
#pragma unroll
    for (int i = 0; i < 18; ++i) acc[i] = (f32x4){0.f, 0.f, 0.f, 0.f};
    const int n0 = strip * 64 + col4 * 4;
    f32x4 w[4], wn[4], wm[4];
#pragma unroll
    for (int q = 0; q < 4; ++q) { w[q] = *(const f32x4*)(aw + (size_t)(kg * 4 + q) * NMODW + n0); wn[q] = *(const f32x4*)(aw + (size_t)(64 + kg * 4 + q) * NMODW + n0); }
#pragma unroll 1
    for (int step = 0; step < 32; ++step) {
        const int kc = (step >> 2) * 256, kl = (step & 3) * 64 + kg * 4;
        if (step + 2 < 32) { const int kn = ((step + 2) >> 2) * 256 + ((step + 2) & 3) * 64 + kg * 4;
#pragma unroll
            for (int q = 0; q < 4; ++q) wm[q] = *(const f32x4*)(aw + (size_t)(kn + q) * NMODW + n0); }
        if ((step & 3) == 0) {
            __syncthreads();
#pragma unroll 1
            for (int hb = 0; hb < 2; ++hb) {
                float cv[9];
#pragma unroll
                for (int it2 = 0; it2 < 9; ++it2) { const int e = tid + (hb * 9 + it2) * NTHR, i = e >> 8, k = e & 255; cv[it2] = i < 4 ? cpr[i * D + kc + k] : csm[(i - 4) * D + kc + k]; }
#pragma unroll
                for (int it2 = 0; it2 < 9; ++it2) sc[tid + (hb * 9 + it2) * NTHR] = silu_f(cv[it2]);
            }
            __syncthreads();
        }
#pragma unroll
        for (int i = 0; i < 18; ++i) { const f32x4 s4 = *(const f32x4*)(sc + (rh * 18 + i) * 256 + kl);
            acc[i] += w[0] * s4[0]; acc[i] += w[1] * s4[1]; acc[i] += w[2] * s4[2]; acc[i] += w[3] * s4[3]; }
#pragma unroll
        for (int q = 0; q < 4; ++q) { w[q] = wn[q]; wn[q] = wm[q]; }
    }
    __syncthreads();
    for (int g = 0; g < 16; ++g) {
        if (kg == g) {
#pragma unroll
            for (int i = 0; i < 18; ++i) { float* rp = red + (rh * 18 + i) * 64 + col4 * 4;
#pragma unroll
                for (int j = 0; j < 4; ++j) rp[j] = (g == 0 ? 0.f : rp[j]) + acc[i][j]; }
        }
        __syncthreads();
    }
    for (int e = tid; e < 36 * 64; e += NTHR) { const int i = e >> 6, c = e & 63; mod[(size_t)i * NMODW + strip * 64 + c] = red[e] + ab[strip * 64 + c]; }
    __syncthreads();
}
__device__ __forceinline__ void phase0(PP p, unsigned char* smem) {
    float* lds = (float*)smem;
    const int bid = blockIdx.x, G = gridDim.x;
    constexpr int T_ALL = 32 * 88 + 88 * 16 + 32 * 46 + 32 * 16;
    if (G == 256) {
        if (bid < 192) adaln_strip(p, bid, lds);
        const ConvPtrs cp = conv_ptrs(p);
        if (bid < 192) convert_seq(cp, 0, 0, 832 + bid, 256, T_ALL - 512, 3712, 512, lds);
        else convert_seq(cp, 13, bid - 192, 832 + bid, 256, T_ALL - 512, 3712, 512, lds);
    } else {
        for (int s2 = bid; s2 < 192; s2 += G) adaln_strip(p, s2, lds);
        const ConvPtrs cp = conv_ptrs(p); convert_seq(cp, 0, 0, bid, G, T_ALL, T_ALL, 0, lds);
    }
}

__device__ __forceinline__ void norm_phase(PP p, const float* xa, const float* xb, const float* nw, int si, bool reduce_parts) {
    const float* mod = (const float*)(p->ws + WS_MOD); bf16_t* H = (bf16_t*)(p->ws + WS_H); float* outp = p->out; const float* parts = (const float*)(p->ws + WS_GDN);
    const int wave = threadIdx.x >> 6, lane = threadIdx.x & 63;
    const int stride = gridDim.x * 8;
    int m = blockIdx.x * 8 + wave;
    f32x4 wv[8];
#pragma unroll
    for (int i = 0; i < 8; ++i) wv[i] = *(const f32x4*)(nw + i * 256 + lane * 4);
    f32x4 v[8], vn[8];
    if (m < MT) { const float* xr = m < MP ? xa + (size_t)m * D : xb + (size_t)(m - MP) * D;
#pragma unroll
        for (int i = 0; i < 8; ++i) v[i] = *(const f32x4*)(xr + i * 256 + lane * 4); }
    while (m < MT) {
        const int mn = m + stride;
        const float* mr = mod + (size_t)cond_of_row(m) * NMODW + si * D;
        f32x4 sh[8], scl[8];
#pragma unroll
        for (int i = 0; i < 8; ++i) { sh[i] = *(const f32x4*)(mr + i * 256 + lane * 4); scl[i] = *(const f32x4*)(mr + D + i * 256 + lane * 4); }
        if (mn < MT) { const float* xr = mn < MP ? xa + (size_t)mn * D : xb + (size_t)(mn - MP) * D;
#pragma unroll
            for (int i = 0; i < 8; ++i) vn[i] = *(const f32x4*)(xr + i * 256 + lane * 4); }
        if (reduce_parts && m >= MP) {
            const float* part = parts + (size_t)(m - MP) * D; const float* g1 = mod + (size_t)cond_of_row(m) * NMODW + 2 * D;
#pragma unroll
            for (int i = 0; i < 8; ++i) { f32x4 a = {0.f, 0.f, 0.f, 0.f};
#pragma unroll
                for (int sp = 0; sp < 8; ++sp) a += *(const f32x4*)(part + (size_t)sp * MS * D + i * 256 + lane * 4);
                v[i] += *(const f32x4*)(g1 + i * 256 + lane * 4) * a; *(f32x4*)(outp + (size_t)m * D + i * 256 + lane * 4) = v[i]; }
        }
        float ss = 0.f;
#pragma unroll
        for (int i = 0; i < 8; ++i) ss += v[i][0] * v[i][0] + v[i][1] * v[i][1] + v[i][2] * v[i][2] + v[i][3] * v[i][3];
#pragma unroll
        for (int o = 32; o >= 1; o >>= 1) ss += __shfl_xor(ss, o);
        const float rstd = rsqrtf(ss * (1.0f / D) + EPS);
#pragma unroll
        for (int i = 0; i < 8; ++i) { const int c = i * 256 + lane * 4;
            const f32x4 h = (v[i] * rstd * wv[i]) * (scl[i] + 1.0f) + sh[i]; u32x2 o; o.x = cvt_pk_bf16(h[0], h[1]); o.y = cvt_pk_bf16(h[2], h[3]); *(u32x2*)(H + (size_t)m * D + c) = o; }
#pragma unroll
        for (int i = 0; i < 8; ++i) v[i] = vn[i];
        m = mn;
    }
}

__device__ __forceinline__ void team_bar(unsigned* cnt, unsigned& target) {
    target += 4u;
    __builtin_amdgcn_fence(__ATOMIC_RELEASE, "workgroup");
    if ((threadIdx.x & 63) == 0) (void)__hip_atomic_fetch_add(cnt, 1u, __ATOMIC_RELAXED, __HIP_MEMORY_SCOPE_WORKGROUP);
    while (__hip_atomic_load(cnt, __ATOMIC_RELAXED, __HIP_MEMORY_SCOPE_WORKGROUP) < target) __builtin_amdgcn_s_sleep(1);
    __builtin_amdgcn_fence(__ATOMIC_ACQUIRE, "workgroup");
}
constexpr int TEAM_LDS = 81920;
__device__ __forceinline__ void gdn_prep(PP p, int item, unsigned char* tl  , unsigned* cnt, unsigned& bt) {
    const int b = item >> 9, h = (item >> 6) & 7, n = item & 63;
    int lt_ = threadIdx.x & 255; asm volatile("" : "+v"(lt_));
    const int lt = lt_, lane = lt & 63, lw = __builtin_amdgcn_readfirstlane(lt >> 6);
    const bf16_t* PROJ = (const bf16_t*)(p->ws + WS_PROJ); const float* AB = (const float*)(p->ws + WS_AB);
    unsigned char* rec = p->ws + WS_GDN + (size_t)item * CH_BYTES;
    const int m0 = b * LP + n * 64;
    bf16_t* QH = (bf16_t*)tl;
    bf16_t* KH = QH + 64 * 136;
    float* GC = (float*)(tl + 34816);
    float* BETA = GC + 64; float* EG = GC + 128; float* BEG = GC + 192;
    bf16_t* QKF = (bf16_t*)(tl + 36864);
    bf16_t* VH = (bf16_t*)(tl + 45056);
    float* AM = (float*)(tl + 62464);
    bf16_t* XS = (bf16_t*)(tl + 45056);
    team_bar(cnt, bt);
    if (lw == 0) {
        const float a = AB[(size_t)(m0 + lane) * 16 + h], bb = AB[(size_t)(m0 + lane) * 16 + 8 + h];
        float g = -__expf(p->in[15][h]) * softplus_f(a + p->in[16][h]);
        float gc = g;
#pragma unroll
        for (int o = 1; o < 64; o <<= 1) { const float t = __shfl_up(gc, o); if (lane >= o) gc += t; }
        const float be = sigmoid_f(bb), eg = __expf(gc);
        GC[lane] = gc; BETA[lane] = be; EG[lane] = eg; BEG[lane] = be * eg;
        if (lane == 63) *(float*)(rec + CH_GL) = eg;
    }
    {
        const float* cw = p->in[14];
#pragma unroll 1
        for (int pass = 0; pass < 2; ++pass) {
            const int slot = pass * 256 + lt, r = slot >> 3, cg = slot & 7; const int t = n * 64 + r;
            u32x4 raw[3][4][2];
#pragma unroll
            for (int which = 0; which < 3; ++which)
#pragma unroll
                for (int i = 0; i < 4; ++i) { const int dr = (t - 3 + i >= 0) ? (r - 3 + i) : r; const bf16_t* src = PROJ + (size_t)(m0 + dr) * NPROJ + which * 1024 + h * 128 + cg * 16;
                    raw[which][i][0] = *(const u32x4*)src; raw[which][i][1] = *(const u32x4*)(src + 8); }
#pragma unroll
            for (int which = 0; which < 3; ++which) {
                const int col = which * 1024 + h * 128 + cg * 16;
                float y[16];
#pragma unroll
                for (int j = 0; j < 16; ++j) y[j] = 0.f;
#pragma unroll
                for (int i = 0; i < 4; ++i) {
                    const float keep = (t - 3 + i >= 0) ? 1.0f : 0.0f;
                    float x[16]; unpack8(raw[which][i][0], x); unpack8(raw[which][i][1], x + 8);
#pragma unroll
                    for (int q = 0; q < 4; ++q) { const f32x4 w = *(const f32x4*)(cw + i * 3072 + col + q * 4) * keep;
#pragma unroll
                        for (int j = 0; j < 4; ++j) y[q * 4 + j] += w[j] * x[q * 4 + j]; }
                }
                float ss = 0.f;
#pragma unroll
                for (int j = 0; j < 16; ++j) { y[j] = silu_f(y[j]); ss += y[j] * y[j]; }
                float rn = 1.0f;
                if (which < 2) { ss += __shfl_xor(ss, 1); ss += __shfl_xor(ss, 2); ss += __shfl_xor(ss, 4); rn = rsqrtf(ss + EPS) * (which == 0 ? 0.08838834764831845f : 1.0f); }
                u32x4 w0, w1;
                w0.x = cvt_pk_bf16(y[0] * rn, y[1] * rn); w0.y = cvt_pk_bf16(y[2] * rn, y[3] * rn); w0.z = cvt_pk_bf16(y[4] * rn, y[5] * rn); w0.w = cvt_pk_bf16(y[6] * rn, y[7] * rn);
                w1.x = cvt_pk_bf16(y[8] * rn, y[9] * rn); w1.y = cvt_pk_bf16(y[10] * rn, y[11] * rn); w1.z = cvt_pk_bf16(y[12] * rn, y[13] * rn); w1.w = cvt_pk_bf16(y[14] * rn, y[15] * rn);
                bf16_t* dst = (which == 0 ? QH : which == 1 ? KH : VH) + r * 136 + cg * 16;
                *(u32x4*)dst = w0; *(u32x4*)(dst + 8) = w1;
            }
            if (n == 63 && r >= 61) {
                float* pc = p->out + O_PCONV + (size_t)(b * 3 + (r - 61)) * 3072;
#pragma unroll
                for (int which = 0; which < 3; ++which) { const int col = which * 1024 + h * 128 + cg * 16; float x[16]; unpack8(raw[which][3][0], x); unpack8(raw[which][3][1], x + 8);
#pragma unroll
                    for (int j = 0; j < 16; ++j) pc[col + j] = x[j]; }
            }
        }
    }
    team_bar(cnt, bt);
    {
        const int fr = lane & 15, kq = lane >> 4;
#pragma unroll
        for (int rep = 0; rep < 4; ++rep) {
            const int tt = lw + rep * 4, ti = tt >> 2, tj = tt & 3;
            f32x4 ck = {0.f, 0.f, 0.f, 0.f}, cq = {0.f, 0.f, 0.f, 0.f};
            if (tj <= ti) {
#pragma unroll
                for (int kk = 0; kk < 4; ++kk) {
                    const bf16x8 ak = *(const bf16x8*)(KH + (16 * ti + fr) * 136 + kk * 32 + kq * 8);
                    const bf16x8 aq = *(const bf16x8*)(QH + (16 * ti + fr) * 136 + kk * 32 + kq * 8);
                    const bf16x8 bk = *(const bf16x8*)(KH + (16 * tj + fr) * 136 + kk * 32 + kq * 8);
                    ck = __builtin_amdgcn_mfma_f32_16x16x32_bf16(ak, bk, ck, 0, 0, 0);
                    cq = __builtin_amdgcn_mfma_f32_16x16x32_bf16(aq, bk, cq, 0, 0, 0);
                }
            }
            const int j = 16 * tj + fr; const float gj = GC[j];
            const int cc = 16 * (tj & 1) + fr; const int kqp = (cc & 15) >> 2, jp = (cc & 3) + (cc >= 16 ? 4 : 0), kc = tj >> 1;
#pragma unroll
            for (int r = 0; r < 4; ++r) {
                const int i = 16 * ti + 4 * kq + r; const float dec = __expf(GC[i] - gj);
                AM[i * 68 + j] = (i > j) ? BETA[i] * dec * ck[r] : 0.f;
                const float qv = (i >= j) ? dec * cq[r] : 0.f;
                const int L = (4 * kq + r) + 16 * kqp;
                QKF[((ti * 2 + kc) * 64 + L) * 8 + jp] = (bf16_t)(cvt_pk_bf16(qv, 0.f) & 0xffffu);
            }
        }
    }
    team_bar(cnt, bt);
    float x[64];
    {
        const int c = lt;
        int zv; asm volatile("v_mov_b32 %0, 0" : "=v"(zv));
        const float* AMv = AM + zv; const float* SCL = (c < 128 ? BETA : BEG) + zv; const bf16_t* R = (c < 128 ? VH : KH) + (c & 127);
        f32x4 amc[16], amn[8];
        float rc = bf2f(R[0]) * SCL[0], rn = 0.f;
#pragma unroll
        for (int i = 0; i < 64; ++i) {
            __builtin_amdgcn_sched_barrier(0);
#pragma unroll
            for (int jj = 8; jj < (i + 3) / 4; ++jj) amc[jj] = *(const f32x4*)(AMv + i * 68 + jj * 4);
            if (i + 1 < 64) { rn = bf2f(R[(i + 1) * 136]) * SCL[i + 1];
#pragma unroll
                for (int jj = 0; jj < ((i + 4) / 4 < 8 ? (i + 4) / 4 : 8); ++jj) amn[jj] = *(const f32x4*)(AMv + (i + 1) * 68 + jj * 4); }
            float a = rc;
#pragma unroll
            for (int jj = 0; jj < (i + 3) / 4; ++jj) {
#pragma unroll
                for (int q = 0; q < 4; ++q) if (jj * 4 + q < i) asm("v_fma_f32 %0, -%1, %2, %0" : "+v"(a) : "v"(amc[jj][q]), "v"(x[jj * 4 + q])); }
            x[i] = a;
            rc = rn;
#pragma unroll
            for (int jj = 0; jj < 8; ++jj) amc[jj] = amn[jj];
        }
    }
    team_bar(cnt, bt);
#pragma unroll
    for (int i = 0; i < 64; ++i) XS[i * 264 + lt] = (bf16_t)(cvt_pk_bf16(x[i], 0.f) & 0xffffu);
    team_bar(cnt, bt);
    {
        const int L = lane, mrow = L & 15, kqp = L >> 4;
        const float g63 = GC[63];
#pragma unroll
        for (int rnd = 0; rnd < 4; ++rnd) { const int f = rnd * 4 + lw, mt = f >> 2, kk = f & 3; const int c = 16 * mt + mrow;
            const u32x2 lo = *(const u32x2*)(XS + c * 264 + 128 + 32 * kk + 4 * kqp), hi = *(const u32x2*)(XS + c * 264 + 128 + 32 * kk + 16 + 4 * kqp);
            u32x4 w; w.x = lo.x; w.y = lo.y; w.z = hi.x; w.w = hi.y;
            *(u32x4*)(rec + CH_W + (size_t)f * 1024 + L * 16) = w; }
#pragma unroll
        for (int rnd = 0; rnd < 2; ++rnd) { const int slot = rnd * 256 + lt, dv = slot >> 2, cs = slot & 3; unsigned pk[8];
#pragma unroll
            for (int q = 0; q < 8; ++q) { const unsigned lo = XS[(16 * cs + 2 * q) * 264 + dv], hi = XS[(16 * cs + 2 * q + 1) * 264 + dv]; pk[q] = lo | (hi << 16); }
            u32x4 w0, w1; w0.x = pk[0]; w0.y = pk[1]; w0.z = pk[2]; w0.w = pk[3]; w1.x = pk[4]; w1.y = pk[5]; w1.z = pk[6]; w1.w = pk[7];
            bf16_t* ut = (bf16_t*)(rec + CH_UT) + dv * 64 + cs * 16; *(u32x4*)ut = w0; *(u32x4*)(ut + 8) = w1; }
#pragma unroll
        for (int rnd = 0; rnd < 4; ++rnd) {
            const int f = rnd * 4 + lw, mt = f >> 2, kk = f & 3; const int c = 16 * mt + mrow; const float e = EG[c];
            const u32x2 lo = *(const u32x2*)(QH + c * 136 + 32 * kk + 4 * kqp), hi = *(const u32x2*)(QH + c * 136 + 32 * kk + 16 + 4 * kqp);
            u32x4 w; w.x = cvt_pk_bf16(bf_lo(lo.x) * e, bf_hi(lo.x) * e); w.y = cvt_pk_bf16(bf_lo(lo.y) * e, bf_hi(lo.y) * e); w.z = cvt_pk_bf16(bf_lo(hi.x) * e, bf_hi(hi.x) * e); w.w = cvt_pk_bf16(bf_lo(hi.y) * e, bf_hi(hi.y) * e);
            *(u32x4*)(rec + CH_QG + (size_t)f * 1024 + L * 16) = w;
        }
#pragma unroll
        for (int rnd = 0; rnd < 4; ++rnd) {
            const int f = rnd * 4 + lw, d = f >> 1, kc = f & 1; const int dk = 16 * d + mrow;
            float v[8];
#pragma unroll
            for (int j = 0; j < 8; ++j) { const int c = 32 * kc + (j < 4 ? 4 * kqp + j : 16 + 4 * kqp + (j - 4)); v[j] = bf2f(KH[c * 136 + dk]) * __expf(g63 - GC[c]); }
            u32x4 w; w.x = cvt_pk_bf16(v[0], v[1]); w.y = cvt_pk_bf16(v[2], v[3]); w.z = cvt_pk_bf16(v[4], v[5]); w.w = cvt_pk_bf16(v[6], v[7]);
            *(u32x4*)(rec + CH_KD + (size_t)f * 1024 + L * 16) = w;
        }
#pragma unroll
        for (int rnd = 0; rnd < 2; ++rnd) { const int e = rnd * 256 + lt; *(u32x4*)(rec + CH_QK + (size_t)e * 16) = *(const u32x4*)((const unsigned char*)QKF + e * 16); }
    }
}

__device__ __forceinline__ void gdn_sample(PP p, int item, unsigned char* smem) {
    const int b = item >> 3, h = item & 7;
    const int tid = threadIdx.x;
    const bf16_t* PROJ = (const bf16_t*)(p->ws + WS_PROJ); const float* AB = (const float*)(p->ws + WS_AB);
    bf16_t* OM = (bf16_t*)(p->ws + WS_H);
    const int m0 = MP + b * 16;
    float* Q = (float*)smem; float* K = Q + 16 * 128; float* V = K + 16 * 128; float* O = V + 16 * 128;
    float* RED = O + 16 * 128;
    float* RED2 = RED + 4 * 128;
    float* GG = RED2 + 4 * 128;
    __syncthreads();
    if (tid < 16) { const float a = AB[(size_t)(m0 + tid) * 16 + h], bb = AB[(size_t)(m0 + tid) * 16 + 8 + h];
        GG[tid] = __expf(-__expf(p->in[15][h]) * softplus_f(a + p->in[16][h])); GG[16 + tid] = sigmoid_f(bb); }
    {
        const int r = tid >> 5, cg = tid & 31; const float* cw = p->in[14]; const float* st = p->in[2] + (size_t)b * 3 * 3072;
#pragma unroll
        for (int which = 0; which < 3; ++which) {
            const int col = which * 1024 + h * 128 + cg * 4; float y[4] = {0.f, 0.f, 0.f, 0.f};
#pragma unroll
            for (int i = 0; i < 4; ++i) { const int t = r - 3 + i; float x[4];
                const u32x2 vp = *(const u32x2*)(PROJ + (size_t)(m0 + (t >= 0 ? t : 0)) * NPROJ + col); const f32x4 vs = *(const f32x4*)(st + (size_t)(t >= 0 ? 0 : 3 + t) * 3072 + col);
                x[0] = t >= 0 ? bf_lo(vp.x) : vs[0]; x[1] = t >= 0 ? bf_hi(vp.x) : vs[1]; x[2] = t >= 0 ? bf_lo(vp.y) : vs[2]; x[3] = t >= 0 ? bf_hi(vp.y) : vs[3];
                const f32x4 w = *(const f32x4*)(cw + i * 3072 + col);
#pragma unroll
                for (int j = 0; j < 4; ++j) y[j] += w[j] * x[j]; }
            float ss = 0.f;
#pragma unroll
            for (int j = 0; j < 4; ++j) { y[j] = silu_f(y[j]); ss += y[j] * y[j]; }
            float rn = 1.0f;
            if (which < 2) {
#pragma unroll
                for (int o = 1; o < 32; o <<= 1) ss += __shfl_xor(ss, o);
                rn = rsqrtf(ss + EPS) * (which == 0 ? 0.08838834764831845f : 1.0f); }
            float* dst = (which == 0 ? Q : which == 1 ? K : V) + r * 128 + cg * 4;
#pragma unroll
            for (int j = 0; j < 4; ++j) dst[j] = y[j] * rn;
            if (r >= 13) {
                const u32x2 v = *(const u32x2*)(PROJ + (size_t)(m0 + r) * NPROJ + col);
                *(f32x4*)(p->out + O_SCONV + (size_t)(b * 3 + r - 13) * 3072 + col) = (f32x4){bf_lo(v.x), bf_hi(v.x), bf_lo(v.y), bf_hi(v.y)}; }
        }
    }
    const int dv = tid & 127, kg = tid >> 7;
    float S[32];
    const float* s0 = p->in[3] + ((size_t)(b * 8 + h) * 128 + kg * 32) * 128 + dv;
#pragma unroll
    for (int i = 0; i < 32; ++i) S[i] = s0[(size_t)i * 128];
    __syncthreads();
    for (int t = 0; t < 16; ++t) {
        const float a = GG[t], be = GG[16 + t]; float part = 0.f;
#pragma unroll
        for (int i = 0; i < 32; ++i) { S[i] *= a; part += K[t * 128 + kg * 32 + i] * S[i]; }
        RED[kg * 128 + dv] = part;
        __syncthreads();
        const float ks = RED[dv] + RED[128 + dv] + RED[256 + dv] + RED[384 + dv];
        const float rr = be * (V[t * 128 + dv] - ks); float po = 0.f;
#pragma unroll
        for (int i = 0; i < 32; ++i) { S[i] += K[t * 128 + kg * 32 + i] * rr; po += Q[t * 128 + kg * 32 + i] * S[i]; }
        RED2[kg * 128 + dv] = po;
        __syncthreads();
        if (kg == 0) O[t * 128 + dv] = RED2[dv] + RED2[128 + dv] + RED2[256 + dv] + RED2[384 + dv];
    }
    float* sd = p->out + O_SDELTA + ((size_t)(b * 8 + h) * 128 + kg * 32) * 128 + dv;
#pragma unroll
    for (int i = 0; i < 32; ++i) sd[(size_t)i * 128] = S[i];
    __syncthreads();
    {
        const int r = tid >> 5, cg = tid & 31; const f32x4 o = *(const f32x4*)(O + r * 128 + cg * 4);
        float ss = o[0] * o[0] + o[1] * o[1] + o[2] * o[2] + o[3] * o[3];
#pragma unroll
        for (int of = 1; of < 32; of <<= 1) ss += __shfl_xor(ss, of);
        const float rs = rsqrtf(ss * (1.0f / 128.f) + EPS); const f32x4 w = *(const f32x4*)(p->in[17] + cg * 4);
        const u32x2 zz = *(const u32x2*)(PROJ + (size_t)(m0 + r) * NPROJ + 3072 + h * 128 + cg * 4);
        const float z[4] = {bf_lo(zz.x), bf_hi(zz.x), bf_lo(zz.y), bf_hi(zz.y)};
        u32x2 ow; ow.x = cvt_pk_bf16(o[0] * rs * w[0] * silu_f(z[0]), o[1] * rs * w[1] * silu_f(z[1])); ow.y = cvt_pk_bf16(o[2] * rs * w[2] * silu_f(z[2]), o[3] * rs * w[3] * silu_f(z[3]));
        *(u32x2*)(OM + (size_t)(m0 + r) * D + h * 128 + cg * 4) = ow;
    }
}

template <int NT  , bool SAMPLE>
__device__ __forceinline__ void swa_item(PP p, int b, int n, int hk, unsigned char* smem) {
    constexpr int SPAN = SAMPLE ? 144 : 192, NQ = SAMPLE ? 16 : 64, VP = NT * 16 + 8;
    const int tid = threadIdx.x, lane = tid & 63, wave = tid >> 6, fr = lane & 15, kq = lane >> 4;
    const bf16_t* PROJ = (const bf16_t*)(p->ws + WS_PROJ); bf16_t* OM = (bf16_t*)(p->ws + WS_H);
    bf16_t* KS = (bf16_t*)smem;
    bf16_t* VT = KS + NT * 16 * 136;
    const int mq0 = SAMPLE ? MP + b * 16 : b * LP + n * 64;
    const float* knw = p->in[19];
    __syncthreads();
    u32x4 kraw[3][2], vraw[3][2];
    if (!SAMPLE) {
#pragma unroll
        for (int pass = 0; pass < 3; ++pass) {
            { const int t = n * 64 - 128 + pass * 64 + (tid >> 3); const bf16_t* src = PROJ + (size_t)(b * LP + (t > 0 ? t : 0)) * NPROJ + 5120 + hk * 128 + (tid & 7) * 16; kraw[pass][0] = *(const u32x4*)src; kraw[pass][1] = *(const u32x4*)(src + 8); }
            { const int t = n * 64 - 128 + pass * 64 + lane; const bf16_t* src = PROJ + (size_t)(b * LP + (t > 0 ? t : 0)) * NPROJ + 5376 + hk * 128 + wave * 16; vraw[pass][0] = *(const u32x4*)src; vraw[pass][1] = *(const u32x4*)(src + 8); }
        }
    }
#pragma unroll
    for (int pass = 0; pass < (NT * 16) / 64 + ((NT * 16) % 64 ? 1 : 0); ++pass) {
        const int key = pass * 64 + (tid >> 3), cg = tid & 7;
        if (key < NT * 16) {
            float x[16]; bool valid = key < SPAN; bool fresh = false; int srow = 0;
            if (SAMPLE) { if (key >= 128) { fresh = true; srow = mq0 + key - 128; } }
            else { const int t = n * 64 - 128 + key; valid = valid && t >= 0; fresh = true; srow = b * LP + t; }
            if (!valid) {
#pragma unroll
                for (int j = 0; j < 16; ++j) x[j] = 0.f;
            } else if (fresh) {
                if (SAMPLE) { const bf16_t* src = PROJ + (size_t)srow * NPROJ + 5120 + hk * 128 + cg * 16; unpack8(*(const u32x4*)src, x); unpack8(*(const u32x4*)(src + 8), x + 8); }
                else { unpack8(kraw[pass][0], x); unpack8(kraw[pass][1], x + 8); }
                float ss = 0.f;
#pragma unroll
                for (int j = 0; j < 16; ++j) ss += x[j] * x[j];
                ss += __shfl_xor(ss, 1); ss += __shfl_xor(ss, 2); ss += __shfl_xor(ss, 4);
                const float rs = rsqrtf(ss * (1.0f / 128.f) + EPS);
#pragma unroll
                for (int j = 0; j < 16; ++j) x[j] = x[j] * rs * knw[cg * 16 + j];
            } else {
                const float* src = p->in[4] + ((size_t)(b * 128 + key) * 2 + hk) * 128 + cg * 16;
#pragma unroll
                for (int q = 0; q < 4; ++q) { const f32x4 v = *(const f32x4*)(src + q * 4); x[q * 4] = v[0]; x[q * 4 + 1] = v[1]; x[q * 4 + 2] = v[2]; x[q * 4 + 3] = v[3]; }
            }
            u32x4 w0, w1;
            w0.x = cvt_pk_bf16(x[0], x[1]); w0.y = cvt_pk_bf16(x[2], x[3]); w0.z = cvt_pk_bf16(x[4], x[5]); w0.w = cvt_pk_bf16(x[6], x[7]);
            w1.x = cvt_pk_bf16(x[8], x[9]); w1.y = cvt_pk_bf16(x[10], x[11]); w1.z = cvt_pk_bf16(x[12], x[13]); w1.w = cvt_pk_bf16(x[14], x[15]);
            *(u32x4*)(KS + key * 136 + cg * 16) = w0; *(u32x4*)(KS + key * 136 + cg * 16 + 8) = w1;
            float* dst = nullptr;
            if (SAMPLE) { if (key >= 16 && key < 144) dst = p->out + O_SK + ((size_t)(b * 128 + key - 16) * 2 + hk) * 128 + cg * 16; }
            else { if (n >= 62 && key >= 128) dst = p->out + O_PK + ((size_t)(b * 128 + (n - 62) * 64 + key - 128) * 2 + hk) * 128 + cg * 16; }
            if (dst) {
#pragma unroll
                for (int q = 0; q < 4; ++q) *(f32x4*)(dst + q * 4) = (f32x4){x[q * 4], x[q * 4 + 1], x[q * 4 + 2], x[q * 4 + 3]}; }
        }
    }
#pragma unroll
    for (int pass = 0; pass < (NT * 16) / 64 + ((NT * 16) % 64 ? 1 : 0); ++pass) {
        const int key = pass * 64 + lane, cg = wave;
        if (key < NT * 16) {
            float x[16]; bool valid = key < SPAN; bool fresh = false; int srow = 0;
            if (SAMPLE) { if (key >= 128) { fresh = true; srow = mq0 + key - 128; } }
            else { const int t = n * 64 - 128 + key; valid = valid && t >= 0; fresh = true; srow = b * LP + t; }
            if (!valid) {
#pragma unroll
                for (int j = 0; j < 16; ++j) x[j] = 0.f;
            } else if (fresh) { if (SAMPLE) { const bf16_t* src = PROJ + (size_t)srow * NPROJ + 5376 + hk * 128 + cg * 16; unpack8(*(const u32x4*)src, x); unpack8(*(const u32x4*)(src + 8), x + 8); } else { unpack8(vraw[pass][0], x); unpack8(vraw[pass][1], x + 8); } }
            else { const float* src = p->in[5] + ((size_t)(b * 128 + key) * 2 + hk) * 128 + cg * 16;
#pragma unroll
                for (int q = 0; q < 4; ++q) { const f32x4 v = *(const f32x4*)(src + q * 4); x[q * 4] = v[0]; x[q * 4 + 1] = v[1]; x[q * 4 + 2] = v[2]; x[q * 4 + 3] = v[3]; } }
#pragma unroll
            for (int j = 0; j < 16; ++j) VT[(cg * 16 + j) * VP + key] = (bf16_t)(cvt_pk_bf16(x[j], 0.f) & 0xffffu);
            float* dst = nullptr;
            if (SAMPLE) { if (key >= 16 && key < 144) dst = p->out + O_SV + ((size_t)(b * 128 + key - 16) * 2 + hk) * 128 + cg * 16; }
            else { if (n >= 62 && key >= 128) dst = p->out + O_PV + ((size_t)(b * 128 + (n - 62) * 64 + key - 128) * 2 + hk) * 128 + cg * 16; }
            if (dst) {
#pragma unroll
                for (int q = 0; q < 4; ++q) *(f32x4*)(dst + q * 4) = (f32x4){x[q * 4], x[q * 4 + 1], x[q * 4 + 2], x[q * 4 + 3]}; }
        }
    }
    __syncthreads();
    if (wave * 32 < NQ * 4) {
        const float* qnw = p->in[18];
        int hq[2], mrow[2], iq[2]; float slope[2], sink[2];
        bf16x8 QF[2][4];
#pragma unroll
        for (int nt2 = 0; nt2 < 2; ++nt2) {
            const int rho = wave * 32 + nt2 * 16 + fr; const int g = rho / NQ; iq[nt2] = rho % NQ; hq[nt2] = hk * 4 + g; mrow[nt2] = mq0 + iq[nt2];
            slope[nt2] = exp2f(-(float)(hq[nt2] + 1)); sink[nt2] = p->in[20][hq[nt2]];
        }
        { u32x4 qr[2][4];
#pragma unroll
          for (int nt2 = 0; nt2 < 2; ++nt2)
#pragma unroll
              for (int kk = 0; kk < 4; ++kk) qr[nt2][kk] = *(const u32x4*)(PROJ + (size_t)mrow[nt2] * NPROJ + 4096 + hq[nt2] * 128 + kk * 32 + kq * 8);
#pragma unroll
          for (int nt2 = 0; nt2 < 2; ++nt2) { float qx[4][8]; float ss = 0.f;
#pragma unroll
              for (int kk = 0; kk < 4; ++kk) { unpack8(qr[nt2][kk], qx[kk]);
#pragma unroll
                  for (int j = 0; j < 8; ++j) ss += qx[kk][j] * qx[kk][j]; }
              ss += __shfl_xor(ss, 16); ss += __shfl_xor(ss, 32);
              const float sc = rsqrtf(ss * (1.0f / 128.f) + EPS) * 0.08838834764831845f;
#pragma unroll
              for (int kk = 0; kk < 4; ++kk) { float w[8];
#pragma unroll
                  for (int j = 0; j < 8; ++j) w[j] = qx[kk][j] * sc * qnw[kk * 32 + kq * 8 + j];
                  u32x4 pk; pk.x = cvt_pk_bf16(w[0], w[1]); pk.y = cvt_pk_bf16(w[2], w[3]); pk.z = cvt_pk_bf16(w[4], w[5]); pk.w = cvt_pk_bf16(w[6], w[7]); QF[nt2][kk] = as_bf16x8(pk); } } }
        bf16x8 PB[2][NT / 2];
#pragma unroll
        for (int nt2 = 0; nt2 < 2; ++nt2) {
            f32x4 st[NT]; float mx = sink[nt2];
#pragma unroll
            for (int mt = 0; mt < NT; mt += 2) {
                __builtin_amdgcn_sched_barrier(0);
                f32x4 a0 = {0.f, 0.f, 0.f, 0.f}, a1 = {0.f, 0.f, 0.f, 0.f};
#pragma unroll
                for (int kk = 0; kk < 4; ++kk) { const bf16x8 k0 = *(const bf16x8*)(KS + (16 * mt + fr) * 136 + kk * 32 + kq * 8), k1 = *(const bf16x8*)(KS + (16 * mt + 16 + fr) * 136 + kk * 32 + kq * 8);
                    a0 = __builtin_amdgcn_mfma_f32_16x16x32_bf16(k0, QF[nt2][kk], a0, 0, 0, 0); a1 = __builtin_amdgcn_mfma_f32_16x16x32_bf16(k1, QF[nt2][kk], a1, 0, 0, 0); }
                int ib = iq[nt2] + 128 - 4 * kq; asm volatile("" : "+v"(ib));
#pragma unroll
                for (int r = 0; r < 4; ++r) { const int key = 16 * mt + 4 * kq + r; bool v0 = key < SPAN, v1 = key + 16 < SPAN; if (!SAMPLE) { v0 = v0 && (n * 64 - 128 + key >= 0); v1 = v1 && (n * 64 - 112 + key >= 0); }
                    const float s0 = v0 ? a0[r] - slope[nt2] * fabsf((float)(ib - (16 * mt + r))) : -INFINITY, s1 = v1 ? a1[r] - slope[nt2] * fabsf((float)(ib - (16 * mt + 16 + r))) : -INFINITY;
                    a0[r] = s0; a1[r] = s1; mx = fmaxf(mx, fmaxf(s0, s1)); }
                st[mt] = a0; st[mt + 1] = a1;
            }
            __builtin_amdgcn_sched_barrier(0);
            mx = fmaxf(mx, __shfl_xor(mx, 16)); mx = fmaxf(mx, __shfl_xor(mx, 32));
            float sum = 0.f;
#pragma unroll
            for (int mt = 0; mt < NT; ++mt)
#pragma unroll
                for (int r = 0; r < 4; ++r) { const float e = __expf(st[mt][r] - mx); st[mt][r] = e; sum += e; }
            sum += __shfl_xor(sum, 16); sum += __shfl_xor(sum, 32);
            const float inv = __builtin_amdgcn_rcpf(sum + __expf(sink[nt2] - mx));
#pragma unroll
            for (int kc = 0; kc < NT / 2; ++kc) { u32x4 pk; pk.x = cvt_pk_bf16(st[2 * kc][0] * inv, st[2 * kc][1] * inv); pk.y = cvt_pk_bf16(st[2 * kc][2] * inv, st[2 * kc][3] * inv);
                pk.z = cvt_pk_bf16(st[2 * kc + 1][0] * inv, st[2 * kc + 1][1] * inv); pk.w = cvt_pk_bf16(st[2 * kc + 1][2] * inv, st[2 * kc + 1][3] * inv); PB[nt2][kc] = as_bf16x8(pk); }
        }
#pragma unroll
        for (int dt = 0; dt < 8; ++dt) {
            __builtin_amdgcn_sched_barrier(0);
            f32x4 o0 = {0.f, 0.f, 0.f, 0.f}, o1 = {0.f, 0.f, 0.f, 0.f};
#pragma unroll
            for (int kc = 0; kc < NT / 2; ++kc) { const u32x2 lo = *(const u32x2*)(VT + (16 * dt + fr) * VP + 32 * kc + 4 * kq), hi = *(const u32x2*)(VT + (16 * dt + fr) * VP + 32 * kc + 16 + 4 * kq);
                u32x4 va; va.x = lo.x; va.y = lo.y; va.z = hi.x; va.w = hi.y;
                o0 = __builtin_amdgcn_mfma_f32_16x16x32_bf16(as_bf16x8(va), PB[0][kc], o0, 0, 0, 0); o1 = __builtin_amdgcn_mfma_f32_16x16x32_bf16(as_bf16x8(va), PB[1][kc], o1, 0, 0, 0); }
            u32x2 ow; ow.x = cvt_pk_bf16(o0[0], o0[1]); ow.y = cvt_pk_bf16(o0[2], o0[3]);
            *(u32x2*)(OM + (size_t)mrow[0] * D + 1024 + hq[0] * 128 + 16 * dt + 4 * kq) = ow;
            ow.x = cvt_pk_bf16(o1[0], o1[1]); ow.y = cvt_pk_bf16(o1[2], o1[3]);
            *(u32x2*)(OM + (size_t)mrow[1] * D + 1024 + hq[1] * 128 + 16 * dt + 4 * kq) = ow;
        }
    }
}

__device__ __forceinline__ void phase3(PP p, unsigned char* smem) {
#ifndef P3_MASK
#define P3_MASK 15
#endif
    const int bid = blockIdx.x, G = gridDim.x;
#ifndef P3_REP
#define P3_REP 0
#endif
    if (P3_MASK & 1) {
        unsigned* cnt = (unsigned*)(smem + 36352) ;
        if (threadIdx.x < 2) cnt[threadIdx.x] = 0u;
        __syncthreads();
        const int team = threadIdx.x >> 8; unsigned bt = 0u;
        for (int r_ = 0; r_ < 1 + (P3_REP & 1); ++r_) for (int it = bid + G * team; it < 2048; it += 2 * G) gdn_prep(p, it, smem + team * TEAM_LDS, cnt + team, bt);
        __syncthreads();
    }
    if (P3_MASK & 2) for (int r_ = 0; r_ < 1 + ((P3_REP >> 1) & 1); ++r_) for (int v = bid; v < 512; v += G) { const int u = (G == 256) ? (v & 7) * 64 + ((v >> 3) & 31) + 32 * (v >> 8) : v;
        swa_item<12, false>(p, u >> 7, (u >> 1) & 63, u & 1, smem); }
    if ((P3_MASK & 4) && G != 256) for (int u = bid; u < 256; u += G) gdn_sample(p, u, smem);
    if ((P3_MASK & 8) && G != 256) for (int u = G - 1 - bid; u < 64; u += G) swa_item<10, true>(p, u >> 1, 0, u & 1, smem);
}

__device__ __forceinline__ void scan_chunk(f32x4 (&S)[8], const unsigned char* cur, float gl, bf16_t* op0, int lane, int fr, int kq, int wave) {
#define FRAG(off, f) (*(const bf16x8*)(cur + (off) + (f) * 1024 + lane * 16))
    bf16x8 sB[4];
#pragma unroll
    for (int kk = 0; kk < 4; ++kk) { u32x4 pk; pk.x = cvt_pk_bf16(S[2 * kk][0], S[2 * kk][1]); pk.y = cvt_pk_bf16(S[2 * kk][2], S[2 * kk][3]); pk.z = cvt_pk_bf16(S[2 * kk + 1][0], S[2 * kk + 1][1]); pk.w = cvt_pk_bf16(S[2 * kk + 1][2], S[2 * kk + 1][3]); sB[kk] = as_bf16x8(pk); }
    bf16x8 Wf[16]; u32x2 uu[4];
#pragma unroll
    for (int f = 0; f < 16; ++f) Wf[f] = FRAG(CH_W, f);
#pragma unroll
    for (int mt = 0; mt < 4; ++mt) uu[mt] = *(const u32x2*)(cur + 57344 + (wave * 16 + fr) * 128 + (16 * mt + 4 * kq) * 2);
    __builtin_amdgcn_sched_barrier(0);
    f32x4 P[4], O[4];
#pragma unroll
    for (int mt = 0; mt < 4; ++mt) { P[mt] = (f32x4){0.f, 0.f, 0.f, 0.f}; O[mt] = (f32x4){0.f, 0.f, 0.f, 0.f}; }
    bf16x8 Gf[16];
#pragma unroll
    for (int kk = 0; kk < 4; ++kk) {
#pragma unroll
        for (int mt = 0; mt < 4; ++mt) { P[mt] = __builtin_amdgcn_mfma_f32_16x16x32_bf16(Wf[mt * 4 + kk], sB[kk], P[mt], 0, 0, 0); Gf[kk * 4 + mt] = FRAG(CH_QG, mt * 4 + kk); }
    }
    __builtin_amdgcn_sched_barrier(0);
    bf16x8 Kf[8], Df[16];
#pragma unroll
    for (int kk = 0; kk < 4; ++kk) {
#pragma unroll
        for (int mt = 0; mt < 4; ++mt) { O[mt] = __builtin_amdgcn_mfma_f32_16x16x32_bf16(Gf[kk * 4 + mt], sB[kk], O[mt], 0, 0, 0); if (kk < 2) Kf[kk * 4 + mt] = FRAG(CH_QK, mt * 2 + kk); else Df[(kk - 2) * 4 + mt] = FRAG(CH_KD, (kk - 2) * 4 + mt); }
    }
    f32x4 vn[4];
#pragma unroll
    for (int mt = 0; mt < 4; ++mt) vn[mt] = (f32x4){bf_lo(uu[mt].x) - P[mt][0], bf_hi(uu[mt].x) - P[mt][1], bf_lo(uu[mt].y) - P[mt][2], bf_hi(uu[mt].y) - P[mt][3]};
    bf16x8 vB[2];
#pragma unroll
    for (int kc = 0; kc < 2; ++kc) { u32x4 pk; pk.x = cvt_pk_bf16(vn[2 * kc][0], vn[2 * kc][1]); pk.y = cvt_pk_bf16(vn[2 * kc][2], vn[2 * kc][3]); pk.z = cvt_pk_bf16(vn[2 * kc + 1][0], vn[2 * kc + 1][1]); pk.w = cvt_pk_bf16(vn[2 * kc + 1][2], vn[2 * kc + 1][3]); vB[kc] = as_bf16x8(pk); }
    __builtin_amdgcn_sched_barrier(0);
#pragma unroll
    for (int kc = 0; kc < 2; ++kc) {
#pragma unroll
        for (int mt = 0; mt < 4; ++mt) { O[mt] = __builtin_amdgcn_mfma_f32_16x16x32_bf16(Kf[kc * 4 + mt], vB[kc], O[mt], 0, 0, 0); Df[8 + kc * 4 + mt] = FRAG(CH_KD, 8 + kc * 4 + mt); }
    }
#pragma unroll
    for (int d = 0; d < 8; ++d) S[d] = S[d] * gl;
    __builtin_amdgcn_sched_barrier(0);
#pragma unroll
    for (int kc = 0; kc < 2; ++kc) {
#pragma unroll
        for (int d = 0; d < 8; ++d) S[d] = __builtin_amdgcn_mfma_f32_16x16x32_bf16(Df[d * 2 + kc], vB[kc], S[d], 0, 0, 0);
    }
#pragma unroll
    for (int mt = 0; mt < 4; ++mt) { bf16_t* op = op0 + (size_t)(16 * mt) * D;
#pragma unroll
        for (int r = 0; r < 4; ++r) op[(size_t)r * D] = (bf16_t)(cvt_pk_bf16(O[mt][r], 0.f) & 0xffffu); }
#undef FRAG
}
__device__ __forceinline__ void phase4(PP p, unsigned char* smem) {
    const int tid = threadIdx.x, lane = tid & 63, wave = tid >> 6, fr = lane & 15, kq = lane >> 4;
    bf16_t* OM = (bf16_t*)(p->ws + WS_H);
    constexpr int NCW = 2, NS = 8 / NCW, USL = 2048 * NCW, BUF = 57344 + USL;
    if (gridDim.x == 256 && blockIdx.x >= 128) { const ConvPtrs cp = conv_ptrs(p); gdn_sample(p, (int)blockIdx.x - 128, smem); gdn_sample(p, (int)blockIdx.x, smem);
        if (blockIdx.x < 192) { const int u = (int)blockIdx.x - 128; swa_item<10, true>(p, u >> 1, 0, u & 1, smem); }
        else { __syncthreads(); convert_seq(cp, 0, 0, (int)blockIdx.x - 192, 64, 512, 0, 3712, (float*)smem); }
        return; }
    for (int item = blockIdx.x; item < 32 * NS; item += gridDim.x) {
        const int xcd = item & 7, iw = item >> 3; const int bh = xcd * 4 + iw / NS, ds = iw % NS; const int b = bh >> 3, h = bh & 7, dvb = ds * 16 * NCW, dv0 = dvb + (wave < NCW ? wave : 0) * 16;
        const unsigned char* rec0 = p->ws + WS_GDN + (size_t)(bh * 64) * CH_BYTES;
        f32x4 S[8];
#pragma unroll
        for (int d = 0; d < 8; ++d) S[d] = (f32x4){0.f, 0.f, 0.f, 0.f};
        u32x4 sa[8], sb[8];
#define SC_LOAD(st, c) do { const unsigned char* r_ = rec0 + (size_t)(c) * CH_BYTES; _Pragma("unroll") for (int i = 0; i < 7; ++i) st[i] = *(const u32x4*)(r_ + (size_t)(i * 512 + tid) * 16); \
        if (tid < 128 * NCW) st[7] = *(const u32x4*)(r_ + CH_UT + (size_t)dvb * 128 + tid * 16); } while (0)
#define SC_STORE(st, buf) do { unsigned char* d_ = smem + (buf) * BUF; _Pragma("unroll") for (int i = 0; i < 7; ++i) *(u32x4*)(d_ + (size_t)(i * 512 + tid) * 16) = st[i]; \
        if (tid < 128 * NCW) *(u32x4*)(d_ + 57344 + tid * 16) = st[7]; } while (0)
        __syncthreads();
        const int glv = __builtin_bit_cast(int, *(const float*)(rec0 + (size_t)lane * CH_BYTES + CH_GL));
        SC_LOAD(sa, 0); SC_LOAD(sb, 1);
        SC_STORE(sa, 0);
        __syncthreads();
        bf16_t* opb = OM + (size_t)(b * LP + 4 * kq) * D + h * 128 + dv0 + fr;
        for (int n = 0; n < 64; n += 2) {
            if (n + 2 < 64) SC_LOAD(sa, n + 2);
            if (wave < NCW) scan_chunk(S, smem, __builtin_bit_cast(float, __builtin_amdgcn_readlane(glv, n)), opb + (size_t)(n * 64) * D, lane, fr, kq, wave);
            SC_STORE(sb, 1);
            __syncthreads();
            if (n + 3 < 64) SC_LOAD(sb, n + 3);
            if (wave < NCW) scan_chunk(S, smem + BUF, __builtin_bit_cast(float, __builtin_amdgcn_readlane(glv, n + 1)), opb + (size_t)((n + 1) * 64) * D, lane, fr, kq, wave);
            if (n + 2 < 64) SC_STORE(sa, 0);
            __syncthreads();
        }
#undef SC_LOAD
#undef SC_STORE
        if (wave < NCW) {
            float* pd = p->out + O_PDELTA + (size_t)bh * 128 * 128;
#pragma unroll
            for (int d = 0; d < 8; ++d)
#pragma unroll
                for (int r = 0; r < 4; ++r) pd[(size_t)(16 * d + 4 * kq + r) * 128 + dv0 + fr] = S[d][r];
        }
    }
}

__device__ __forceinline__ void phase5(PP p) {
    const bf16_t* PROJ = (const bf16_t*)(p->ws + WS_PROJ); bf16_t* OM = (bf16_t*)(p->ws + WS_H);
    const int tid = threadIdx.x, sub = tid & 15, grp = tid >> 4;
    const float* gw = p->in[17];
    for (int pr = blockIdx.x * 32 + grp; pr < MP * 8; pr += gridDim.x * 32) {
        const int m = pr >> 3, h = pr & 7;
        bf16_t* op = OM + (size_t)m * D + h * 128 + sub * 8;
        float o[8], z[8]; unpack8(*(const u32x4*)op, o); unpack8(*(const u32x4*)(PROJ + (size_t)m * NPROJ + 3072 + h * 128 + sub * 8), z);
        float ss = 0.f;
#pragma unroll
        for (int j = 0; j < 8; ++j) ss += o[j] * o[j];
        ss += __shfl_xor(ss, 1); ss += __shfl_xor(ss, 2); ss += __shfl_xor(ss, 4); ss += __shfl_xor(ss, 8);
        const float rs = rsqrtf(ss * (1.0f / 128.f) + EPS);
        float w[8];
#pragma unroll
        for (int j = 0; j < 8; ++j) w[j] = o[j] * rs * gw[sub * 8 + j] * silu_f(z[j]);
        u32x4 pk; pk.x = cvt_pk_bf16(w[0], w[1]); pk.y = cvt_pk_bf16(w[2], w[3]); pk.z = cvt_pk_bf16(w[4], w[5]); pk.w = cvt_pk_bf16(w[6], w[7]);
        *(u32x4*)op = pk;
    }
}

__device__ __forceinline__ void phase9(PP p) {
    const float* HEAD = (const float*)(p->ws + WS_HEAD); const float* HALO = (const float*)(p->ws + WS_HALO); const float* US = (const float*)(p->ws + WS_US);
    bf16_t* ACT = (bf16_t*)(p->ws + WS_PROJ); const float* cw = p->in[23]; const float* cb = p->in[24]; const float* st = p->in[6]; float* outp = p->out;
    const int gt = blockIdx.x * NTHR + threadIdx.x, gs = gridDim.x * NTHR;
    constexpr int FQ = FF / 4, FQ2 = FF2 / 4;
    const f32x4 z4 = {0.f, 0.f, 0.f, 0.f};
    for (int e = gt; e < 256 * 2 * FQ; e += gs) {
        const int c = (e % FQ) * 4, rr = (e / FQ) & 1, blk = e / (2 * FQ);
        const bool first = (blk & 63) == 0;
        f32x4 uc[2];
#pragma unroll
        for (int s = 0; s < 2; ++s) { const int cu = c + s * FF;
            const f32x4 u0 = *(const f32x4*)(HEAD + (size_t)(blk * 2 + rr) * FF2 + cu);
            const float* h1 = first ? HEAD : HALO + (size_t)((blk - 1) * 2 + 1) * FF2; const float* h0 = first ? HEAD : HALO + (size_t)((blk - 1) * 2) * FF2;
            const f32x4 a1 = *(const f32x4*)(h1 + cu), a0 = *(const f32x4*)(h0 + cu), hd0 = *(const f32x4*)(HEAD + (size_t)(blk * 2) * FF2 + cu);
            const f32x4 u1 = rr == 0 ? (first ? z4 : a1) : hd0;
            const f32x4 u2 = rr == 0 ? (first ? z4 : a0) : (first ? z4 : a1);
            uc[s] = *(const f32x4*)(cw + 2 * FF2 + cu) * u0 + *(const f32x4*)(cw + FF2 + cu) * u1 + *(const f32x4*)(cw + cu) * u2 + *(const f32x4*)(cb + cu); }
        u32x2 w; w.x = cvt_pk_bf16(silu_f(uc[0][0]) * uc[1][0], silu_f(uc[0][1]) * uc[1][1]); w.y = cvt_pk_bf16(silu_f(uc[0][2]) * uc[1][2], silu_f(uc[0][3]) * uc[1][3]);
        *(u32x2*)(ACT + (size_t)(blk * 64 + rr) * FF + c) = w;
    }
    for (int e = gt; e < MS * FQ; e += gs) {
        const int c = (e % FQ) * 4, row = e / FQ, b = row >> 4, t = row & 15;
        f32x4 uc[2];
#pragma unroll
        for (int s = 0; s < 2; ++s) { const int cu = c + s * FF;
            const f32x4 u0 = *(const f32x4*)(US + (size_t)row * FF2 + cu);
            const f32x4 u1 = *(const f32x4*)((t >= 1 ? US + (size_t)(row - 1) * FF2 : st + (size_t)(b * 2 + 1) * FF2) + cu);
            const f32x4 u2 = *(const f32x4*)((t >= 2 ? US + (size_t)(row - 2) * FF2 : st + (size_t)(b * 2 + t) * FF2) + cu);
            uc[s] = *(const f32x4*)(cw + 2 * FF2 + cu) * u0 + *(const f32x4*)(cw + FF2 + cu) * u1 + *(const f32x4*)(cw + cu) * u2 + *(const f32x4*)(cb + cu); }
        u32x2 w; w.x = cvt_pk_bf16(silu_f(uc[0][0]) * uc[1][0], silu_f(uc[0][1]) * uc[1][1]); w.y = cvt_pk_bf16(silu_f(uc[0][2]) * uc[1][2], silu_f(uc[0][3]) * uc[1][3]);
        *(u32x2*)(ACT + (size_t)(MP + row) * FF + c) = w;
    }
    for (int e = gt; e < 4 * 2 * FQ2; e += gs) { const int cu = (e % FQ2) * 4, rr = (e / FQ2) & 1, b = e / (2 * FQ2); *(f32x4*)(outp + O_PFFN + (size_t)e * 4) = *(const f32x4*)(HALO + (size_t)((b * 64 + 63) * 2 + rr) * FF2 + cu); }
    for (int e = gt; e < 32 * 2 * FQ2; e += gs) { const int cu = (e % FQ2) * 4, rr = (e / FQ2) & 1, b = e / (2 * FQ2); *(f32x4*)(outp + O_SFFN + (size_t)e * 4) = *(const f32x4*)(US + (size_t)(b * 16 + 14 + rr) * FF2 + cu); }
}

#define XB_TMO      128
#define XB_XCNT(j)  (256  + 64 * (j))
#define XB_XSUB(j)  (1280 + 64 * (j))
#define XB_XGEN(j)  (2304 + 64 * (j))
#define XB_TOP      3328
#define XB_TOPGEN   3392
#define XCD_BAR_WORDS 3456
#define XB_SPIN_CAP (1u << 18)
__device__ __forceinline__ unsigned xb_ld(unsigned* p)              { return __hip_atomic_load(p, __ATOMIC_RELAXED, __HIP_MEMORY_SCOPE_AGENT); }
__device__ __forceinline__ unsigned xb_add(unsigned* p, unsigned v) { return __hip_atomic_fetch_add(p, v, __ATOMIC_RELAXED, __HIP_MEMORY_SCOPE_AGENT); }
__device__ __forceinline__ unsigned xb_xcc_id() { return (unsigned)__builtin_amdgcn_s_getreg((3 << 11) | 20) & 0xFu; }
#define XB_SPIN(cond, bar) do { unsigned _sp = 0; while (cond) { __builtin_amdgcn_s_sleep(1); \
    if ((++_sp & 255u) == 0u) { if (xb_ld(&(bar)[XB_TMO])) break; if (_sp > XB_SPIN_CAP) { atomicAdd(&(bar)[XB_TMO], 1u); break; } } } } while (0)
struct XcdBarrier { unsigned* bar; unsigned x; volatile LAS unsigned* st; };
__device__ __forceinline__ bool sum_ok(unsigned* bar) { return xb_ld(&bar[XB_TMO]) == 0u; }
__device__ __forceinline__ XcdBarrier xcd_barrier_post(unsigned* bar, volatile LAS unsigned* st) {
    XcdBarrier b; b.bar = bar; b.x = xb_xcc_id(); b.st = st;
    if (threadIdx.x == 0) st[2] = xb_add(&bar[XB_XCNT(b.x)], 1u);
    return b;
}
__device__ __forceinline__ void xcd_barrier_complete(unsigned* bar, unsigned x, unsigned& nloc, unsigned& nx, unsigned& all32) {
    const unsigned G = gridDim.x * gridDim.y * gridDim.z;
    unsigned sum, cnt, mine, sp = 0u;
    for (;;) {
        sum = 0u; cnt = 0u; mine = 0u; all32 = 1u;
#pragma unroll
        for (unsigned j = 0; j < 16; ++j) { const unsigned c = xb_ld(&bar[XB_XCNT(j)]); sum += c; cnt += (c > 0u) ? 1u : 0u; mine = (j == x) ? c : mine; if (c != 0u && c != 32u) all32 = 0u; }
        if (sum == G) break;
        __builtin_amdgcn_s_sleep(1);
        if ((++sp & 255u) == 0u) { if (xb_ld(&bar[XB_TMO])) break; if (sp > XB_SPIN_CAP) { atomicAdd(&bar[XB_TMO], 1u); break; } }
    }
    nloc = mine > 0u ? mine : 1u; nx = cnt > 0u ? cnt : 1u;
}
__device__ __forceinline__ void xcd_barrier(const XcdBarrier& b) {
    asm volatile("s_waitcnt vmcnt(0)" ::: "memory");
    __syncthreads();
    if (threadIdx.x == 0) {
        unsigned* bar = b.bar;
        __builtin_amdgcn_s_waitcnt(0);
        unsigned nloc = b.st[0], nx = b.st[1];
        if (nloc == 0u) { unsigned all32 = 0u; xcd_barrier_complete(bar, b.x, nloc, nx, all32); b.st[0] = nloc; b.st[1] = nx; b.st[3] = (all32 != 0u && nx == 8u && sum_ok(bar)) ? 1u : 0u; }
        const unsigned old = xb_add(&bar[XB_XSUB(b.x)], 1u);
        const unsigned gen = old / nloc;
        if (old + 1u == (gen + 1u) * nloc) {
            __builtin_amdgcn_fence(__ATOMIC_RELEASE, "agent");
            asm volatile("s_waitcnt vmcnt(0)" ::: "memory");
            const unsigned og = xb_add(&bar[XB_TOP], 1u);
            const unsigned tg = og / nx;
            if (og + 1u == (tg + 1u) * nx) xb_add(&bar[XB_TOPGEN], 1u);
            else XB_SPIN(xb_ld(&bar[XB_TOPGEN]) == tg, bar);
            __builtin_amdgcn_fence(__ATOMIC_ACQUIRE, "agent");
            xb_add(&bar[XB_XGEN(b.x)], 1u);
            asm volatile("s_waitcnt vmcnt(0)" ::: "memory");
        } else {
            XB_SPIN(xb_ld(&bar[XB_XGEN(b.x)]) == gen, bar);
            __builtin_amdgcn_fence(__ATOMIC_ACQUIRE, "agent");
            asm volatile("s_waitcnt vmcnt(0)" ::: "memory");
        }
    }
    __syncthreads();
}

constexpr int N_PHASES = 12;
__global__ void __launch_bounds__(NTHR, 2) hybrid_fwd(Params p_) {
    extern __shared__ __attribute__((aligned(16))) unsigned char smem[];
    PP p = (PP)__builtin_amdgcn_kernarg_segment_ptr();
    const int lo = p->ph_lo, hi = p->ph_hi;
    const int G = gridDim.x;
    volatile LAS unsigned* bst = (volatile LAS unsigned*)((LAS unsigned char*)smem + LDS_BYTES - 16);
    XcdBarrier xbar; xbar.bar = (unsigned*)(p->ws + WS_BAR); xbar.x = 0; xbar.st = bst;
    if (hi - lo > 1) { if (threadIdx.x < 4) bst[threadIdx.x] = 0u; __syncthreads(); xbar = xcd_barrier_post((unsigned*)(p->ws + WS_BAR), bst); }
#ifndef PH_MASK
#define PH_MASK 0xfff
#endif
#define IN(k) (((PH_MASK >> (k)) & 1) && lo <= (k) && (k) < hi)
#ifndef REP_MASK
#define REP_MASK 0
#endif
#define VCU() ((bst[3] == 1u && (hi - lo > 1)) ? (int)(xbar.x + 8u * bst[2]) : (int)blockIdx.x)
#define LAUNDER() asm volatile("" : "+s"(p))
#define REP(k) for (int rep_ = 0; rep_ < 1 + ((REP_MASK >> (k)) & 1); ++rep_)
#define SEAM(k) do { if (IN(k) && IN((k) + 1)) { xcd_barrier(xbar); } } while (0)
    if (hi == 0x7fffffff) cg::this_grid().sync();
    LAUNDER();
    if (IN(0)) REP(0) phase0(p, smem);
    SEAM(0);
    LAUNDER();
    if (IN(1)) REP(1) norm_phase(p, p->in[0], p->in[1], p->in[11], 0, false);
    SEAM(1);
    LAUNDER();
    if (IN(2)) REP(2) { pg8::Gemm g{(const bf16_t*)(p->ws + WS_H), (const bf16_t*)(p->ws + WS_WIN), MT, NIN_PAD, D, D}; pg8::StaticOrder S; S.init(MT, NIN_PAD, G, VCU());
        Epi1 E{(bf16_t*)(p->ws + WS_PROJ), (float*)(p->ws + WS_AB)}; pg8::gemm_phase<Epi1, pg8::StaticOrder>((LAS unsigned char*)smem, g, S, E); }
    SEAM(2);
    LAUNDER();
    if (IN(3)) REP(3) phase3(p, smem);
    SEAM(3);
    LAUNDER();
    if (IN(4)) REP(4) phase4(p, smem);
    SEAM(4);
    LAUNDER();
    if (IN(5)) phase5(p);
    SEAM(5);
    LAUNDER();
    if (IN(6)) REP(6) { pg8::Gemm g{(const bf16_t*)(p->ws + WS_H), (const bf16_t*)(p->ws + WS_WO), MP, D, D, D}; pg8::StaticOrder S; S.init(MP, D, G, VCU());
        EpiRes E{p->in[0], p->in[1], p->out, (const float*)(p->ws + WS_MOD), 2}; pg8::gemm_phase<EpiRes, pg8::StaticOrder>((LAS unsigned char*)smem, g, S, E);
        pg8::Gemm g2{(const bf16_t*)(p->ws + WS_H) + (size_t)MP * D, (const bf16_t*)(p->ws + WS_WO), MS, D, 256, D}; pg8::SplitOrder S2; S2.init(MS, D, D / 256, G, VCU());
        EpiPart E2{(float*)(p->ws + WS_GDN)}; pg8::gemm_phase<EpiPart, pg8::SplitOrder>((LAS unsigned char*)smem, g2, S2, E2); }
    SEAM(6);
    LAUNDER();
    if (IN(7)) REP(7) norm_phase(p, p->out, p->in[1], p->in[12], 3, true);
    SEAM(7);
    LAUNDER();
    if (IN(8)) REP(8) { pg8::Gemm g{(const bf16_t*)(p->ws + WS_H), (const bf16_t*)(p->ws + WS_WUP), MT, FF2, D, D}; pg8::StaticOrder S; S.init(MT, FF2, G, VCU());
        Epi3 E{(bf16_t*)(p->ws + WS_PROJ), (float*)(p->ws + WS_HEAD), (float*)(p->ws + WS_HALO), (float*)(p->ws + WS_US), p->in[23], p->in[24]}; pg8::gemm_phase<Epi3, pg8::StaticOrder>((LAS unsigned char*)smem, g, S, E); }
    SEAM(8);
    LAUNDER();
    if (IN(9)) REP(9) phase9(p);
    SEAM(9);
    LAUNDER();
    if (IN(10)) { pg8::Gemm g{(const bf16_t*)(p->ws + WS_PROJ), (const bf16_t*)(p->ws + WS_WDN), MP, D, FF, FF}; pg8::StaticOrder S; S.init(MP, D, G, VCU());
        EpiRes E{p->out, p->out + (size_t)MP * D, p->out, (const float*)(p->ws + WS_MOD), 5}; pg8::gemm_phase<EpiRes, pg8::StaticOrder>((LAS unsigned char*)smem, g, S, E);
        pg8::Gemm g2{(const bf16_t*)(p->ws + WS_PROJ) + (size_t)MP * FF, (const bf16_t*)(p->ws + WS_WDN), MS, D, 512, FF}; pg8::SplitOrder S2; S2.init(MS, D, FF / 512, G, VCU());
        EpiPart E2{(float*)(p->ws + WS_GDN)}; pg8::gemm_phase<EpiPart, pg8::SplitOrder>((LAS unsigned char*)smem, g2, S2, E2); }
    SEAM(10);
    LAUNDER();
    if (IN(11)) {
        const float* part = (const float*)(p->ws + WS_GDN); const float* mod = (const float*)(p->ws + WS_MOD);
        for (int e = blockIdx.x * NTHR + threadIdx.x; e < MS * D / 4; e += G * NTHR) { const int row = e >> 9, c = (e & 511) * 4; f32x4 a = {0.f, 0.f, 0.f, 0.f};
#pragma unroll
            for (int sp = 0; sp < 11; ++sp) a += *(const f32x4*)(part + (size_t)sp * MS * D + (size_t)row * D + c);
            float* o = p->out + (size_t)(MP + row) * D + c; *(f32x4*)o = *(const f32x4*)o + *(const f32x4*)(mod + (size_t)(4 + (row >> 4)) * NMODW + 5 * D + c) * a; } }
#undef IN
#undef SEAM
}

extern "C" void kernel_launch(void* const* d_in, const int* in_sizes, int n_in, void* d_out, int out_size, void* d_ws, size_t ws_size, hipStream_t stream) {
    static int grid = 0;
    if (grid == 0) {
        if (n_in != 26 || (size_t)out_size != O_END || ws_size < WS_ALL) { fprintf(stderr, "kernel_launch: unexpected shapes (n_in %d out %d ws %zu)\n", n_in, out_size, ws_size); grid = -1; return; }
        int dev = 0, cus = 0, per_cu = 0;
        hipGetDevice(&dev); hipDeviceGetAttribute(&cus, hipDeviceAttributeMultiprocessorCount, dev);
        if (hipFuncSetAttribute((const void*)hybrid_fwd, hipFuncAttributeMaxDynamicSharedMemorySize, LDS_BYTES) != hipSuccess) { fprintf(stderr, "kernel_launch: hipFuncSetAttribute failed\n"); grid = -1; return; }
        if (hipOccupancyMaxActiveBlocksPerMultiprocessor(&per_cu, (const void*)hybrid_fwd, NTHR, LDS_BYTES) != hipSuccess || per_cu < 1) { fprintf(stderr, "kernel_launch: occupancy query says %d\n", per_cu); per_cu = 1; }
        (void)hipGetLastError();
        grid = cus * 1;
    }
    if (grid < 0) return;
    Params p{};
    for (int i = 0; i < 26; ++i) p.in[i] = (const float*)d_in[i];
    p.out = (float*)d_out; p.ws = (unsigned char*)d_ws;
#if N_LAUNCH_MODE == 1
    if (hipMemsetAsync((char*)d_ws + WS_BAR, 0, 16384, stream) != hipSuccess) { fprintf(stderr, "kernel_launch: memset failed\n"); return; }
    p.ph_lo = 0; p.ph_hi = N_PHASES;
    void* args[] = {&p};
    hipError_t e = hipLaunchCooperativeKernel((const void*)hybrid_fwd, dim3(grid), dim3(NTHR), args, LDS_BYTES, stream);
    if (e != hipSuccess) fprintf(stderr, "cooperative launch failed: %s (grid %d)\n", hipGetErrorString(e), grid);
#else
    for (int ph = 0; ph < N_PHASES; ++ph) { p.ph_lo = ph; p.ph_hi = ph + 1; hipLaunchKernelGGL(hybrid_fwd, dim3(grid), dim3(NTHR), LDS_BYTES, stream, p); }
#endif
}
```

```cpp
#include <hip/hip_runtime.h>
#include <hip/hip_cooperative_groups.h>
#include <cstdio>
#include <cstdint>
namespace cg = cooperative_groups;

#ifndef N_LAUNCH_MODE
#define N_LAUNCH_MODE 1
#endif

#define LAS __attribute__((address_space(3)))
typedef unsigned short bf16_t;
typedef short bf16x8 __attribute__((ext_vector_type(8)));
typedef float f32x4 __attribute__((ext_vector_type(4)));
typedef float f32x2 __attribute__((ext_vector_type(2)));
typedef unsigned u32x4 __attribute__((ext_vector_type(4)));
typedef unsigned u32x2 __attribute__((ext_vector_type(2)));

constexpr int D = 2048, MP = 16384, MS = 512, MT = MP + MS, LP = 4096, LS = 16, NBP = 4, NBS = 32;
constexpr int NPROJ = 5632, NIN_PAD = 5888, INW = 5648, FF = 5632, FF2 = 11264;
constexpr int NMODW = 12288;
constexpr float EPS = 1e-6f;
constexpr int NTHR = 512;
constexpr int LDS_BYTES = 163840;

constexpr size_t O_YP = 0, O_YS = O_YP + (size_t)MP * D, O_PCONV = O_YS + (size_t)MS * D, O_PDELTA = O_PCONV + 4 * 3 * 3072,
                 O_PK = O_PDELTA + (size_t)4 * 8 * 128 * 128, O_PV = O_PK + 4 * 128 * 2 * 128, O_PFFN = O_PV + 4 * 128 * 2 * 128,
                 O_SCONV = O_PFFN + 4 * 2 * FF2, O_SDELTA = O_SCONV + 32 * 3 * 3072, O_SK = O_SDELTA + (size_t)32 * 8 * 128 * 128,
                 O_SV = O_SK + 32 * 128 * 2 * 128, O_SFFN = O_SV + 32 * 128 * 2 * 128, O_END = O_SFFN + 32 * 2 * FF2;

constexpr size_t WS_WUP = 0, WS_WDN = WS_WUP + (size_t)FF2 * D * 2, WS_WIN = WS_WDN + (size_t)D * FF * 2, WS_WO = WS_WIN + (size_t)NIN_PAD * D * 2,
                 WS_MOD = WS_WO + (size_t)D * D * 2, WS_AB = WS_MOD + (size_t)36 * NMODW * 4, WS_H = WS_AB + (size_t)MT * 16 * 4,
                 WS_PROJ = WS_H + (size_t)MT * D * 2, WS_GDN = WS_PROJ + (size_t)MT * NPROJ * 2;
constexpr size_t CH_BYTES = 73984, CH_W = 0, CH_QG = 16384, CH_QK = 32768, CH_KD = 40960, CH_UT = 57344, CH_GL = 73728;
constexpr size_t WS_END = WS_GDN + (size_t)2048 * CH_BYTES;
constexpr size_t WS_HEAD = WS_GDN, WS_HALO = WS_HEAD + (size_t)256 * 2 * FF2 * 4, WS_US = WS_HALO + (size_t)256 * 2 * FF2 * 4;
static_assert(WS_US + (size_t)MS * FF2 * 4 <= WS_END, "ffn side buffers");
constexpr size_t WS_BAR = WS_END, WS_ALL = WS_BAR + 16384;
static_assert(WS_ALL <= (size_t)536870912, "workspace");

struct Params { const float* in[26]; float* out; unsigned char* ws; int ph_lo, ph_hi; };
typedef const __attribute__((address_space(4))) Params* PP;

typedef __bf16 bf16x2_t __attribute__((ext_vector_type(2)));
__device__ __forceinline__ unsigned cvt_pk_bf16(float lo, float hi) { f32x2 f = {lo, hi}; bf16x2_t v = __builtin_convertvector(f, bf16x2_t); return __builtin_bit_cast(unsigned, v); }
__device__ __forceinline__ float bf_lo(unsigned u) { return __uint_as_float(u << 16); }
__device__ __forceinline__ float bf_hi(unsigned u) { return __uint_as_float(u & 0xffff0000u); }
__device__ __forceinline__ float bf2f(bf16_t b) { return __uint_as_float(((unsigned)b) << 16); }
__device__ __forceinline__ float silu_f(float x) { return x * __builtin_amdgcn_rcpf(1.0f + __expf(-x)); }
__device__ __forceinline__ float sigmoid_f(float x) { return __builtin_amdgcn_rcpf(1.0f + __expf(-x)); }
__device__ __forceinline__ float softplus_f(float x) { return x > 20.f ? x : log1pf(__expf(x)); }
template <int CTRL> __device__ __forceinline__ float dpp0(float v) { return __builtin_bit_cast(float, __builtin_amdgcn_update_dpp(0, __builtin_bit_cast(int, v), CTRL, 0xf, 0xf, true)); }
__device__ __forceinline__ int cond_of_row(int m) { return m < MP ? (m >> 12) : 4 + ((m - MP) >> 4); }
__device__ __forceinline__ void unpack8(u32x4 v, float* f) { f[0] = bf_lo(v.x); f[1] = bf_hi(v.x); f[2] = bf_lo(v.y); f[3] = bf_hi(v.y); f[4] = bf_lo(v.z); f[5] = bf_hi(v.z); f[6] = bf_lo(v.w); f[7] = bf_hi(v.w); }
__device__ __forceinline__ bf16x8 as_bf16x8(u32x4 v) { return __builtin_bit_cast(bf16x8, v); }

namespace pg8 {
constexpr int BM = 256, BK = 64, HALF = 128, HTB = HALF * BK * 2, STAGE_BYTES = 8 * HTB, NXCD = 8, WGM = 2;
__host__ __device__ __forceinline__ int lds_byte(int r, int c) { const int st = (r >> 4) * 2 + (c >> 5), rr = r & 15, cc = c & 31, ob = rr * 64 + cc * 2; return st * 1024 + (ob ^ (((ob >> 9) & 1) << 5)); }
__host__ __device__ __forceinline__ void stage_rc(int b, int& R, int& C) { const int st = b / 1024, sb = b % 1024, swz = sb ^ (((sb >> 9) & 1) << 5); R = (st >> 1) * 16 + swz / 64; C = (st & 1) * 32 + (swz % 64) / 2; }
struct Unit { int pm, pn, ks; };
struct Gemm { const bf16_t* A; const bf16_t* Bt; int M, N, K, ldk; };
struct StaticOrder {
    int nM, nN, nwg, G, c;
    __host__ __device__ __forceinline__ void init(int M, int N, int G_, int c_) { nM = M / BM; nN = N / BM; nwg = nM * nN; G = G_; c = c_; }
    __host__ __device__ bool next(int i, Unit& u) const {
        const long L = (long)i * G + c; if (L >= nwg) return false;
        int wgid = (int)L; { const int q = nwg / NXCD, r = nwg % NXCD, xcd = wgid % NXCD, off = wgid / NXCD; wgid = (xcd < r ? xcd * (q + 1) : r * (q + 1) + (xcd - r) * q) + off; }
        const int nig = WGM * nN, gid = wgid / nig, fm = gid * WGM, gsz = (nM - fm) < WGM ? (nM - fm) : WGM;
        u.pm = fm + ((wgid % nig) % gsz); u.pn = (wgid % nig) / gsz; u.ks = 0; return true;
    }
};
struct SplitOrder {
    int nM, nN, nS, nwg, G, c;
    __host__ __device__ __forceinline__ void init(int M, int N, int nS_, int G_, int c_) { nM = M / BM; nN = N / BM; nS = nS_; nwg = nM * nN * nS; G = G_; c = c_; }
    __host__ __device__ bool next(int i, Unit& u) const {
        const long L = (long)i * G + c; if (L >= nwg) return false;
        const int l = (int)L; u.ks = l % nS; const int t = l / nS; u.pn = t % nN; u.pm = t / nN; return true;
    }
};

template <class Epi, class Sched>
__device__ __forceinline__ void gemm_phase(LAS unsigned char* lds, const Gemm g, const Sched& S, const Epi& E) {
    const int tid = threadIdx.x, wid = __builtin_amdgcn_readfirstlane(tid >> 6), lane = tid & 63, wr = wid >> 2, wc = wid & 3, fr = lane & 15, fq = lane >> 4;
    const int K = g.ldk, nt = g.K / BK;
    const size_t sstep = (size_t)g.K * 2;
    unsigned voffA[2];
#pragma unroll
    for (int i = 0; i < 2; ++i) { int R, C; stage_rc(tid * 16 + i * 8192, R, C); voffA[i] = (unsigned)(R * K + C) * 2u; }
    const size_t kstep = (size_t)(BK * 2);
    const size_t hstep = (size_t)HALF * K * 2;
    const size_t tstep = 2 * hstep;
    const unsigned ldsw = (unsigned)wid * 1024u;
    const int aoff = lds_byte(wr * 64 + fr, fq * 8), boff = lds_byte(wc * 32 + fr, fq * 8);
#define PG8_SA(b, h) (((b) * 2 + (h)) * HTB)
#define PG8_SB(b, h) ((4 + (b) * 2 + (h)) * HTB)
#define PG8_STAGE(bufoff, gbase, voff) do { _Pragma("unroll") for (int _i = 0; _i < 2; ++_i) \
        __builtin_amdgcn_global_load_lds((const unsigned*)((const char*)(gbase) + (voff)[_i]), (LAS unsigned*)(lds + (bufoff) + ldsw + _i * 8192), 16, 0, 0); } while (0)
#define PG8_LDA(dst, b, h) do { _Pragma("unroll") for (int m = 0; m < 4; ++m) _Pragma("unroll") for (int k = 0; k < 2; ++k) dst[m][k] = *(const LAS bf16x8*)(lds + PG8_SA(b, h) + aoff + m * 2048 + k * 1024); } while (0)
#define PG8_LDB(dst, b, h) do { _Pragma("unroll") for (int n = 0; n < 2; ++n) _Pragma("unroll") for (int k = 0; k < 2; ++k) dst[n][k] = *(const LAS bf16x8*)(lds + PG8_SB(b, h) + boff + n * 2048 + k * 1024); } while (0)
#define PG8_MMA(ai, bj, At, Bt) do { __builtin_amdgcn_s_setprio(1); _Pragma("unroll") for (int m = 0; m < 4; ++m) _Pragma("unroll") for (int n = 0; n < 2; ++n) _Pragma("unroll") for (int k = 0; k < 2; ++k) \
        acc[ai][bj][m][n] = __builtin_amdgcn_mfma_f32_16x16x32_bf16(Bt[n][k], At[m][k], acc[ai][bj][m][n], 0, 0, 0); __builtin_amdgcn_s_setprio(0); } while (0)
#define PG8_WAIT_V(n) asm volatile("s_waitcnt vmcnt(" #n ")" ::: "memory")
#define PG8_WAIT_L(n) asm volatile("s_waitcnt lgkmcnt(" #n ")" ::: "memory")
#define PG8_BAR __builtin_amdgcn_s_barrier()
#define PG8_SCHED __builtin_amdgcn_sched_barrier(0)
    Unit cur, nxt; int ui = 0;
    if (!S.next(0, cur)) return;
    f32x4 acc[2][2][4][2];
#pragma unroll
    for (int a = 0; a < 2; ++a)
#pragma unroll
        for (int b = 0; b < 2; ++b)
#pragma unroll
            for (int m = 0; m < 4; ++m)
#pragma unroll
                for (int n = 0; n < 2; ++n) acc[a][b][m][n] = (f32x4){0.f, 0.f, 0.f, 0.f};
    bf16x8 At[4][2], B0[2][2], B1[2][2];
    const char* cA = (const char*)g.A + (size_t)cur.pm * tstep + cur.ks * sstep; const char* cB = (const char*)g.Bt + (size_t)cur.pn * tstep + cur.ks * sstep;
    PG8_STAGE(PG8_SB(0, 0), cB, voffA); PG8_STAGE(PG8_SA(0, 0), cA, voffA); PG8_STAGE(PG8_SB(0, 1), cB + hstep, voffA); PG8_STAGE(PG8_SA(0, 1), cA + hstep, voffA);
    if (wr == 1) PG8_BAR;
    PG8_WAIT_V(4); PG8_BAR;
    PG8_STAGE(PG8_SB(1, 0), cB + kstep, voffA); PG8_STAGE(PG8_SA(1, 0), cA + kstep, voffA); PG8_STAGE(PG8_SB(1, 1), cB + hstep + kstep, voffA);
    PG8_WAIT_V(6); PG8_BAR;
    for (;;) {
        const bool has_next = S.next(ui + 1, nxt);
        const char* nA = has_next ? (const char*)g.A + (size_t)nxt.pm * tstep + nxt.ks * sstep : cA; const char* nB = has_next ? (const char*)g.Bt + (size_t)nxt.pn * tstep + nxt.ks * sstep : cB;
        for (int t = 0; t < nt; t += 2) {
            const bool last = (t == nt - 2);
            const char* a1 = cA + (size_t)(t + 1) * kstep;
            const char* a2 = last ? nA : cA + (size_t)(t + 2) * kstep; const char* b2 = last ? nB : cB + (size_t)(t + 2) * kstep;
            const char* a3 = a2 + kstep; const char* b3 = b2 + kstep;
            PG8_LDB(B0, 0, 0); PG8_SCHED; PG8_LDA(At, 0, 0); PG8_STAGE(PG8_SA(1, 1), a1 + hstep, voffA);
            PG8_WAIT_L(8); PG8_BAR; PG8_WAIT_L(0); PG8_MMA(0, 0, At, B0); PG8_BAR; PG8_SCHED;
            PG8_LDB(B1, 0, 1); PG8_STAGE(PG8_SB(0, 0), b2, voffA);
            PG8_BAR; PG8_WAIT_L(0); PG8_MMA(0, 1, At, B1); PG8_BAR;
            PG8_LDA(At, 0, 1); PG8_STAGE(PG8_SA(0, 0), a2, voffA);
            PG8_BAR; PG8_WAIT_L(0); PG8_MMA(1, 0, At, B0); PG8_BAR; PG8_SCHED;
            PG8_STAGE(PG8_SB(0, 1), b2 + hstep, voffA);
            PG8_WAIT_V(6); PG8_BAR; PG8_MMA(1, 1, At, B1); PG8_BAR;
            PG8_LDB(B0, 1, 0); PG8_SCHED; PG8_LDA(At, 1, 0); PG8_STAGE(PG8_SA(0, 1), a2 + hstep, voffA);
            PG8_WAIT_L(8); PG8_BAR; PG8_WAIT_L(0); PG8_MMA(0, 0, At, B0); PG8_BAR; PG8_SCHED;
            PG8_LDB(B1, 1, 1); PG8_STAGE(PG8_SB(1, 0), b3, voffA);
            PG8_BAR; PG8_WAIT_L(0); PG8_MMA(0, 1, At, B1); PG8_BAR;
            PG8_LDA(At, 1, 1); PG8_STAGE(PG8_SA(1, 0), a3, voffA);
            PG8_BAR; PG8_WAIT_L(0); PG8_MMA(1, 0, At, B0); PG8_BAR; PG8_SCHED;
            PG8_STAGE(PG8_SB(1, 1), b3 + hstep, voffA);
            PG8_WAIT_V(6); PG8_BAR; PG8_MMA(1, 1, At, B1); PG8_BAR;
        }
        E(acc, cur, wr, wc, fr, fq);
        if (!has_next) break;
#pragma unroll
        for (int a = 0; a < 2; ++a)
#pragma unroll
            for (int b = 0; b < 2; ++b)
#pragma unroll
                for (int m = 0; m < 4; ++m)
#pragma unroll
                    for (int n = 0; n < 2; ++n) acc[a][b][m][n] = (f32x4){0.f, 0.f, 0.f, 0.f};
        cur = nxt; cA = nA; cB = nB; ++ui;
    }
    PG8_WAIT_V(0);
    if (wr == 0) PG8_BAR;
    PG8_BAR;
#undef PG8_SA
#undef PG8_SB
#undef PG8_STAGE
#undef PG8_LDA
#undef PG8_LDB
#undef PG8_MMA
#undef PG8_WAIT_V
#undef PG8_WAIT_L
#undef PG8_BAR
#undef PG8_SCHED
}
}
using pg8::Unit;

struct Epi1 {
    bf16_t* P; float* AB;
    __device__ __forceinline__ void operator()(const f32x4 (&acc)[2][2][4][2], const Unit& u, int wr, int wc, int fr, int fq) const {
        const int row0 = u.pm * 256 + wr * 64 + fr;
        if (u.pn < 22) {
            const int col0 = u.pn * 256 + wc * 32 + 4 * fq;
#pragma unroll
            for (int ai = 0; ai < 2; ++ai)
#pragma unroll
                for (int m = 0; m < 4; ++m) { bf16_t* rowp = P + (size_t)(row0 + ai * 128 + m * 16) * NPROJ + col0;
#pragma unroll
                    for (int bj = 0; bj < 2; ++bj)
#pragma unroll
                        for (int n = 0; n < 2; ++n) { const f32x4 a = acc[ai][bj][m][n]; u32x2 w; w.x = cvt_pk_bf16(a[0], a[1]); w.y = cvt_pk_bf16(a[2], a[3]); *(u32x2*)(rowp + bj * 128 + n * 16) = w; } }
        } else if (wc == 0) {
#pragma unroll
            for (int ai = 0; ai < 2; ++ai)
#pragma unroll
                for (int m = 0; m < 4; ++m) *(f32x4*)(AB + (size_t)(row0 + ai * 128 + m * 16) * 16 + 4 * fq) = acc[ai][0][m][0];
        }
    }
};
struct EpiRes {
    const float* xa; const float* xb; float* out; const float* mod; int gi;
    __device__ __forceinline__ void operator()(const f32x4 (&acc)[2][2][4][2], const Unit& u, int wr, int wc, int fr, int fq) const {
        const int row0 = u.pm * 256 + wr * 64 + fr, col0 = u.pn * 256 + wc * 32 + 4 * fq;
        const float* gr = mod + (size_t)cond_of_row(u.pm * 256) * NMODW + gi * D + col0;
        f32x4 g4[2][2];
#pragma unroll
        for (int bj = 0; bj < 2; ++bj)
#pragma unroll
            for (int n = 0; n < 2; ++n) g4[bj][n] = *(const f32x4*)(gr + bj * 128 + n * 16);
#pragma unroll
        for (int ai = 0; ai < 2; ++ai) {
            f32x4 xv[4][2][2];
#pragma unroll
            for (int m = 0; m < 4; ++m) { const float* xr = xa + (size_t)(row0 + ai * 128 + m * 16) * D + col0;
#pragma unroll
                for (int bj = 0; bj < 2; ++bj)
#pragma unroll
                    for (int n = 0; n < 2; ++n) xv[m][bj][n] = *(const f32x4*)(xr + bj * 128 + n * 16); }
            __builtin_amdgcn_sched_barrier(0);
#pragma unroll
            for (int m = 0; m < 4; ++m) { float* orow = out + (size_t)(row0 + ai * 128 + m * 16) * D + col0;
#pragma unroll
                for (int bj = 0; bj < 2; ++bj)
#pragma unroll
                    for (int n = 0; n < 2; ++n) *(f32x4*)(orow + bj * 128 + n * 16) = xv[m][bj][n] + g4[bj][n] * acc[ai][bj][m][n]; }
        }
    }
};
struct EpiPart {
    float* part;
    __device__ __forceinline__ void operator()(const f32x4 (&acc)[2][2][4][2], const Unit& u, int wr, int wc, int fr, int fq) const {
        const int row0 = u.pm * 256 + wr * 64 + fr, col0 = u.pn * 256 + wc * 32 + 4 * fq;
        float* base = part + (size_t)u.ks * MS * D;
#pragma unroll
        for (int ai = 0; ai < 2; ++ai)
#pragma unroll
            for (int m = 0; m < 4; ++m) { float* orow = base + (size_t)(row0 + ai * 128 + m * 16) * D + col0;
#pragma unroll
                for (int bj = 0; bj < 2; ++bj)
#pragma unroll
                    for (int n = 0; n < 2; ++n) *(f32x4*)(orow + bj * 128 + n * 16) = acc[ai][bj][m][n]; }
    }
};
struct Epi3 {
    bf16_t* ACT; float* HEAD; float* HALO; float* US; const float* cw; const float* cb;
    __device__ __forceinline__ void operator()(const f32x4 (&acc)[2][2][4][2], const Unit& u, int wr, int wc, int fr, int fq) const {
        const int cg0 = u.pn * 128 + wc * 32 + 4 * fq;
        if (u.pm >= 64) {
            const int row0 = (u.pm - 64) * 256 + wr * 64 + fr;
#pragma unroll
            for (int ai = 0; ai < 2; ++ai)
#pragma unroll
                for (int m = 0; m < 4; ++m) { float* rp = US + (size_t)(row0 + ai * 128 + m * 16) * FF2 + cg0;
#pragma unroll
                    for (int bj = 0; bj < 2; ++bj)
#pragma unroll
                        for (int n = 0; n < 2; ++n) *(f32x4*)(rp + bj * FF + n * 16) = acc[ai][bj][m][n]; }
            return;
        }
#pragma unroll
        for (int n = 0; n < 2; ++n) {
            const int cg = cg0 + n * 16;
            f32x4 w0[2], w1[2], w2[2], bb[2];
#pragma unroll
            for (int bj = 0; bj < 2; ++bj) { const int c = cg + bj * FF; w0[bj] = *(const f32x4*)(cw + c); w1[bj] = *(const f32x4*)(cw + FF2 + c); w2[bj] = *(const f32x4*)(cw + 2 * FF2 + c); bb[bj] = *(const f32x4*)(cb + c); }
#pragma unroll
            for (int ai = 0; ai < 2; ++ai) {
                const int blk = u.pm * 4 + ai * 2 + wr;
                const int rowb = blk * 64;
                f32x4 p15[2] = {{0.f, 0.f, 0.f, 0.f}, {0.f, 0.f, 0.f, 0.f}}, p14[2] = {{0.f, 0.f, 0.f, 0.f}, {0.f, 0.f, 0.f, 0.f}};
#pragma unroll
                for (int m = 0; m < 4; ++m) {
                    f32x4 uc[2];
#pragma unroll
                    for (int bj = 0; bj < 2; ++bj) { const f32x4 cur = acc[ai][bj][m][n]; f32x4 pr1, pr2, n15, n14;
#pragma unroll
                        for (int j = 0; j < 4; ++j) { pr1[j] = dpp0<0x111>(cur[j]) + p15[bj][j]; pr2[j] = dpp0<0x112>(cur[j]) + p14[bj][j]; n15[j] = dpp0<0x10F>(cur[j]); n14[j] = dpp0<0x10E>(cur[j]); }
                        p15[bj] = n15; p14[bj] = n14;
                        uc[bj] = w2[bj] * cur + w1[bj] * pr1 + w0[bj] * pr2 + bb[bj];
                        if (m == 0 && fr < 2) *(f32x4*)(HEAD + (size_t)(blk * 2 + fr) * FF2 + cg + bj * FF) = cur;
                        if (m == 3 && fr >= 14) *(f32x4*)(HALO + (size_t)(blk * 2 + fr - 14) * FF2 + cg + bj * FF) = cur;
                    }
                    if (m > 0 || fr >= 2) { u32x2 w; w.x = cvt_pk_bf16(silu_f(uc[0][0]) * uc[1][0], silu_f(uc[0][1]) * uc[1][1]); w.y = cvt_pk_bf16(silu_f(uc[0][2]) * uc[1][2], silu_f(uc[0][3]) * uc[1][3]);
                        *(u32x2*)(ACT + (size_t)(rowb + m * 16 + fr) * FF + cg) = w; }
                }
            }
        }
    }
};

struct TileDesc { const float* W; bf16_t* Wt; int K, N, k0, n0, sc0, nv; };
struct ConvPtrs { const float* up; const float* dn; const float* in; const float* o; unsigned char* ws; };
__device__ __forceinline__ ConvPtrs conv_ptrs(PP p) { ConvPtrs c; c.up = p->in[22]; c.dn = p->in[25]; c.in = p->in[13]; c.o = p->in[21]; c.ws = p->ws; return c; }
__device__ __forceinline__ TileDesc tile_desc(const float* up, const float* dn, const float* win, const float* wo, unsigned char* ws, int t) {
    constexpr int T_UP = 32 * 88, T_DN = 88 * 16, T_IN = 32 * 46;
    const int cls = t < T_UP ? 0 : t < T_UP + T_DN ? 1 : t < T_UP + T_DN + T_IN ? 2 : 3;
    const int u = t - (cls == 0 ? 0 : cls == 1 ? T_UP : cls == 2 ? T_UP + T_DN : T_UP + T_DN + T_IN);
    const int NTn = cls == 0 ? 88 : cls == 2 ? 46 : 16; const int q4 = u >> 2; const int nt = q4 % NTn, kt = (q4 / NTn) * 4 + (u & 3), n0 = nt * 128;
    TileDesc d;
    d.W = cls == 0 ? up : cls == 1 ? dn : cls == 2 ? win : wo;
    d.Wt = (bf16_t*)(ws + (cls == 0 ? WS_WUP : cls == 1 ? WS_WDN : cls == 2 ? WS_WIN : WS_WO));
    d.K = cls == 1 ? FF : D; d.N = cls == 0 ? FF2 : cls == 2 ? INW : D; d.k0 = kt * 64; d.n0 = n0;
    const int pn = n0 >> 8;
    d.sc0 = cls == 0 ? ((n0 & 255) < 128 ? 128 * pn : FF + 128 * pn) : cls == 2 ? (n0 < 4096 ? n0 : (n0 < NPROJ ? n0 + 16 : 4096)) : n0;
    d.nv = cls == 2 ? (n0 < NPROJ ? 128 : (n0 == NPROJ ? 16 : 0)) : 128;
    return d;
}
__device__ __forceinline__ void tile_load(const TileDesc& d, f32x4 (&v)[4]) {
    const int tx = threadIdx.x & 31, ty = threadIdx.x >> 5;
#pragma unroll
    for (int ps = 0; ps < 4; ++ps) v[ps] = (4 * tx < d.nv) ? *(const f32x4*)(d.W + (size_t)(d.k0 + ps * 16 + ty) * d.N + d.sc0 + 4 * tx) : (f32x4){0.f, 0.f, 0.f, 0.f};
}
__device__ __forceinline__ void tile_to_lds(const f32x4 (&v)[4], float* tile) {
    const int tx = threadIdx.x & 31, ty = threadIdx.x >> 5;
#pragma unroll
    for (int ps = 0; ps < 4; ++ps) *(f32x4*)(tile + (ps * 16 + ty) * 132 + ((4 * tx + 8 * ps) & 127)) = v[ps];
}
__device__ __forceinline__ void tile_store(const TileDesc& d, const float* tile) {
    const int n = threadIdx.x >> 2, ks = threadIdx.x & 3; float v[16];
#pragma unroll
    for (int j = 0; j < 16; ++j) v[j] = tile[(ks * 16 + j) * 132 + ((n + 8 * ks) & 127)];
    u32x4 w0, w1; w0.x = cvt_pk_bf16(v[0], v[1]); w0.y = cvt_pk_bf16(v[2], v[3]); w0.z = cvt_pk_bf16(v[4], v[5]); w0.w = cvt_pk_bf16(v[6], v[7]);
    w1.x = cvt_pk_bf16(v[8], v[9]); w1.y = cvt_pk_bf16(v[10], v[11]); w1.z = cvt_pk_bf16(v[12], v[13]); w1.w = cvt_pk_bf16(v[14], v[15]);
    bf16_t* dst = d.Wt + (size_t)(d.n0 + n) * d.K + d.k0 + ks * 16; *(u32x4*)dst = w0; *(u32x4*)(dst + 8) = w1;
}
__device__ __forceinline__ void convert_seq(const ConvPtrs p, int n_extra, int first, int base, int stride, int t_all, int split, int shift, float* tile) {
    const int cnt = n_extra + (base < t_all ? (t_all - base + stride - 1) / stride : 0);
    auto tid_of = [&](int i) { const int v = i < n_extra ? first + 64 * i : base + stride * (i - n_extra); return v < split ? v : v + shift; };
    f32x4 ra[4], rb[4];
    if (cnt > 0) tile_load(tile_desc(p.up, p.dn, p.in, p.o, p.ws, tid_of(0)), ra);
    if (cnt > 1) tile_load(tile_desc(p.up, p.dn, p.in, p.o, p.ws, tid_of(1)), rb);
    for (int i = 0; i < cnt; i += 2) {
        { const TileDesc d = tile_desc(p.up, p.dn, p.in, p.o, p.ws, tid_of(i));
          tile_to_lds(ra, tile); if (i + 2 < cnt) tile_load(tile_desc(p.up, p.dn, p.in, p.o, p.ws, tid_of(i + 2)), ra);
          __syncthreads(); tile_store(d, tile); __syncthreads(); }
        if (i + 1 < cnt) { const TileDesc d = tile_desc(p.up, p.dn, p.in, p.o, p.ws, tid_of(i + 1));
          tile_to_lds(rb, tile); if (i + 3 < cnt) tile_load(tile_desc(p.up, p.dn, p.in, p.o, p.ws, tid_of(i + 3)), rb);
          __syncthreads(); tile_store(d, tile); __syncthreads(); }
    }
}
__device__ __forceinline__ void adaln_strip(PP p, int strip, float* lds) {
    const float* cpr = p->in[7]; const float* csm = p->in[8]; const float* aw = p->in[9]; const float* ab = p->in[10];
    float* mod = (float*)(p->ws + WS_MOD);
    const int tid = threadIdx.x, col4 = tid & 15, kg = (tid >> 4) & 15, rh = tid >> 8;
    float* sc = lds;
    float* red = lds + 36 * 256;
    f32x4 acc[18];
#pragma unroll
    for (int i = 0; i < 18; ++i) acc[i] = (f32x4){0.f, 0.f, 0.f, 0.f};
    const int n0 = strip * 64 + col4 * 4;
    f32x4 w[4], wn[4], wm[4];
#pragma unroll
    for (int q = 0; q < 4; ++q) { w[q] = *(const f32x4*)(aw + (size_t)(kg * 4 + q) * NMODW + n0); wn[q] = *(const f32x4*)(aw + (size_t)(64 + kg * 4 + q) * NMODW + n0); }
#pragma unroll 1
    for (int step = 0; step < 32; ++step) {
        const int kc = (step >> 2) * 256, kl = (step & 3) * 64 + kg * 4;
        if (step + 2 < 32) { const int kn = ((step + 2) >> 2) * 256 + ((step + 2) & 3) * 64 + kg * 4;
#pragma unroll
            for (int q = 0; q < 4; ++q) wm[q] = *(const f32x4*)(aw + (size_t)(kn + q) * NMODW + n0); }
        if ((step & 3) == 0) {
            __syncthreads();
#pragma unroll 1
            for (int hb = 0; hb < 2; ++hb) {
                float cv[9];
#pragma unroll
                for (int it2 = 0; it2 < 9; ++it2) { const int e = tid + (hb * 9 + it2) * NTHR, i = e >> 8, k = e & 255; cv[it2] = i < 4 ? cpr[i * D + kc + k] : csm[(i - 4) * D + kc + k]; }
#pragma unroll
                for (int it2 = 0; it2 < 9; ++it2) sc[tid + (hb * 9 + it2) * NTHR] = silu_f(cv[it2]);
            }
            __syncthreads();
        }
#pragma unroll
        for (int i = 0; i < 18; ++i) { const f32x4 s4 = *(const f32x4*)(sc + (rh * 18 + i) * 256 + kl);
            acc[i] += w[0] * s4[0]; acc[i] += w[1] * s4[1]; acc[i] += w[2] * s4[2]; acc[i] += w[3] * s4[3]; }
#pragma unroll
        for (int q = 0; q < 4; ++q) { w[q] = wn[q]; wn[q] = wm[q]; }
    }
    __syncthreads();
    for (int g = 0; g < 16; ++g) {
        if (kg == g) {
#pragma unroll
            for (int i = 0; i < 18; ++i) { float* rp = red + (rh * 18 + i) * 64 + col4 * 4;
#pragma unroll
                for (int j = 0; j < 4; ++j) rp[j] = (g == 0 ? 0.f : rp[j]) + acc[i][j]; }
        }
        __syncthreads();
    }
    for (int e = tid; e < 36 * 64; e += NTHR) { const int i = e >> 6, c = e & 63; mod[(size_t)i * NMODW + strip * 64 + c] = red[e] + ab[strip * 64 + c]; }
    __syncthreads();
}
__device__ __forceinline__ void phase0(PP p, unsigned char* smem) {
    float* lds = (float*)smem;
    const int bid = blockIdx.x, G = gridDim.x;
    constexpr int T_ALL = 32 * 88 + 88 * 16 + 32 * 46 + 32 * 16;
    if (G == 256) {
        if (bid < 192) adaln_strip(p, bid, lds);
        const ConvPtrs cp = conv_ptrs(p);
        if (bid < 192) convert_seq(cp, 0, 0, 832 + bid, 256, T_ALL - 256, 3968, 256, lds);
        else convert_seq(cp, 13, bid - 192, 832 + bid, 256, T_ALL - 256, 3968, 256, lds);
    } else {
        for (int s2 = bid; s2 < 192; s2 += G) adaln_strip(p, s2, lds);
        const ConvPtrs cp = conv_ptrs(p); convert_seq(cp, 0, 0, bid, G, T_ALL, T_ALL, 0, lds);
    }
}

__device__ __forceinline__ void norm_phase(PP p, const float* xa, const float* xb, const float* nw, int si, bool reduce_parts) {
    const float* mod = (const float*)(p->ws + WS_MOD); bf16_t* H = (bf16_t*)(p->ws + WS_H); float* outp = p->out; const float* parts = (const float*)(p->ws + WS_GDN);
    const int wave = threadIdx.x >> 6, lane = threadIdx.x & 63;
    const int stride = gridDim.x * 8;
    int m = blockIdx.x * 8 + wave;
    f32x4 wv[8];
#pragma unroll
    for (int i = 0; i < 8; ++i) wv[i] = *(const f32x4*)(nw + i * 256 + lane * 4);
    f32x4 v[8], vn[8];
    if (m < MT) { const float* xr = m < MP ? xa + (size_t)m * D : xb + (size_t)(m - MP) * D;
#pragma unroll
        for (int i = 0; i < 8; ++i) v[i] = *(const f32x4*)(xr + i * 256 + lane * 4); }
    while (m < MT) {
        const int mn = m + stride;
        const float* mr = mod + (size_t)cond_of_row(m) * NMODW + si * D;
        f32x4 sh[8], scl[8];
#pragma unroll
        for (int i = 0; i < 8; ++i) { sh[i] = *(const f32x4*)(mr + i * 256 + lane * 4); scl[i] = *(const f32x4*)(mr + D + i * 256 + lane * 4); }
        if (mn < MT) { const float* xr = mn < MP ? xa + (size_t)mn * D : xb + (size_t)(mn - MP) * D;
#pragma unroll
            for (int i = 0; i < 8; ++i) vn[i] = *(const f32x4*)(xr + i * 256 + lane * 4); }
        if (reduce_parts && m >= MP) {
            const float* part = parts + (size_t)(m - MP) * D; const float* g1 = mod + (size_t)cond_of_row(m) * NMODW + 2 * D;
#pragma unroll
            for (int i = 0; i < 8; ++i) { f32x4 a = {0.f, 0.f, 0.f, 0.f};
#pragma unroll
                for (int sp = 0; sp < 8; ++sp) a += *(const f32x4*)(part + (size_t)sp * MS * D + i * 256 + lane * 4);
                v[i] += *(const f32x4*)(g1 + i * 256 + lane * 4) * a; *(f32x4*)(outp + (size_t)m * D + i * 256 + lane * 4) = v[i]; }
        }
        float ss = 0.f;
#pragma unroll
        for (int i = 0; i < 8; ++i) ss += v[i][0] * v[i][0] + v[i][1] * v[i][1] + v[i][2] * v[i][2] + v[i][3] * v[i][3];
#pragma unroll
        for (int o = 32; o >= 1; o >>= 1) ss += __shfl_xor(ss, o);
        const float rstd = rsqrtf(ss * (1.0f / D) + EPS);
#pragma unroll
        for (int i = 0; i < 8; ++i) { const int c = i * 256 + lane * 4;
            const f32x4 h = (v[i] * rstd * wv[i]) * (scl[i] + 1.0f) + sh[i]; u32x2 o; o.x = cvt_pk_bf16(h[0], h[1]); o.y = cvt_pk_bf16(h[2], h[3]); *(u32x2*)(H + (size_t)m * D + c) = o; }
#pragma unroll
        for (int i = 0; i < 8; ++i) v[i] = vn[i];
        m = mn;
    }
}

__device__ __forceinline__ void team_bar(unsigned* cnt, unsigned& target) {
    target += 4u;
    __builtin_amdgcn_fence(__ATOMIC_RELEASE, "workgroup");
    if ((threadIdx.x & 63) == 0) (void)__hip_atomic_fetch_add(cnt, 1u, __ATOMIC_RELAXED, __HIP_MEMORY_SCOPE_WORKGROUP);
    while (__hip_atomic_load(cnt, __ATOMIC_RELAXED, __HIP_MEMORY_SCOPE_WORKGROUP) < target) __builtin_amdgcn_s_sleep(1);
    __builtin_amdgcn_fence(__ATOMIC_ACQUIRE, "workgroup");
}
constexpr int TEAM_LDS = 81920;
__device__ __forceinline__ void gdn_prep(PP p, int item, unsigned char* tl  , unsigned* cnt, unsigned& bt) {
    const int b = item >> 9, h = (item >> 6) & 7, n = item & 63;
    int lt_ = threadIdx.x & 255; asm volatile("" : "+v"(lt_));
    const int lt = lt_, lane = lt & 63, lw = __builtin_amdgcn_readfirstlane(lt >> 6);
    const bf16_t* PROJ = (const bf16_t*)(p->ws + WS_PROJ); const float* AB = (const float*)(p->ws + WS_AB);
    unsigned char* rec = p->ws + WS_GDN + (size_t)item * CH_BYTES;
    const int m0 = b * LP + n * 64;
    bf16_t* QH = (bf16_t*)tl;
    bf16_t* KH = QH + 64 * 136;
    float* GC = (float*)(tl + 34816);
    float* BETA = GC + 64; float* EG = GC + 128; float* BEG = GC + 192;
    bf16_t* QKF = (bf16_t*)(tl + 36864);
    bf16_t* VH = (bf16_t*)(tl + 45056);
    float* AM = (float*)(tl + 62464);
    bf16_t* XS = (bf16_t*)(tl + 45056);
    team_bar(cnt, bt);
    if (lw == 0) {
        const float a = AB[(size_t)(m0 + lane) * 16 + h], bb = AB[(size_t)(m0 + lane) * 16 + 8 + h];
        float g = -__expf(p->in[15][h]) * softplus_f(a + p->in[16][h]);
        float gc = g;
#pragma unroll
        for (int o = 1; o < 64; o <<= 1) { const float t = __shfl_up(gc, o); if (lane >= o) gc += t; }
        const float be = sigmoid_f(bb), eg = __expf(gc);
        GC[lane] = gc; BETA[lane] = be; EG[lane] = eg; BEG[lane] = be * eg;
        if (lane == 63) *(float*)(rec + CH_GL) = eg;
    }
    {
        const float* cw = p->in[14];
#pragma unroll 1
        for (int pass = 0; pass < 2; ++pass) {
            const int slot = pass * 256 + lt, r = slot >> 3, cg = slot & 7; const int t = n * 64 + r;
            u32x4 raw[3][4][2];
#pragma unroll
            for (int which = 0; which < 3; ++which)
#pragma unroll
                for (int i = 0; i < 4; ++i) { const int dr = (t - 3 + i >= 0) ? (r - 3 + i) : r; const bf16_t* src = PROJ + (size_t)(m0 + dr) * NPROJ + which * 1024 + h * 128 + cg * 16;
                    raw[which][i][0] = *(const u32x4*)src; raw[which][i][1] = *(const u32x4*)(src + 8); }
#pragma unroll
            for (int which = 0; which < 3; ++which) {
                const int col = which * 1024 + h * 128 + cg * 16;
                float y[16];
#pragma unroll
                for (int j = 0; j < 16; ++j) y[j] = 0.f;
#pragma unroll
                for (int i = 0; i < 4; ++i) {
                    const float keep = (t - 3 + i >= 0) ? 1.0f : 0.0f;
                    float x[16]; unpack8(raw[which][i][0], x); unpack8(raw[which][i][1], x + 8);
#pragma unroll
                    for (int q = 0; q < 4; ++q) { const f32x4 w = *(const f32x4*)(cw + i * 3072 + col + q * 4) * keep;
#pragma unroll
                        for (int j = 0; j < 4; ++j) y[q * 4 + j] += w[j] * x[q * 4 + j]; }
                }
                float ss = 0.f;
#pragma unroll
                for (int j = 0; j < 16; ++j) { y[j] = silu_f(y[j]); ss += y[j] * y[j]; }
                float rn = 1.0f;
                if (which < 2) { ss += __shfl_xor(ss, 1); ss += __shfl_xor(ss, 2); ss += __shfl_xor(ss, 4); rn = rsqrtf(ss + EPS) * (which == 0 ? 0.08838834764831845f : 1.0f); }
                u32x4 w0, w1;
                w0.x = cvt_pk_bf16(y[0] * rn, y[1] * rn); w0.y = cvt_pk_bf16(y[2] * rn, y[3] * rn); w0.z = cvt_pk_bf16(y[4] * rn, y[5] * rn); w0.w = cvt_pk_bf16(y[6] * rn, y[7] * rn);
                w1.x = cvt_pk_bf16(y[8] * rn, y[9] * rn); w1.y = cvt_pk_bf16(y[10] * rn, y[11] * rn); w1.z = cvt_pk_bf16(y[12] * rn, y[13] * rn); w1.w = cvt_pk_bf16(y[14] * rn, y[15] * rn);
                bf16_t* dst = (which == 0 ? QH : which == 1 ? KH : VH) + r * 136 + cg * 16;
                *(u32x4*)dst = w0; *(u32x4*)(dst + 8) = w1;
            }
            if (n == 63 && r >= 61) {
                float* pc = p->out + O_PCONV + (size_t)(b * 3 + (r - 61)) * 3072;
#pragma unroll
                for (int which = 0; which < 3; ++which) { const int col = which * 1024 + h * 128 + cg * 16; float x[16]; unpack8(raw[which][3][0], x); unpack8(raw[which][3][1], x + 8);
#pragma unroll
                    for (int j = 0; j < 16; ++j) pc[col + j] = x[j]; }
            }
        }
    }
    team_bar(cnt, bt);
    {
        const int fr = lane & 15, kq = lane >> 4;
#pragma unroll
        for (int rep = 0; rep < 4; ++rep) {
            const int tt = lw + rep * 4, ti = tt >> 2, tj = tt & 3;
            f32x4 ck = {0.f, 0.f, 0.f, 0.f}, cq = {0.f, 0.f, 0.f, 0.f};
            if (tj <= ti) {
#pragma unroll
                for (int kk = 0; kk < 4; ++kk) {
                    const bf16x8 ak = *(const bf16x8*)(KH + (16 * ti + fr) * 136 + kk * 32 + kq * 8);
                    const bf16x8 aq = *(const bf16x8*)(QH + (16 * ti + fr) * 136 + kk * 32 + kq * 8);
                    const bf16x8 bk = *(const bf16x8*)(KH + (16 * tj + fr) * 136 + kk * 32 + kq * 8);
                    ck = __builtin_amdgcn_mfma_f32_16x16x32_bf16(ak, bk, ck, 0, 0, 0);
                    cq = __builtin_amdgcn_mfma_f32_16x16x32_bf16(aq, bk, cq, 0, 0, 0);
                }
            }
            const int j = 16 * tj + fr; const float gj = GC[j];
            const int cc = 16 * (tj & 1) + fr; const int kqp = (cc & 15) >> 2, jp = (cc & 3) + (cc >= 16 ? 4 : 0), kc = tj >> 1;
#pragma unroll
            for (int r = 0; r < 4; ++r) {
                const int i = 16 * ti + 4 * kq + r; const float dec = __expf(GC[i] - gj);
                AM[i * 68 + j] = (i > j) ? BETA[i] * dec * ck[r] : 0.f;
                const float qv = (i >= j) ? dec * cq[r] : 0.f;
                const int L = (4 * kq + r) + 16 * kqp;
                QKF[((ti * 2 + kc) * 64 + L) * 8 + jp] = (bf16_t)(cvt_pk_bf16(qv, 0.f) & 0xffffu);
            }
        }
    }
    team_bar(cnt, bt);
    float x[64];
    {
        const int c = lt;
        int zv; asm volatile("v_mov_b32 %0, 0" : "=v"(zv));
        const float* AMv = AM + zv; const float* SCL = (c < 128 ? BETA : BEG) + zv; const bf16_t* R = (c < 128 ? VH : KH) + (c & 127);
        f32x4 amc[16], amn[8];
        float rc = bf2f(R[0]) * SCL[0], rn = 0.f;
#pragma unroll
        for (int i = 0; i < 64; ++i) {
            __builtin_amdgcn_sched_barrier(0);
#pragma unroll
            for (int jj = 8; jj < (i + 3) / 4; ++jj) amc[jj] = *(const f32x4*)(AMv + i * 68 + jj * 4);
            if (i + 1 < 64) { rn = bf2f(R[(i + 1) * 136]) * SCL[i + 1];
#pragma unroll
                for (int jj = 0; jj < ((i + 4) / 4 < 8 ? (i + 4) / 4 : 8); ++jj) amn[jj] = *(const f32x4*)(AMv + (i + 1) * 68 + jj * 4); }
            float a = rc;
#pragma unroll
            for (int jj = 0; jj < (i + 3) / 4; ++jj) {
#pragma unroll
                for (int q = 0; q < 4; ++q) if (jj * 4 + q < i) asm("v_fma_f32 %0, -%1, %2, %0" : "+v"(a) : "v"(amc[jj][q]), "v"(x[jj * 4 + q])); }
            x[i] = a;
            rc = rn;
#pragma unroll
            for (int jj = 0; jj < 8; ++jj) amc[jj] = amn[jj];
        }
    }
    team_bar(cnt, bt);
#pragma unroll
    for (int i = 0; i < 64; ++i) XS[i * 264 + lt] = (bf16_t)(cvt_pk_bf16(x[i], 0.f) & 0xffffu);
    team_bar(cnt, bt);
    {
        const int L = lane, mrow = L & 15, kqp = L >> 4;
        const float g63 = GC[63];
#pragma unroll
        for (int rnd = 0; rnd < 4; ++rnd) { const int f = rnd * 4 + lw, mt = f >> 2, kk = f & 3; const int c = 16 * mt + mrow;
            const u32x2 lo = *(const u32x2*)(XS + c * 264 + 128 + 32 * kk + 4 * kqp), hi = *(const u32x2*)(XS + c * 264 + 128 + 32 * kk + 16 + 4 * kqp);
            u32x4 w; w.x = lo.x; w.y = lo.y; w.z = hi.x; w.w = hi.y;
            *(u32x4*)(rec + CH_W + (size_t)f * 1024 + L * 16) = w; }
#pragma unroll
        for (int rnd = 0; rnd < 2; ++rnd) { const int slot = rnd * 256 + lt, dv = slot >> 2, cs = slot & 3; unsigned pk[8];
#pragma unroll
            for (int q = 0; q < 8; ++q) { const unsigned lo = XS[(16 * cs + 2 * q) * 264 + dv], hi = XS[(16 * cs + 2 * q + 1) * 264 + dv]; pk[q] = lo | (hi << 16); }
            u32x4 w0, w1; w0.x = pk[0]; w0.y = pk[1]; w0.z = pk[2]; w0.w = pk[3]; w1.x = pk[4]; w1.y = pk[5]; w1.z = pk[6]; w1.w = pk[7];
            bf16_t* ut = (bf16_t*)(rec + CH_UT) + dv * 64 + cs * 16; *(u32x4*)ut = w0; *(u32x4*)(ut + 8) = w1; }
#pragma unroll
        for (int rnd = 0; rnd < 4; ++rnd) {
            const int f = rnd * 4 + lw, mt = f >> 2, kk = f & 3; const int c = 16 * mt + mrow; const float e = EG[c];
            const u32x2 lo = *(const u32x2*)(QH + c * 136 + 32 * kk + 4 * kqp), hi = *(const u32x2*)(QH + c * 136 + 32 * kk + 16 + 4 * kqp);
            u32x4 w; w.x = cvt_pk_bf16(bf_lo(lo.x) * e, bf_hi(lo.x) * e); w.y = cvt_pk_bf16(bf_lo(lo.y) * e, bf_hi(lo.y) * e); w.z = cvt_pk_bf16(bf_lo(hi.x) * e, bf_hi(hi.x) * e); w.w = cvt_pk_bf16(bf_lo(hi.y) * e, bf_hi(hi.y) * e);
            *(u32x4*)(rec + CH_QG + (size_t)f * 1024 + L * 16) = w;
        }
#pragma unroll
        for (int rnd = 0; rnd < 4; ++rnd) {
            const int f = rnd * 4 + lw, d = f >> 1, kc = f & 1; const int dk = 16 * d + mrow;
            float v[8];
#pragma unroll
            for (int j = 0; j < 8; ++j) { const int c = 32 * kc + (j < 4 ? 4 * kqp + j : 16 + 4 * kqp + (j - 4)); v[j] = bf2f(KH[c * 136 + dk]) * __expf(g63 - GC[c]); }
            u32x4 w; w.x = cvt_pk_bf16(v[0], v[1]); w.y = cvt_pk_bf16(v[2], v[3]); w.z = cvt_pk_bf16(v[4], v[5]); w.w = cvt_pk_bf16(v[6], v[7]);
            *(u32x4*)(rec + CH_KD + (size_t)f * 1024 + L * 16) = w;
        }
#pragma unroll
        for (int rnd = 0; rnd < 2; ++rnd) { const int e = rnd * 256 + lt; *(u32x4*)(rec + CH_QK + (size_t)e * 16) = *(const u32x4*)((const unsigned char*)QKF + e * 16); }
    }
}

__device__ __forceinline__ void gdn_sample(PP p, int item, unsigned char* smem) {
    const int b = item >> 3, h = item & 7;
    const int tid = threadIdx.x;
    const bf16_t* PROJ = (const bf16_t*)(p->ws + WS_PROJ); const float* AB = (const float*)(p->ws + WS_AB);
    bf16_t* OM = (bf16_t*)(p->ws + WS_H);
    const int m0 = MP + b * 16;
    float* Q = (float*)smem; float* K = Q + 16 * 128; float* V = K + 16 * 128; float* O = V + 16 * 128;
    float* RED = O + 16 * 128;
    float* RED2 = RED + 4 * 128;
    float* GG = RED2 + 4 * 128;
    __syncthreads();
    if (tid < 16) { const float a = AB[(size_t)(m0 + tid) * 16 + h], bb = AB[(size_t)(m0 + tid) * 16 + 8 + h];
        GG[tid] = __expf(-__expf(p->in[15][h]) * softplus_f(a + p->in[16][h])); GG[16 + tid] = sigmoid_f(bb); }
    {
        const int r = tid >> 5, cg = tid & 31; const float* cw = p->in[14]; const float* st = p->in[2] + (size_t)b * 3 * 3072;
#pragma unroll
        for (int which = 0; which < 3; ++which) {
            const int col = which * 1024 + h * 128 + cg * 4; float y[4] = {0.f, 0.f, 0.f, 0.f};
#pragma unroll
            for (int i = 0; i < 4; ++i) { const int t = r - 3 + i; float x[4];
                const u32x2 vp = *(const u32x2*)(PROJ + (size_t)(m0 + (t >= 0 ? t : 0)) * NPROJ + col); const f32x4 vs = *(const f32x4*)(st + (size_t)(t >= 0 ? 0 : 3 + t) * 3072 + col);
                x[0] = t >= 0 ? bf_lo(vp.x) : vs[0]; x[1] = t >= 0 ? bf_hi(vp.x) : vs[1]; x[2] = t >= 0 ? bf_lo(vp.y) : vs[2]; x[3] = t >= 0 ? bf_hi(vp.y) : vs[3];
                const f32x4 w = *(const f32x4*)(cw + i * 3072 + col);
#pragma unroll
                for (int j = 0; j < 4; ++j) y[j] += w[j] * x[j]; }
            float ss = 0.f;
#pragma unroll
            for (int j = 0; j < 4; ++j) { y[j] = silu_f(y[j]); ss += y[j] * y[j]; }
            float rn = 1.0f;
            if (which < 2) {
#pragma unroll
                for (int o = 1; o < 32; o <<= 1) ss += __shfl_xor(ss, o);
                rn = rsqrtf(ss + EPS) * (which == 0 ? 0.08838834764831845f : 1.0f); }
            float* dst = (which == 0 ? Q : which == 1 ? K : V) + r * 128 + cg * 4;
#pragma unroll
            for (int j = 0; j < 4; ++j) dst[j] = y[j] * rn;
            if (r >= 13) {
                const u32x2 v = *(const u32x2*)(PROJ + (size_t)(m0 + r) * NPROJ + col);
                *(f32x4*)(p->out + O_SCONV + (size_t)(b * 3 + r - 13) * 3072 + col) = (f32x4){bf_lo(v.x), bf_hi(v.x), bf_lo(v.y), bf_hi(v.y)}; }
        }
    }
    const int dv = tid & 127, kg = tid >> 7;
    float S[32];
    const float* s0 = p->in[3] + ((size_t)(b * 8 + h) * 128 + kg * 32) * 128 + dv;
#pragma unroll
    for (int i = 0; i < 32; ++i) S[i] = s0[(size_t)i * 128];
    __syncthreads();
    for (int t = 0; t < 16; ++t) {
        const float a = GG[t], be = GG[16 + t]; float part = 0.f;
#pragma unroll
        for (int i = 0; i < 32; ++i) { S[i] *= a; part += K[t * 128 + kg * 32 + i] * S[i]; }
        RED[kg * 128 + dv] = part;
        __syncthreads();
        const float ks = RED[dv] + RED[128 + dv] + RED[256 + dv] + RED[384 + dv];
        const float rr = be * (V[t * 128 + dv] - ks); float po = 0.f;
#pragma unroll
        for (int i = 0; i < 32; ++i) { S[i] += K[t * 128 + kg * 32 + i] * rr; po += Q[t * 128 + kg * 32 + i] * S[i]; }
        RED2[kg * 128 + dv] = po;
        __syncthreads();
        if (kg == 0) O[t * 128 + dv] = RED2[dv] + RED2[128 + dv] + RED2[256 + dv] + RED2[384 + dv];
    }
    float* sd = p->out + O_SDELTA + ((size_t)(b * 8 + h) * 128 + kg * 32) * 128 + dv;
#pragma unroll
    for (int i = 0; i < 32; ++i) sd[(size_t)i * 128] = S[i];
    __syncthreads();
    {
        const int r = tid >> 5, cg = tid & 31; const f32x4 o = *(const f32x4*)(O + r * 128 + cg * 4);
        float ss = o[0] * o[0] + o[1] * o[1] + o[2] * o[2] + o[3] * o[3];
#pragma unroll
        for (int of = 1; of < 32; of <<= 1) ss += __shfl_xor(ss, of);
        const float rs = rsqrtf(ss * (1.0f / 128.f) + EPS); const f32x4 w = *(const f32x4*)(p->in[17] + cg * 4);
        const u32x2 zz = *(const u32x2*)(PROJ + (size_t)(m0 + r) * NPROJ + 3072 + h * 128 + cg * 4);
        const float z[4] = {bf_lo(zz.x), bf_hi(zz.x), bf_lo(zz.y), bf_hi(zz.y)};
        u32x2 ow; ow.x = cvt_pk_bf16(o[0] * rs * w[0] * silu_f(z[0]), o[1] * rs * w[1] * silu_f(z[1])); ow.y = cvt_pk_bf16(o[2] * rs * w[2] * silu_f(z[2]), o[3] * rs * w[3] * silu_f(z[3]));
        *(u32x2*)(OM + (size_t)(m0 + r) * D + h * 128 + cg * 4) = ow;
    }
}

template <int NT  , bool SAMPLE>
__device__ __forceinline__ void swa_item(PP p, int b, int n, int hk, unsigned char* smem) {
    constexpr int SPAN = SAMPLE ? 144 : 192, NQ = SAMPLE ? 16 : 64, VP = NT * 16 + 8;
    const int tid = threadIdx.x, lane = tid & 63, wave = tid >> 6, fr = lane & 15, kq = lane >> 4;
    const bf16_t* PROJ = (const bf16_t*)(p->ws + WS_PROJ); bf16_t* OM = (bf16_t*)(p->ws + WS_H);
    bf16_t* KS = (bf16_t*)smem;
    bf16_t* VT = KS + NT * 16 * 136;
    const int mq0 = SAMPLE ? MP + b * 16 : b * LP + n * 64;
    const float* knw = p->in[19];
    __syncthreads();
    u32x4 kraw[3][2], vraw[3][2];
    if (!SAMPLE) {
#pragma unroll
        for (int pass = 0; pass < 3; ++pass) {
            { const int t = n * 64 - 128 + pass * 64 + (tid >> 3); const bf16_t* src = PROJ + (size_t)(b * LP + (t > 0 ? t : 0)) * NPROJ + 5120 + hk * 128 + (tid & 7) * 16; kraw[pass][0] = *(const u32x4*)src; kraw[pass][1] = *(const u32x4*)(src + 8); }
            { const int t = n * 64 - 128 + pass * 64 + lane; const bf16_t* src = PROJ + (size_t)(b * LP + (t > 0 ? t : 0)) * NPROJ + 5376 + hk * 128 + wave * 16; vraw[pass][0] = *(const u32x4*)src; vraw[pass][1] = *(const u32x4*)(src + 8); }
        }
    }
#pragma unroll
    for (int pass = 0; pass < (NT * 16) / 64 + ((NT * 16) % 64 ? 1 : 0); ++pass) {
        const int key = pass * 64 + (tid >> 3), cg = tid & 7;
        if (key < NT * 16) {
            float x[16]; bool valid = key < SPAN; bool fresh = false; int srow = 0;
            if (SAMPLE) { if (key >= 128) { fresh = true; srow = mq0 + key - 128; } }
            else { const int t = n * 64 - 128 + key; valid = valid && t >= 0; fresh = true; srow = b * LP + t; }
            if (!valid) {
#pragma unroll
                for (int j = 0; j < 16; ++j) x[j] = 0.f;
            } else if (fresh) {
                if (SAMPLE) { const bf16_t* src = PROJ + (size_t)srow * NPROJ + 5120 + hk * 128 + cg * 16; unpack8(*(const u32x4*)src, x); unpack8(*(const u32x4*)(src + 8), x + 8); }
                else { unpack8(kraw[pass][0], x); unpack8(kraw[pass][1], x + 8); }
                float ss = 0.f;
#pragma unroll
                for (int j = 0; j < 16; ++j) ss += x[j] * x[j];
                ss += __shfl_xor(ss, 1); ss += __shfl_xor(ss, 2); ss += __shfl_xor(ss, 4);
                const float rs = rsqrtf(ss * (1.0f / 128.f) + EPS);
#pragma unroll
                for (int j = 0; j < 16; ++j) x[j] = x[j] * rs * knw[cg * 16 + j];
            } else {
                const float* src = p->in[4] + ((size_t)(b * 128 + key) * 2 + hk) * 128 + cg * 16;
#pragma unroll
                for (int q = 0; q < 4; ++q) { const f32x4 v = *(const f32x4*)(src + q * 4); x[q * 4] = v[0]; x[q * 4 + 1] = v[1]; x[q * 4 + 2] = v[2]; x[q * 4 + 3] = v[3]; }
            }
            u32x4 w0, w1;
            w0.x = cvt_pk_bf16(x[0], x[1]); w0.y = cvt_pk_bf16(x[2], x[3]); w0.z = cvt_pk_bf16(x[4], x[5]); w0.w = cvt_pk_bf16(x[6], x[7]);
            w1.x = cvt_pk_bf16(x[8], x[9]); w1.y = cvt_pk_bf16(x[10], x[11]); w1.z = cvt_pk_bf16(x[12], x[13]); w1.w = cvt_pk_bf16(x[14], x[15]);
            *(u32x4*)(KS + key * 136 + cg * 16) = w0; *(u32x4*)(KS + key * 136 + cg * 16 + 8) = w1;
            float* dst = nullptr;
            if (SAMPLE) { if (key >= 16 && key < 144) dst = p->out + O_SK + ((size_t)(b * 128 + key - 16) * 2 + hk) * 128 + cg * 16; }
            else { if (n >= 62 && key >= 128) dst = p->out + O_PK + ((size_t)(b * 128 + (n - 62) * 64 + key - 128) * 2 + hk) * 128 + cg * 16; }
            if (dst) {
#pragma unroll
                for (int q = 0; q < 4; ++q) *(f32x4*)(dst + q * 4) = (f32x4){x[q * 4], x[q * 4 + 1], x[q * 4 + 2], x[q * 4 + 3]}; }
        }
    }
#pragma unroll
    for (int pass = 0; pass < (NT * 16) / 64 + ((NT * 16) % 64 ? 1 : 0); ++pass) {
        const int key = pass * 64 + lane, cg = wave;
        if (key < NT * 16) {
            float x[16]; bool valid = key < SPAN; bool fresh = false; int srow = 0;
            if (SAMPLE) { if (key >= 128) { fresh = true; srow = mq0 + key - 128; } }
            else { const int t = n * 64 - 128 + key; valid = valid && t >= 0; fresh = true; srow = b * LP + t; }
            if (!valid) {
#pragma unroll
                for (int j = 0; j < 16; ++j) x[j] = 0.f;
            } else if (fresh) { if (SAMPLE) { const bf16_t* src = PROJ + (size_t)srow * NPROJ + 5376 + hk * 128 + cg * 16; unpack8(*(const u32x4*)src, x); unpack8(*(const u32x4*)(src + 8), x + 8); } else { unpack8(vraw[pass][0], x); unpack8(vraw[pass][1], x + 8); } }
            else { const float* src = p->in[5] + ((size_t)(b * 128 + key) * 2 + hk) * 128 + cg * 16;
#pragma unroll
                for (int q = 0; q < 4; ++q) { const f32x4 v = *(const f32x4*)(src + q * 4); x[q * 4] = v[0]; x[q * 4 + 1] = v[1]; x[q * 4 + 2] = v[2]; x[q * 4 + 3] = v[3]; } }
#pragma unroll
            for (int j = 0; j < 16; ++j) VT[(cg * 16 + j) * VP + key] = (bf16_t)(cvt_pk_bf16(x[j], 0.f) & 0xffffu);
            float* dst = nullptr;
            if (SAMPLE) { if (key >= 16 && key < 144) dst = p->out + O_SV + ((size_t)(b * 128 + key - 16) * 2 + hk) * 128 + cg * 16; }
            else { if (n >= 62 && key >= 128) dst = p->out + O_PV + ((size_t)(b * 128 + (n - 62) * 64 + key - 128) * 2 + hk) * 128 + cg * 16; }
            if (dst) {
#pragma unroll
                for (int q = 0; q < 4; ++q) *(f32x4*)(dst + q * 4) = (f32x4){x[q * 4], x[q * 4 + 1], x[q * 4 + 2], x[q * 4 + 3]}; }
        }
    }
    __syncthreads();
    if (wave * 32 < NQ * 4) {
        const float* qnw = p->in[18];
        int hq[2], mrow[2], iq[2]; float slope[2], sink[2];
        bf16x8 QF[2][4];
#pragma unroll
        for (int nt2 = 0; nt2 < 2; ++nt2) {
            const int rho = wave * 32 + nt2 * 16 + fr; const int g = rho / NQ; iq[nt2] = rho % NQ; hq[nt2] = hk * 4 + g; mrow[nt2] = mq0 + iq[nt2];
            slope[nt2] = exp2f(-(float)(hq[nt2] + 1)); sink[nt2] = p->in[20][hq[nt2]];
        }
        { u32x4 qr[2][4];
#pragma unroll
          for (int nt2 = 0; nt2 < 2; ++nt2)
#pragma unroll
              for (int kk = 0; kk < 4; ++kk) qr[nt2][kk] = *(const u32x4*)(PROJ + (size_t)mrow[nt2] * NPROJ + 4096 + hq[nt2] * 128 + kk * 32 + kq * 8);
#pragma unroll
          for (int nt2 = 0; nt2 < 2; ++nt2) { float qx[4][8]; float ss = 0.f;
#pragma unroll
              for (int kk = 0; kk < 4; ++kk) { unpack8(qr[nt2][kk], qx[kk]);
#pragma unroll
                  for (int j = 0; j < 8; ++j) ss += qx[kk][j] * qx[kk][j]; }
              ss += __shfl_xor(ss, 16); ss += __shfl_xor(ss, 32);
              const float sc = rsqrtf(ss * (1.0f / 128.f) + EPS) * 0.08838834764831845f;
#pragma unroll
              for (int kk = 0; kk < 4; ++kk) { float w[8];
#pragma unroll
                  for (int j = 0; j < 8; ++j) w[j] = qx[kk][j] * sc * qnw[kk * 32 + kq * 8 + j];
                  u32x4 pk; pk.x = cvt_pk_bf16(w[0], w[1]); pk.y = cvt_pk_bf16(w[2], w[3]); pk.z = cvt_pk_bf16(w[4], w[5]); pk.w = cvt_pk_bf16(w[6], w[7]); QF[nt2][kk] = as_bf16x8(pk); } } }
        bf16x8 PB[2][NT / 2];
#pragma unroll
        for (int nt2 = 0; nt2 < 2; ++nt2) {
            f32x4 st[NT]; float mx = sink[nt2];
#pragma unroll
            for (int mt = 0; mt < NT; mt += 2) {
                __builtin_amdgcn_sched_barrier(0);
                f32x4 a0 = {0.f, 0.f, 0.f, 0.f}, a1 = {0.f, 0.f, 0.f, 0.f};
#pragma unroll
                for (int kk = 0; kk < 4; ++kk) { const bf16x8 k0 = *(const bf16x8*)(KS + (16 * mt + fr) * 136 + kk * 32 + kq * 8), k1 = *(const bf16x8*)(KS + (16 * mt + 16 + fr) * 136 + kk * 32 + kq * 8);
                    a0 = __builtin_amdgcn_mfma_f32_16x16x32_bf16(k0, QF[nt2][kk], a0, 0, 0, 0); a1 = __builtin_amdgcn_mfma_f32_16x16x32_bf16(k1, QF[nt2][kk], a1, 0, 0, 0); }
                int ib = iq[nt2] + 128 - 4 * kq; asm volatile("" : "+v"(ib));
#pragma unroll
                for (int r = 0; r < 4; ++r) { const int key = 16 * mt + 4 * kq + r; bool v0 = key < SPAN, v1 = key + 16 < SPAN; if (!SAMPLE) { v0 = v0 && (n * 64 - 128 + key >= 0); v1 = v1 && (n * 64 - 112 + key >= 0); }
                    const float s0 = v0 ? a0[r] - slope[nt2] * fabsf((float)(ib - (16 * mt + r))) : -INFINITY, s1 = v1 ? a1[r] - slope[nt2] * fabsf((float)(ib - (16 * mt + 16 + r))) : -INFINITY;
                    a0[r] = s0; a1[r] = s1; mx = fmaxf(mx, fmaxf(s0, s1)); }
                st[mt] = a0; st[mt + 1] = a1;
            }
            __builtin_amdgcn_sched_barrier(0);
            mx = fmaxf(mx, __shfl_xor(mx, 16)); mx = fmaxf(mx, __shfl_xor(mx, 32));
            float sum = 0.f;
#pragma unroll
            for (int mt = 0; mt < NT; ++mt)
#pragma unroll
                for (int r = 0; r < 4; ++r) { const float e = __expf(st[mt][r] - mx); st[mt][r] = e; sum += e; }
            sum += __shfl_xor(sum, 16); sum += __shfl_xor(sum, 32);
            const float inv = __builtin_amdgcn_rcpf(sum + __expf(sink[nt2] - mx));
#pragma unroll
            for (int kc = 0; kc < NT / 2; ++kc) { u32x4 pk; pk.x = cvt_pk_bf16(st[2 * kc][0] * inv, st[2 * kc][1] * inv); pk.y = cvt_pk_bf16(st[2 * kc][2] * inv, st[2 * kc][3] * inv);
                pk.z = cvt_pk_bf16(st[2 * kc + 1][0] * inv, st[2 * kc + 1][1] * inv); pk.w = cvt_pk_bf16(st[2 * kc + 1][2] * inv, st[2 * kc + 1][3] * inv); PB[nt2][kc] = as_bf16x8(pk); }
        }
#pragma unroll
        for (int dt = 0; dt < 8; ++dt) {
            __builtin_amdgcn_sched_barrier(0);
            f32x4 o0 = {0.f, 0.f, 0.f, 0.f}, o1 = {0.f, 0.f, 0.f, 0.f};
#pragma unroll
            for (int kc = 0; kc < NT / 2; ++kc) { const u32x2 lo = *(const u32x2*)(VT + (16 * dt + fr) * VP + 32 * kc + 4 * kq), hi = *(const u32x2*)(VT + (16 * dt + fr) * VP + 32 * kc + 16 + 4 * kq);
                u32x4 va; va.x = lo.x; va.y = lo.y; va.z = hi.x; va.w = hi.y;
                o0 = __builtin_amdgcn_mfma_f32_16x16x32_bf16(as_bf16x8(va), PB[0][kc], o0, 0, 0, 0); o1 = __builtin_amdgcn_mfma_f32_16x16x32_bf16(as_bf16x8(va), PB[1][kc], o1, 0, 0, 0); }
            u32x2 ow; ow.x = cvt_pk_bf16(o0[0], o0[1]); ow.y = cvt_pk_bf16(o0[2], o0[3]);
            *(u32x2*)(OM + (size_t)mrow[0] * D + 1024 + hq[0] * 128 + 16 * dt + 4 * kq) = ow;
            ow.x = cvt_pk_bf16(o1[0], o1[1]); ow.y = cvt_pk_bf16(o1[2], o1[3]);
            *(u32x2*)(OM + (size_t)mrow[1] * D + 1024 + hq[1] * 128 + 16 * dt + 4 * kq) = ow;
        }
    }
}

__device__ __forceinline__ void phase3(PP p, unsigned char* smem) {
#ifndef P3_MASK
#define P3_MASK 15
#endif
    const int bid = blockIdx.x, G = gridDim.x;
#ifndef P3_REP
#define P3_REP 0
#endif
    if (P3_MASK & 1) {
        unsigned* cnt = (unsigned*)(smem + 36352) ;
        if (threadIdx.x < 2) cnt[threadIdx.x] = 0u;
        __syncthreads();
        const int team = threadIdx.x >> 8; unsigned bt = 0u;
        for (int r_ = 0; r_ < 1 + (P3_REP & 1); ++r_) for (int it = bid + G * team; it < 2048; it += 2 * G) gdn_prep(p, it, smem + team * TEAM_LDS, cnt + team, bt);
        __syncthreads();
    }
    if (P3_MASK & 2) for (int r_ = 0; r_ < 1 + ((P3_REP >> 1) & 1); ++r_) for (int v = bid; v < 512; v += G) { const int u = (G == 256) ? (v & 7) * 64 + ((v >> 3) & 31) + 32 * (v >> 8) : v;
        swa_item<12, false>(p, u >> 7, (u >> 1) & 63, u & 1, smem); }
    if ((P3_MASK & 4) && G != 256) for (int u = bid; u < 256; u += G) gdn_sample(p, u, smem);
    if ((P3_MASK & 8) && G != 256) for (int u = G - 1 - bid; u < 64; u += G) swa_item<10, true>(p, u >> 1, 0, u & 1, smem);
}

__device__ __forceinline__ void scan_chunk(f32x4 (&S)[8], const unsigned char* cur, float gl, bf16_t* op0, int lane, int fr, int kq, int wave) {
#define FRAG(off, f) (*(const bf16x8*)(cur + (off) + (f) * 1024 + lane * 16))
    bf16x8 sB[4];
#pragma unroll
    for (int kk = 0; kk < 4; ++kk) { u32x4 pk; pk.x = cvt_pk_bf16(S[2 * kk][0], S[2 * kk][1]); pk.y = cvt_pk_bf16(S[2 * kk][2], S[2 * kk][3]); pk.z = cvt_pk_bf16(S[2 * kk + 1][0], S[2 * kk + 1][1]); pk.w = cvt_pk_bf16(S[2 * kk + 1][2], S[2 * kk + 1][3]); sB[kk] = as_bf16x8(pk); }
    bf16x8 Wf[16]; u32x2 uu[4];
#pragma unroll
    for (int f = 0; f < 16; ++f) Wf[f] = FRAG(CH_W, f);
#pragma unroll
    for (int mt = 0; mt < 4; ++mt) uu[mt] = *(const u32x2*)(cur + 57344 + (wave * 16 + fr) * 128 + (16 * mt + 4 * kq) * 2);
    __builtin_amdgcn_sched_barrier(0);
    f32x4 P[4], O[4];
#pragma unroll
    for (int mt = 0; mt < 4; ++mt) { P[mt] = (f32x4){0.f, 0.f, 0.f, 0.f}; O[mt] = (f32x4){0.f, 0.f, 0.f, 0.f}; }
    bf16x8 Gf[16];
#pragma unroll
    for (int kk = 0; kk < 4; ++kk) {
#pragma unroll
        for (int mt = 0; mt < 4; ++mt) { P[mt] = __builtin_amdgcn_mfma_f32_16x16x32_bf16(Wf[mt * 4 + kk], sB[kk], P[mt], 0, 0, 0); Gf[kk * 4 + mt] = FRAG(CH_QG, mt * 4 + kk); }
    }
    __builtin_amdgcn_sched_barrier(0);
    bf16x8 Kf[8], Df[16];
#pragma unroll
    for (int kk = 0; kk < 4; ++kk) {
#pragma unroll
        for (int mt = 0; mt < 4; ++mt) { O[mt] = __builtin_amdgcn_mfma_f32_16x16x32_bf16(Gf[kk * 4 + mt], sB[kk], O[mt], 0, 0, 0); if (kk < 2) Kf[kk * 4 + mt] = FRAG(CH_QK, mt * 2 + kk); else Df[(kk - 2) * 4 + mt] = FRAG(CH_KD, (kk - 2) * 4 + mt); }
    }
    f32x4 vn[4];
#pragma unroll
    for (int mt = 0; mt < 4; ++mt) vn[mt] = (f32x4){bf_lo(uu[mt].x) - P[mt][0], bf_hi(uu[mt].x) - P[mt][1], bf_lo(uu[mt].y) - P[mt][2], bf_hi(uu[mt].y) - P[mt][3]};
    bf16x8 vB[2];
#pragma unroll
    for (int kc = 0; kc < 2; ++kc) { u32x4 pk; pk.x = cvt_pk_bf16(vn[2 * kc][0], vn[2 * kc][1]); pk.y = cvt_pk_bf16(vn[2 * kc][2], vn[2 * kc][3]); pk.z = cvt_pk_bf16(vn[2 * kc + 1][0], vn[2 * kc + 1][1]); pk.w = cvt_pk_bf16(vn[2 * kc + 1][2], vn[2 * kc + 1][3]); vB[kc] = as_bf16x8(pk); }
    __builtin_amdgcn_sched_barrier(0);
#pragma unroll
    for (int kc = 0; kc < 2; ++kc) {
#pragma unroll
        for (int mt = 0; mt < 4; ++mt) { O[mt] = __builtin_amdgcn_mfma_f32_16x16x32_bf16(Kf[kc * 4 + mt], vB[kc], O[mt], 0, 0, 0); Df[8 + kc * 4 + mt] = FRAG(CH_KD, 8 + kc * 4 + mt); }
    }
#pragma unroll
    for (int d = 0; d < 8; ++d) S[d] = S[d] * gl;
    __builtin_amdgcn_sched_barrier(0);
#pragma unroll
    for (int kc = 0; kc < 2; ++kc) {
#pragma unroll
        for (int d = 0; d < 8; ++d) S[d] = __builtin_amdgcn_mfma_f32_16x16x32_bf16(Df[d * 2 + kc], vB[kc], S[d], 0, 0, 0);
    }
#pragma unroll
    for (int mt = 0; mt < 4; ++mt) { bf16_t* op = op0 + (size_t)(16 * mt) * D;
#pragma unroll
        for (int r = 0; r < 4; ++r) op[(size_t)r * D] = (bf16_t)(cvt_pk_bf16(O[mt][r], 0.f) & 0xffffu); }
#undef FRAG
}
__device__ __forceinline__ void phase4(PP p, unsigned char* smem) {
    const int tid = threadIdx.x, lane = tid & 63, wave = tid >> 6, fr = lane & 15, kq = lane >> 4;
    bf16_t* OM = (bf16_t*)(p->ws + WS_H);
    constexpr int NCW = 2, NS = 8 / NCW, USL = 2048 * NCW, BUF = 57344 + USL;
    if (gridDim.x == 256 && blockIdx.x >= 128) { const ConvPtrs cp = conv_ptrs(p); gdn_sample(p, (int)blockIdx.x - 128, smem); gdn_sample(p, (int)blockIdx.x, smem);
        if (blockIdx.x < 192) { const int u = (int)blockIdx.x - 128; swa_item<10, true>(p, u >> 1, 0, u & 1, smem); }
        else { __syncthreads(); convert_seq(cp, 0, 0, (int)blockIdx.x - 192, 64, 256, 0, 3968, (float*)smem); }
        return; }
    for (int item = blockIdx.x; item < 32 * NS; item += gridDim.x) {
        const int xcd = item & 7, iw = item >> 3; const int bh = xcd * 4 + iw / NS, ds = iw % NS; const int b = bh >> 3, h = bh & 7, dvb = ds * 16 * NCW, dv0 = dvb + (wave < NCW ? wave : 0) * 16;
        const unsigned char* rec0 = p->ws + WS_GDN + (size_t)(bh * 64) * CH_BYTES;
        f32x4 S[8];
#pragma unroll
        for (int d = 0; d < 8; ++d) S[d] = (f32x4){0.f, 0.f, 0.f, 0.f};
        u32x4 sa[8], sb[8];
#define SC_LOAD(st, c) do { const unsigned char* r_ = rec0 + (size_t)(c) * CH_BYTES; _Pragma("unroll") for (int i = 0; i < 7; ++i) st[i] = *(const u32x4*)(r_ + (size_t)(i * 512 + tid) * 16); \
        if (tid < 128 * NCW) st[7] = *(const u32x4*)(r_ + CH_UT + (size_t)dvb * 128 + tid * 16); } while (0)
#define SC_STORE(st, buf) do { unsigned char* d_ = smem + (buf) * BUF; _Pragma("unroll") for (int i = 0; i < 7; ++i) *(u32x4*)(d_ + (size_t)(i * 512 + tid) * 16) = st[i]; \
        if (tid < 128 * NCW) *(u32x4*)(d_ + 57344 + tid * 16) = st[7]; } while (0)
        __syncthreads();
        const int glv = __builtin_bit_cast(int, *(const float*)(rec0 + (size_t)lane * CH_BYTES + CH_GL));
        SC_LOAD(sa, 0); SC_LOAD(sb, 1);
        SC_STORE(sa, 0);
        __syncthreads();
        bf16_t* opb = OM + (size_t)(b * LP + 4 * kq) * D + h * 128 + dv0 + fr;
        for (int n = 0; n < 64; n += 2) {
            if (n + 2 < 64) SC_LOAD(sa, n + 2);
            if (wave < NCW) scan_chunk(S, smem, __builtin_bit_cast(float, __builtin_amdgcn_readlane(glv, n)), opb + (size_t)(n * 64) * D, lane, fr, kq, wave);
            SC_STORE(sb, 1);
            __syncthreads();
            if (n + 3 < 64) SC_LOAD(sb, n + 3);
            if (wave < NCW) scan_chunk(S, smem + BUF, __builtin_bit_cast(float, __builtin_amdgcn_readlane(glv, n + 1)), opb + (size_t)((n + 1) * 64) * D, lane, fr, kq, wave);
            if (n + 2 < 64) SC_STORE(sa, 0);
            __syncthreads();
        }
#undef SC_LOAD
#undef SC_STORE
        if (wave < NCW) {
            float* pd = p->out + O_PDELTA + (size_t)bh * 128 * 128;
#pragma unroll
            for (int d = 0; d < 8; ++d)
#pragma unroll
                for (int r = 0; r < 4; ++r) pd[(size_t)(16 * d + 4 * kq + r) * 128 + dv0 + fr] = S[d][r];
        }
    }
}

__device__ __forceinline__ void phase5(PP p) {
    const bf16_t* PROJ = (const bf16_t*)(p->ws + WS_PROJ); bf16_t* OM = (bf16_t*)(p->ws + WS_H);
    const int tid = threadIdx.x, sub = tid & 15, grp = tid >> 4;
    const float* gw = p->in[17];
    for (int pr = blockIdx.x * 32 + grp; pr < MP * 8; pr += gridDim.x * 32) {
        const int m = pr >> 3, h = pr & 7;
        bf16_t* op = OM + (size_t)m * D + h * 128 + sub * 8;
        float o[8], z[8]; unpack8(*(const u32x4*)op, o); unpack8(*(const u32x4*)(PROJ + (size_t)m * NPROJ + 3072 + h * 128 + sub * 8), z);
        float ss = 0.f;
#pragma unroll
        for (int j = 0; j < 8; ++j) ss += o[j] * o[j];
        ss += __shfl_xor(ss, 1); ss += __shfl_xor(ss, 2); ss += __shfl_xor(ss, 4); ss += __shfl_xor(ss, 8);
        const float rs = rsqrtf(ss * (1.0f / 128.f) + EPS);
        float w[8];
#pragma unroll
        for (int j = 0; j < 8; ++j) w[j] = o[j] * rs * gw[sub * 8 + j] * silu_f(z[j]);
        u32x4 pk; pk.x = cvt_pk_bf16(w[0], w[1]); pk.y = cvt_pk_bf16(w[2], w[3]); pk.z = cvt_pk_bf16(w[4], w[5]); pk.w = cvt_pk_bf16(w[6], w[7]);
        *(u32x4*)op = pk;
    }
}

__device__ __forceinline__ void phase9(PP p) {
    const float* HEAD = (const float*)(p->ws + WS_HEAD); const float* HALO = (const float*)(p->ws + WS_HALO); const float* US = (const float*)(p->ws + WS_US);
    bf16_t* ACT = (bf16_t*)(p->ws + WS_PROJ); const float* cw = p->in[23]; const float* cb = p->in[24]; const float* st = p->in[6]; float* outp = p->out;
    const int gt = blockIdx.x * NTHR + threadIdx.x, gs = gridDim.x * NTHR;
    constexpr int FQ = FF / 4, FQ2 = FF2 / 4;
    const f32x4 z4 = {0.f, 0.f, 0.f, 0.f};
    for (int e = gt; e < 256 * 2 * FQ; e += gs) {
        const int c = (e % FQ) * 4, rr = (e / FQ) & 1, blk = e / (2 * FQ);
        const bool first = (blk & 63) == 0;
        f32x4 uc[2];
#pragma unroll
        for (int s = 0; s < 2; ++s) { const int cu = c + s * FF;
            const f32x4 u0 = *(const f32x4*)(HEAD + (size_t)(blk * 2 + rr) * FF2 + cu);
            const float* h1 = first ? HEAD : HALO + (size_t)((blk - 1) * 2 + 1) * FF2; const float* h0 = first ? HEAD : HALO + (size_t)((blk - 1) * 2) * FF2;
            const f32x4 a1 = *(const f32x4*)(h1 + cu), a0 = *(const f32x4*)(h0 + cu), hd0 = *(const f32x4*)(HEAD + (size_t)(blk * 2) * FF2 + cu);
            const f32x4 u1 = rr == 0 ? (first ? z4 : a1) : hd0;
            const f32x4 u2 = rr == 0 ? (first ? z4 : a0) : (first ? z4 : a1);
            uc[s] = *(const f32x4*)(cw + 2 * FF2 + cu) * u0 + *(const f32x4*)(cw + FF2 + cu) * u1 + *(const f32x4*)(cw + cu) * u2 + *(const f32x4*)(cb + cu); }
        u32x2 w; w.x = cvt_pk_bf16(silu_f(uc[0][0]) * uc[1][0], silu_f(uc[0][1]) * uc[1][1]); w.y = cvt_pk_bf16(silu_f(uc[0][2]) * uc[1][2], silu_f(uc[0][3]) * uc[1][3]);
        *(u32x2*)(ACT + (size_t)(blk * 64 + rr) * FF + c) = w;
    }
    for (int e = gt; e < MS * FQ; e += gs) {
        const int c = (e % FQ) * 4, row = e / FQ, b = row >> 4, t = row & 15;
        f32x4 uc[2];
#pragma unroll
        for (int s = 0; s < 2; ++s) { const int cu = c + s * FF;
            const f32x4 u0 = *(const f32x4*)(US + (size_t)row * FF2 + cu);
            const f32x4 u1 = *(const f32x4*)((t >= 1 ? US + (size_t)(row - 1) * FF2 : st + (size_t)(b * 2 + 1) * FF2) + cu);
            const f32x4 u2 = *(const f32x4*)((t >= 2 ? US + (size_t)(row - 2) * FF2 : st + (size_t)(b * 2 + t) * FF2) + cu);
            uc[s] = *(const f32x4*)(cw + 2 * FF2 + cu) * u0 + *(const f32x4*)(cw + FF2 + cu) * u1 + *(const f32x4*)(cw + cu) * u2 + *(const f32x4*)(cb + cu); }
        u32x2 w; w.x = cvt_pk_bf16(silu_f(uc[0][0]) * uc[1][0], silu_f(uc[0][1]) * uc[1][1]); w.y = cvt_pk_bf16(silu_f(uc[0][2]) * uc[1][2], silu_f(uc[0][3]) * uc[1][3]);
        *(u32x2*)(ACT + (size_t)(MP + row) * FF + c) = w;
    }
    for (int e = gt; e < 4 * 2 * FQ2; e += gs) { const int cu = (e % FQ2) * 4, rr = (e / FQ2) & 1, b = e / (2 * FQ2); *(f32x4*)(outp + O_PFFN + (size_t)e * 4) = *(const f32x4*)(HALO + (size_t)((b * 64 + 63) * 2 + rr) * FF2 + cu); }
    for (int e = gt; e < 32 * 2 * FQ2; e += gs) { const int cu = (e % FQ2) * 4, rr = (e / FQ2) & 1, b = e / (2 * FQ2); *(f32x4*)(outp + O_SFFN + (size_t)e * 4) = *(const f32x4*)(US + (size_t)(b * 16 + 14 + rr) * FF2 + cu); }
}

#define XB_TMO      128
#define XB_XCNT(j)  (256  + 64 * (j))
#define XB_XSUB(j)  (1280 + 64 * (j))
#define XB_XGEN(j)  (2304 + 64 * (j))
#define XB_TOP      3328
#define XB_TOPGEN   3392
#define XCD_BAR_WORDS 3456
#define XB_SPIN_CAP (1u << 18)
__device__ __forceinline__ unsigned xb_ld(unsigned* p)              { return __hip_atomic_load(p, __ATOMIC_RELAXED, __HIP_MEMORY_SCOPE_AGENT); }
__device__ __forceinline__ unsigned xb_add(unsigned* p, unsigned v) { return __hip_atomic_fetch_add(p, v, __ATOMIC_RELAXED, __HIP_MEMORY_SCOPE_AGENT); }
__device__ __forceinline__ unsigned xb_xcc_id() { return (unsigned)__builtin_amdgcn_s_getreg((3 << 11) | 20) & 0xFu; }
#define XB_SPIN(cond, bar) do { unsigned _sp = 0; while (cond) { __builtin_amdgcn_s_sleep(1); \
    if ((++_sp & 255u) == 0u) { if (xb_ld(&(bar)[XB_TMO])) break; if (_sp > XB_SPIN_CAP) { atomicAdd(&(bar)[XB_TMO], 1u); break; } } } } while (0)
struct XcdBarrier { unsigned* bar; unsigned x; volatile LAS unsigned* st; };
__device__ __forceinline__ bool sum_ok(unsigned* bar) { return xb_ld(&bar[XB_TMO]) == 0u; }
__device__ __forceinline__ XcdBarrier xcd_barrier_post(unsigned* bar, volatile LAS unsigned* st) {
    XcdBarrier b; b.bar = bar; b.x = xb_xcc_id(); b.st = st;
    if (threadIdx.x == 0) st[2] = xb_add(&bar[XB_XCNT(b.x)], 1u);
    return b;
}
__device__ __forceinline__ void xcd_barrier_complete(unsigned* bar, unsigned x, unsigned& nloc, unsigned& nx, unsigned& all32) {
    const unsigned G = gridDim.x * gridDim.y * gridDim.z;
    unsigned sum, cnt, mine, sp = 0u;
    for (;;) {
        sum = 0u; cnt = 0u; mine = 0u; all32 = 1u;
#pragma unroll
        for (unsigned j = 0; j < 16; ++j) { const unsigned c = xb_ld(&bar[XB_XCNT(j)]); sum += c; cnt += (c > 0u) ? 1u : 0u; mine = (j == x) ? c : mine; if (c != 0u && c != 32u) all32 = 0u; }
        if (sum == G) break;
        __builtin_amdgcn_s_sleep(1);
        if ((++sp & 255u) == 0u) { if (xb_ld(&bar[XB_TMO])) break; if (sp > XB_SPIN_CAP) { atomicAdd(&bar[XB_TMO], 1u); break; } }
    }
    nloc = mine > 0u ? mine : 1u; nx = cnt > 0u ? cnt : 1u;
}
__device__ __forceinline__ void xcd_barrier(const XcdBarrier& b) {
    asm volatile("s_waitcnt vmcnt(0)" ::: "memory");
    __syncthreads();
    if (threadIdx.x == 0) {
        unsigned* bar = b.bar;
        __builtin_amdgcn_s_waitcnt(0);
        unsigned nloc = b.st[0], nx = b.st[1];
        if (nloc == 0u) { unsigned all32 = 0u; xcd_barrier_complete(bar, b.x, nloc, nx, all32); b.st[0] = nloc; b.st[1] = nx; b.st[3] = (all32 != 0u && nx == 8u && sum_ok(bar)) ? 1u : 0u; }
        const unsigned old = xb_add(&bar[XB_XSUB(b.x)], 1u);
        const unsigned gen = old / nloc;
        if (old + 1u == (gen + 1u) * nloc) {
            __builtin_amdgcn_fence(__ATOMIC_RELEASE, "agent");
            asm volatile("s_waitcnt vmcnt(0)" ::: "memory");
            const unsigned og = xb_add(&bar[XB_TOP], 1u);
            const unsigned tg = og / nx;
            if (og + 1u == (tg + 1u) * nx) xb_add(&bar[XB_TOPGEN], 1u);
            else XB_SPIN(xb_ld(&bar[XB_TOPGEN]) == tg, bar);
            __builtin_amdgcn_fence(__ATOMIC_ACQUIRE, "agent");
            xb_add(&bar[XB_XGEN(b.x)], 1u);
            asm volatile("s_waitcnt vmcnt(0)" ::: "memory");
        } else {
            XB_SPIN(xb_ld(&bar[XB_XGEN(b.x)]) == gen, bar);
            __builtin_amdgcn_fence(__ATOMIC_ACQUIRE, "agent");
            asm volatile("s_waitcnt vmcnt(0)" ::: "memory");
        }
    }
    __syncthreads();
}

constexpr int N_PHASES = 12;
__global__ void __launch_bounds__(NTHR, 2) hybrid_fwd(Params p_) {
    extern __shared__ __attribute__((aligned(16))) unsigned char smem[];
    PP p = (PP)__builtin_amdgcn_kernarg_segment_ptr();
    const int lo = p->ph_lo, hi = p->ph_hi;
    const int G = gridDim.x;
    volatile LAS unsigned* bst = (volatile LAS unsigned*)((LAS unsigned char*)smem + LDS_BYTES - 16);
    XcdBarrier xbar; xbar.bar = (unsigned*)(p->ws + WS_BAR); xbar.x = 0; xbar.st = bst;
    if (hi - lo > 1) { if (threadIdx.x < 4) bst[threadIdx.x] = 0u; __syncthreads(); xbar = xcd_barrier_post((unsigned*)(p->ws + WS_BAR), bst); }
#ifndef PH_MASK
#define PH_MASK 0xfff
#endif
#define IN(k) (((PH_MASK >> (k)) & 1) && lo <= (k) && (k) < hi)
#ifndef REP_MASK
#define REP_MASK 0
#endif
#define VCU() ((bst[3] == 1u && (hi - lo > 1)) ? (int)(xbar.x + 8u * bst[2]) : (int)blockIdx.x)
#define LAUNDER() asm volatile("" : "+s"(p))
#define REP(k) for (int rep_ = 0; rep_ < 1 + ((REP_MASK >> (k)) & 1); ++rep_)
#define SEAM(k) do { if (IN(k) && IN((k) + 1)) { xcd_barrier(xbar); } } while (0)
    if (hi == 0x7fffffff) cg::this_grid().sync();
    LAUNDER();
    if (IN(0)) REP(0) phase0(p, smem);
    SEAM(0);
    LAUNDER();
    if (IN(1)) REP(1) norm_phase(p, p->in[0], p->in[1], p->in[11], 0, false);
    SEAM(1);
    LAUNDER();
    if (IN(2)) REP(2) { pg8::Gemm g{(const bf16_t*)(p->ws + WS_H), (const bf16_t*)(p->ws + WS_WIN), MT, NIN_PAD, D, D}; pg8::StaticOrder S; S.init(MT, NIN_PAD, G, VCU());
        Epi1 E{(bf16_t*)(p->ws + WS_PROJ), (float*)(p->ws + WS_AB)}; pg8::gemm_phase<Epi1, pg8::StaticOrder>((LAS unsigned char*)smem, g, S, E); }
    SEAM(2);
    LAUNDER();
    if (IN(3)) REP(3) phase3(p, smem);
    SEAM(3);
    LAUNDER();
    if (IN(4)) REP(4) phase4(p, smem);
    SEAM(4);
    LAUNDER();
    if (IN(5)) phase5(p);
    SEAM(5);
    LAUNDER();
    if (IN(6)) REP(6) { pg8::Gemm g{(const bf16_t*)(p->ws + WS_H), (const bf16_t*)(p->ws + WS_WO), MP, D, D, D}; pg8::StaticOrder S; S.init(MP, D, G, VCU());
        EpiRes E{p->in[0], p->in[1], p->out, (const float*)(p->ws + WS_MOD), 2}; pg8::gemm_phase<EpiRes, pg8::StaticOrder>((LAS unsigned char*)smem, g, S, E);
        pg8::Gemm g2{(const bf16_t*)(p->ws + WS_H) + (size_t)MP * D, (const bf16_t*)(p->ws + WS_WO), MS, D, 256, D}; pg8::SplitOrder S2; S2.init(MS, D, D / 256, G, VCU());
        EpiPart E2{(float*)(p->ws + WS_GDN)}; pg8::gemm_phase<EpiPart, pg8::SplitOrder>((LAS unsigned char*)smem, g2, S2, E2); }
    SEAM(6);
    LAUNDER();
    if (IN(7)) REP(7) norm_phase(p, p->out, p->in[1], p->in[12], 3, true);
    SEAM(7);
    LAUNDER();
    if (IN(8)) REP(8) { pg8::Gemm g{(const bf16_t*)(p->ws + WS_H), (const bf16_t*)(p->ws + WS_WUP), MT, FF2, D, D}; pg8::StaticOrder S; S.init(MT, FF2, G, VCU());
        Epi3 E{(bf16_t*)(p->ws + WS_PROJ), (float*)(p->ws + WS_HEAD), (float*)(p->ws + WS_HALO), (float*)(p->ws + WS_US), p->in[23], p->in[24]}; pg8::gemm_phase<Epi3, pg8::StaticOrder>((LAS unsigned char*)smem, g, S, E); }
    SEAM(8);
    LAUNDER();
    if (IN(9)) REP(9) phase9(p);
    SEAM(9);
    LAUNDER();
    if (IN(10)) { pg8::Gemm g{(const bf16_t*)(p->ws + WS_PROJ), (const bf16_t*)(p->ws + WS_WDN), MP, D, FF, FF}; pg8::StaticOrder S; S.init(MP, D, G, VCU());
        EpiRes E{p->out, p->out + (size_t)MP * D, p->out, (const float*)(p->ws + WS_MOD), 5}; pg8::gemm_phase<EpiRes, pg8::StaticOrder>((LAS unsigned char*)smem, g, S, E);
        pg8::Gemm g2{(const bf16_t*)(p->ws + WS_PROJ) + (size_t)MP * FF, (const bf16_t*)(p->ws + WS_WDN), MS, D, 512, FF}; pg8::SplitOrder S2; S2.init(MS, D, FF / 512, G, VCU());
        EpiPart E2{(float*)(p->ws + WS_GDN)}; pg8::gemm_phase<EpiPart, pg8::SplitOrder>((LAS unsigned char*)smem, g2, S2, E2); }
    SEAM(10);
    LAUNDER();
    if (IN(11)) {
        const float* part = (const float*)(p->ws + WS_GDN); const float* mod = (const float*)(p->ws + WS_MOD);
        for (int e = blockIdx.x * NTHR + threadIdx.x; e < MS * D / 4; e += G * NTHR) { const int row = e >> 9, c = (e & 511) * 4; f32x4 a = {0.f, 0.f, 0.f, 0.f};
#pragma unroll
            for (int sp = 0; sp < 11; ++sp) a += *(const f32x4*)(part + (size_t)sp * MS * D + (size_t)row * D + c);
            float* o = p->out + (size_t)(MP + row) * D + c; *(f32x4*)o = *(const f32x4*)o + *(const f32x4*)(mod + (size_t)(4 + (row >> 4)) * NMODW + 5 * D + c) * a; } }
#undef IN
#undef SEAM
}

extern "C" void kernel_launch(void* const* d_in, const int* in_sizes, int n_in, void* d_out, int out_size, void* d_ws, size_t ws_size, hipStream_t stream) {
    static int grid = 0;
    if (grid == 0) {
        if (n_in != 26 || (size_t)out_size != O_END || ws_size < WS_ALL) { fprintf(stderr, "kernel_launch: unexpected shapes (n_in %d out %d ws %zu)\n", n_in, out_size, ws_size); grid = -1; return; }
        int dev = 0, cus = 0, per_cu = 0;
        hipGetDevice(&dev); hipDeviceGetAttribute(&cus, hipDeviceAttributeMultiprocessorCount, dev);
        if (hipFuncSetAttribute((const void*)hybrid_fwd, hipFuncAttributeMaxDynamicSharedMemorySize, LDS_BYTES) != hipSuccess) { fprintf(stderr, "kernel_launch: hipFuncSetAttribute failed\n"); grid = -1; return; }
        if (hipOccupancyMaxActiveBlocksPerMultiprocessor(&per_cu, (const void*)hybrid_fwd, NTHR, LDS_BYTES) != hipSuccess || per_cu < 1) { fprintf(stderr, "kernel_launch: occupancy query says %d\n", per_cu); per_cu = 1; }
        (void)hipGetLastError();
        grid = cus * 1;
    }
    if (grid < 0) return;
    Params p{};
    for (int i = 0; i < 26; ++i) p.in[i] = (const float*)d_in[i];
    p.out = (float*)d_out; p.ws = (unsigned char*)d_ws;
#if N_LAUNCH_MODE == 1
    if (hipMemsetAsync((char*)d_ws + WS_BAR, 0, 16384, stream) != hipSuccess) { fprintf(stderr, "kernel_launch: memset failed\n"); return; }
    p.ph_lo = 0; p.ph_hi = N_PHASES;
    void* args[] = {&p};
    hipError_t e = hipLaunchCooperativeKernel((const void*)hybrid_fwd, dim3(grid), dim3(NTHR), args, LDS_BYTES, stream);
    if (e != hipSuccess) fprintf(stderr, "cooperative launch failed: %s (grid %d)\n", hipGetErrorString(e), grid);
#else
    for (int ph = 0; ph < N_PHASES; ++ph) { p.ph_lo = ph; p.ph_hi = ph + 1; hipLaunchKernelGGL(hybrid_fwd, dim3(grid), dim3(NTHR), LDS_BYTES, stream, p); }
#endif
}
```

```cpp
#include <hip/hip_runtime.h>
#include <hip/hip_cooperative_groups.h>
#include <cstdio>
#include <cstdint>
namespace cg = cooperative_groups;

#ifndef N_LAUNCH_MODE
#define N_LAUNCH_MODE 1
#endif

#define LAS __attribute__((address_space(3)))
typedef unsigned short bf16_t;
typedef short bf16x8 __attribute__((ext_vector_type(8)));
typedef float f32x4 __attribute__((ext_vector_type(4)));
typedef float f32x2 __attribute__((ext_vector_type(2)));
typedef unsigned u32x4 __attribute__((ext_vector_type(4)));
typedef unsigned u32x2 __attribute__((ext_vector_type(2)));

constexpr int D = 2048, MP = 16384, MS = 512, MT = MP + MS, LP = 4096, LS = 16, NBP = 4, NBS = 32;
constexpr int NPROJ = 5632, NIN_PAD = 5888, INW = 5648, FF = 5632, FF2 = 11264;
constexpr int NMODW = 12288;
constexpr float EPS = 1e-6f;
constexpr int NTHR = 512;
constexpr int LDS_BYTES = 163840;

constexpr size_t O_YP = 0, O_YS = O_YP + (size_t)MP * D, O_PCONV = O_YS + (size_t)MS * D, O_PDELTA = O_PCONV + 4 * 3 * 3072,
                 O_PK = O_PDELTA + (size_t)4 * 8 * 128 * 128, O_PV = O_PK + 4 * 128 * 2 * 128, O_PFFN = O_PV + 4 * 128 * 2 * 128,
                 O_SCONV = O_PFFN + 4 * 2 * FF2, O_SDELTA = O_SCONV + 32 * 3 * 3072, O_SK = O_SDELTA + (size_t)32 * 8 * 128 * 128,
                 O_SV = O_SK + 32 * 128 * 2 * 128, O_SFFN = O_SV + 32 * 128 * 2 * 128, O_END = O_SFFN + 32 * 2 * FF2;

constexpr size_t WS_WUP = 0, WS_WDN = WS_WUP + (size_t)FF2 * D * 2, WS_WIN = WS_WDN + (size_t)D * FF * 2, WS_WO = WS_WIN + (size_t)NIN_PAD * D * 2,
                 WS_MOD = WS_WO + (size_t)D * D * 2, WS_AB = WS_MOD + (size_t)36 * NMODW * 4, WS_H = WS_AB + (size_t)MT * 16 * 4,
                 WS_PROJ = WS_H + (size_t)MT * D * 2, WS_GDN = WS_PROJ + (size_t)MT * NPROJ * 2;
constexpr size_t CH_BYTES = 73984, CH_W = 0, CH_QG = 16384, CH_QK = 32768, CH_KD = 40960, CH_UT = 57344, CH_GL = 73728;
constexpr size_t WS_END = WS_GDN + (size_t)2048 * CH_BYTES;
constexpr size_t WS_HEAD = WS_GDN, WS_HALO = WS_HEAD + (size_t)256 * 2 * FF2 * 4, WS_US = WS_HALO + (size_t)256 * 2 * FF2 * 4;
static_assert(WS_US + (size_t)MS * FF2 * 4 <= WS_END, "ffn side buffers");
constexpr size_t WS_BAR = WS_END, WS_ALL = WS_BAR + 16384;
static_assert(WS_ALL <= (size_t)536870912, "workspace");

struct Params { const float* in[26]; float* out; unsigned char* ws; int ph_lo, ph_hi; };
typedef const __attribute__((address_space(4))) Params* PP;

typedef __bf16 bf16x2_t __attribute__((ext_vector_type(2)));
__device__ __forceinline__ unsigned cvt_pk_bf16(float lo, float hi) { f32x2 f = {lo, hi}; bf16x2_t v = __builtin_convertvector(f, bf16x2_t); return __builtin_bit_cast(unsigned, v); }
__device__ __forceinline__ float bf_lo(unsigned u) { return __uint_as_float(u << 16); }
__device__ __forceinline__ float bf_hi(unsigned u) { return __uint_as_float(u & 0xffff0000u); }
__device__ __forceinline__ float bf2f(bf16_t b) { return __uint_as_float(((unsigned)b) << 16); }
__device__ __forceinline__ float silu_f(float x) { return x * __builtin_amdgcn_rcpf(1.0f + __expf(-x)); }
__device__ __forceinline__ float sigmoid_f(float x) { return __builtin_amdgcn_rcpf(1.0f + __expf(-x)); }
__device__ __forceinline__ float softplus_f(float x) { return x > 20.f ? x : log1pf(__expf(x)); }
template <int CTRL> __device__ __forceinline__ float dpp0(float v) { return __builtin_bit_cast(float, __builtin_amdgcn_update_dpp(0, __builtin_bit_cast(int, v), CTRL, 0xf, 0xf, true)); }
__device__ __forceinline__ int cond_of_row(int m) { return m < MP ? (m >> 12) : 4 + ((m - MP) >> 4); }
__device__ __forceinline__ void unpack8(u32x4 v, float* f) { f[0] = bf_lo(v.x); f[1] = bf_hi(v.x); f[2] = bf_lo(v.y); f[3] = bf_hi(v.y); f[4] = bf_lo(v.z); f[5] = bf_hi(v.z); f[6] = bf_lo(v.w); f[7] = bf_hi(v.w); }
__device__ __forceinline__ bf16x8 as_bf16x8(u32x4 v) { return __builtin_bit_cast(bf16x8, v); }

namespace pg8 {
constexpr int BM = 256, BK = 64, HALF = 128, HTB = HALF * BK * 2, STAGE_BYTES = 8 * HTB, NXCD = 8, WGM = 2;
__host__ __device__ __forceinline__ int lds_byte(int r, int c) { const int st = (r >> 4) * 2 + (c >> 5), rr = r & 15, cc = c & 31, ob = rr * 64 + cc * 2; return st * 1024 + (ob ^ (((ob >> 9) & 1) << 5)); }
__host__ __device__ __forceinline__ void stage_rc(int b, int& R, int& C) { const int st = b / 1024, sb = b % 1024, swz = sb ^ (((sb >> 9) & 1) << 5); R = (st >> 1) * 16 + swz / 64; C = (st & 1) * 32 + (swz % 64) / 2; }
struct Unit { int pm, pn, ks; };
struct Gemm { const bf16_t* A; const bf16_t* Bt; int M, N, K, ldk; };
struct StaticOrder {
    int nM, nN, nwg, G, c;
    __host__ __device__ __forceinline__ void init(int M, int N, int G_, int c_) { nM = M / BM; nN = N / BM; nwg = nM * nN; G = G_; c = c_; }
    __host__ __device__ bool next(int i, Unit& u) const {
        const long L = (long)i * G + c; if (L >= nwg) return false;
        int wgid = (int)L; { const int q = nwg / NXCD, r = nwg % NXCD, xcd = wgid % NXCD, off = wgid / NXCD; wgid = (xcd < r ? xcd * (q + 1) : r * (q + 1) + (xcd - r) * q) + off; }
        const int nig = WGM * nN, gid = wgid / nig, fm = gid * WGM, gsz = (nM - fm) < WGM ? (nM - fm) : WGM;
        u.pm = fm + ((wgid % nig) % gsz); u.pn = (wgid % nig) / gsz; u.ks = 0; return true;
    }
};
struct SplitOrder {
    int nM, nN, nS, nwg, G, c;
    __host__ __device__ __forceinline__ void init(int M, int N, int nS_, int G_, int c_) { nM = M / BM; nN = N / BM; nS = nS_; nwg = nM * nN * nS; G = G_; c = c_; }
    __host__ __device__ bool next(int i, Unit& u) const {
        const long L = (long)i * G + c; if (L >= nwg) return false;
        const int l = (int)L; u.ks = l % nS; const int t = l / nS; u.pn = t % nN; u.pm = t / nN; return true;
    }
};

template <class Epi, class Sched>
__device__ __forceinline__ void gemm_phase(LAS unsigned char* lds, const Gemm g, const Sched& S, const Epi& E) {
    const int tid = threadIdx.x, wid = __builtin_amdgcn_readfirstlane(tid >> 6), lane = tid & 63, wr = wid >> 2, wc = wid & 3, fr = lane & 15, fq = lane >> 4;
    const int K = g.ldk, nt = g.K / BK;
    const size_t sstep = (size_t)g.K * 2;
    unsigned voffA[2];
#pragma unroll
    for (int i = 0; i < 2; ++i) { int R, C; stage_rc(tid * 16 + i * 8192, R, C); voffA[i] = (unsigned)(R * K + C) * 2u; }
    const size_t kstep = (size_t)(BK * 2);
    const size_t hstep = (size_t)HALF * K * 2;
    const size_t tstep = 2 * hstep;
    const unsigned ldsw = (unsigned)wid * 1024u;
    const int aoff = lds_byte(wr * 64 + fr, fq * 8), boff = lds_byte(wc * 32 + fr, fq * 8);
#define PG8_SA(b, h) (((b) * 2 + (h)) * HTB)
#define PG8_SB(b, h) ((4 + (b) * 2 + (h)) * HTB)
#define PG8_STAGE(bufoff, gbase, voff) do { _Pragma("unroll") for (int _i = 0; _i < 2; ++_i) \
        __builtin_amdgcn_global_load_lds((const unsigned*)((const char*)(gbase) + (voff)[_i]), (LAS unsigned*)(lds + (bufoff) + ldsw + _i * 8192), 16, 0, 0); } while (0)
#define PG8_LDA(dst, b, h) do { _Pragma("unroll") for (int m = 0; m < 4; ++m) _Pragma("unroll") for (int k = 0; k < 2; ++k) dst[m][k] = *(const LAS bf16x8*)(lds + PG8_SA(b, h) + aoff + m * 2048 + k * 1024); } while (0)
#define PG8_LDB(dst, b, h) do { _Pragma("unroll") for (int n = 0; n < 2; ++n) _Pragma("unroll") for (int k = 0; k < 2; ++k) dst[n][k] = *(const LAS bf16x8*)(lds + PG8_SB(b, h) + boff + n * 2048 + k * 1024); } while (0)
#define PG8_MMA(ai, bj, At, Bt) do { __builtin_amdgcn_s_setprio(1); _Pragma("unroll") for (int m = 0; m < 4; ++m) _Pragma("unroll") for (int n = 0; n < 2; ++n) _Pragma("unroll") for (int k = 0; k < 2; ++k) \
        acc[ai][bj][m][n] = __builtin_amdgcn_mfma_f32_16x16x32_bf16(Bt[n][k], At[m][k], acc[ai][bj][m][n], 0, 0, 0); __builtin_amdgcn_s_setprio(0); } while (0)
#define PG8_WAIT_V(n) asm volatile("s_waitcnt vmcnt(" #n ")" ::: "memory")
#define PG8_WAIT_L(n) asm volatile("s_waitcnt lgkmcnt(" #n ")" ::: "memory")
#define PG8_BAR __builtin_amdgcn_s_barrier()
#define PG8_SCHED __builtin_amdgcn_sched_barrier(0)
    Unit cur, nxt; int ui = 0;
    if (!S.next(0, cur)) return;
    f32x4 acc[2][2][4][2];
#pragma unroll
    for (int a = 0; a < 2; ++a)
#pragma unroll
        for (int b = 0; b < 2; ++b)
#pragma unroll
            for (int m = 0; m < 4; ++m)
#pragma unroll
                for (int n = 0; n < 2; ++n) acc[a][b][m][n] = (f32x4){0.f, 0.f, 0.f, 0.f};
    bf16x8 At[4][2], B0[2][2], B1[2][2];
    const char* cA = (const char*)g.A + (size_t)cur.pm * tstep + cur.ks * sstep; const char* cB = (const char*)g.Bt + (size_t)cur.pn * tstep + cur.ks * sstep;
    PG8_STAGE(PG8_SB(0, 0), cB, voffA); PG8_STAGE(PG8_SA(0, 0), cA, voffA); PG8_STAGE(PG8_SB(0, 1), cB + hstep, voffA); PG8_STAGE(PG8_SA(0, 1), cA + hstep, voffA);
    if (wr == 1) PG8_BAR;
    PG8_WAIT_V(4); PG8_BAR;
    PG8_STAGE(PG8_SB(1, 0), cB + kstep, voffA); PG8_STAGE(PG8_SA(1, 0), cA + kstep, voffA); PG8_STAGE(PG8_SB(1, 1), cB + hstep + kstep, voffA);
    PG8_WAIT_V(6); PG8_BAR;
    for (;;) {
        const bool has_next = S.next(ui + 1, nxt);
        const char* nA = has_next ? (const char*)g.A + (size_t)nxt.pm * tstep + nxt.ks * sstep : cA; const char* nB = has_next ? (const char*)g.Bt + (size_t)nxt.pn * tstep + nxt.ks * sstep : cB;
        for (int t = 0; t < nt; t += 2) {
            const bool last = (t == nt - 2);
            const char* a1 = cA + (size_t)(t + 1) * kstep;
            const char* a2 = last ? nA : cA + (size_t)(t + 2) * kstep; const char* b2 = last ? nB : cB + (size_t)(t + 2) * kstep;
            const char* a3 = a2 + kstep; const char* b3 = b2 + kstep;
            PG8_LDB(B0, 0, 0); PG8_SCHED; PG8_LDA(At, 0, 0); PG8_STAGE(PG8_SA(1, 1), a1 + hstep, voffA);
            PG8_WAIT_L(8); PG8_BAR; PG8_WAIT_L(0); PG8_MMA(0, 0, At, B0); PG8_BAR; PG8_SCHED;
            PG8_LDB(B1, 0, 1); PG8_STAGE(PG8_SB(0, 0), b2, voffA);
            PG8_BAR; PG8_WAIT_L(0); PG8_MMA(0, 1, At, B1); PG8_BAR;
            PG8_LDA(At, 0, 1); PG8_STAGE(PG8_SA(0, 0), a2, voffA);
            PG8_BAR; PG8_WAIT_L(0); PG8_MMA(1, 0, At, B0); PG8_BAR; PG8_SCHED;
            PG8_STAGE(PG8_SB(0, 1), b2 + hstep, voffA);
            PG8_WAIT_V(6); PG8_BAR; PG8_MMA(1, 1, At, B1); PG8_BAR;
            PG8_LDB(B0, 1, 0); PG8_SCHED; PG8_LDA(At, 1, 0); PG8_STAGE(PG8_SA(0, 1), a2 + hstep, voffA);
            PG8_WAIT_L(8); PG8_BAR; PG8_WAIT_L(0); PG8_MMA(0, 0, At, B0); PG8_BAR; PG8_SCHED;
            PG8_LDB(B1, 1, 1); PG8_STAGE(PG8_SB(1, 0), b3, voffA);
            PG8_BAR; PG8_WAIT_L(0); PG8_MMA(0, 1, At, B1); PG8_BAR;
            PG8_LDA(At, 1, 1); PG8_STAGE(PG8_SA(1, 0), a3, voffA);
            PG8_BAR; PG8_WAIT_L(0); PG8_MMA(1, 0, At, B0); PG8_BAR; PG8_SCHED;
            PG8_STAGE(PG8_SB(1, 1), b3 + hstep, voffA);
            PG8_WAIT_V(6); PG8_BAR; PG8_MMA(1, 1, At, B1); PG8_BAR;
        }
        E(acc, cur, wr, wc, fr, fq);
        if (!has_next) break;
#pragma unroll
        for (int a = 0; a < 2; ++a)
#pragma unroll
            for (int b = 0; b < 2; ++b)
#pragma unroll
                for (int m = 0; m < 4; ++m)
#pragma unroll
                    for (int n = 0; n < 2; ++n) acc[a][b][m][n] = (f32x4){0.f, 0.f, 0.f, 0.f};
        cur = nxt; cA = nA; cB = nB; ++ui;
    }
    PG8_WAIT_V(0);
    if (wr == 0) PG8_BAR;
    PG8_BAR;
#undef PG8_SA
#undef PG8_SB
#undef PG8_STAGE
#undef PG8_LDA
#undef PG8_LDB
#undef PG8_MMA
#undef PG8_WAIT_V
#undef PG8_WAIT_L
#undef PG8_BAR
#undef PG8_SCHED
}
}
using pg8::Unit;

struct Epi1 {
    bf16_t* P; float* AB;
    __device__ __forceinline__ void operator()(const f32x4 (&acc)[2][2][4][2], const Unit& u, int wr, int wc, int fr, int fq) const {
        const int row0 = u.pm * 256 + wr * 64 + fr;
        if (u.pn < 22) {
            const int col0 = u.pn * 256 + wc * 32 + 4 * fq;
#pragma unroll
            for (int ai = 0; ai < 2; ++ai)
#pragma unroll
                for (int m = 0; m < 4; ++m) { bf16_t* rowp = P + (size_t)(row0 + ai * 128 + m * 16) * NPROJ + col0;
#pragma unroll
                    for (int bj = 0; bj < 2; ++bj)
#pragma unroll
                        for (int n = 0; n < 2; ++n) { const f32x4 a = acc[ai][bj][m][n]; u32x2 w; w.x = cvt_pk_bf16(a[0], a[1]); w.y = cvt_pk_bf16(a[2], a[3]); *(u32x2*)(rowp + bj * 128 + n * 16) = w; } }
        } else if (wc == 0) {
#pragma unroll
            for (int ai = 0; ai < 2; ++ai)
#pragma unroll
                for (int m = 0; m < 4; ++m) *(f32x4*)(AB + (size_t)(row0 + ai * 128 + m * 16) * 16 + 4 * fq) = acc[ai][0][m][0];
        }
    }
};
struct EpiRes {
    const float* xa; const float* xb; float* out; const float* mod; int gi;
    __device__ __forceinline__ void operator()(const f32x4 (&acc)[2][2][4][2], const Unit& u, int wr, int wc, int fr, int fq) const {
        const int row0 = u.pm * 256 + wr * 64 + fr, col0 = u.pn * 256 + wc * 32 + 4 * fq;
        const float* gr = mod + (size_t)cond_of_row(u.pm * 256) * NMODW + gi * D + col0;
        f32x4 g4[2][2];
#pragma unroll
        for (int bj = 0; bj < 2; ++bj)
#pragma unroll
            for (int n = 0; n < 2; ++n) g4[bj][n] = *(const f32x4*)(gr + bj * 128 + n * 16);
#pragma unroll
        for (int ai = 0; ai < 2; ++ai) {
            f32x4 xv[4][2][2];
#pragma unroll
            for (int m = 0; m < 4; ++m) { const float* xr = xa + (size_t)(row0 + ai * 128 + m * 16) * D + col0;
#pragma unroll
                for (int bj = 0; bj < 2; ++bj)
#pragma unroll
                    for (int n = 0; n < 2; ++n) xv[m][bj][n] = *(const f32x4*)(xr + bj * 128 + n * 16); }
            __builtin_amdgcn_sched_barrier(0);
#pragma unroll
            for (int m = 0; m < 4; ++m) { float* orow = out + (size_t)(row0 + ai * 128 + m * 16) * D + col0;
#pragma unroll
                for (int bj = 0; bj < 2; ++bj)
#pragma unroll
                    for (int n = 0; n < 2; ++n) *(f32x4*)(orow + bj * 128 + n * 16) = xv[m][bj][n] + g4[bj][n] * acc[ai][bj][m][n]; }
        }
    }
};
struct EpiPart {
    float* part;
    __device__ __forceinline__ void operator()(const f32x4 (&acc)[2][2][4][2], const Unit& u, int wr, int wc, int fr, int fq) const {
        const int row0 = u.pm * 256 + wr * 64 + fr, col0 = u.pn * 256 + wc * 32 + 4 * fq;
        float* base = part + (size_t)u.ks * MS * D;
#pragma unroll
        for (int ai = 0; ai < 2; ++ai)
#pragma unroll
            for (int m = 0; m < 4; ++m) { float* orow = base + (size_t)(row0 + ai * 128 + m * 16) * D + col0;
#pragma unroll
                for (int bj = 0; bj < 2; ++bj)
#pragma unroll
                    for (int n = 0; n < 2; ++n) *(f32x4*)(orow + bj * 128 + n * 16) = acc[ai][bj][m][n]; }
    }
};
struct Epi3 {
    bf16_t* ACT; float* HEAD; float* HALO; float* US; const float* cw; const float* cb;
    __device__ __forceinline__ void operator()(const f32x4 (&acc)[2][2][4][2], const Unit& u, int wr, int wc, int fr, int fq) const {
        const int cg0 = u.pn * 128 + wc * 32 + 4 * fq;
        if (u.pm >= 64) {
            const int row0 = (u.pm - 64) * 256 + wr * 64 + fr;
#pragma unroll
            for (int ai = 0; ai < 2; ++ai)
#pragma unroll
                for (int m = 0; m < 4; ++m) { float* rp = US + (size_t)(row0 + ai * 128 + m * 16) * FF2 + cg0;
#pragma unroll
                    for (int bj = 0; bj < 2; ++bj)
#pragma unroll
                        for (int n = 0; n < 2; ++n) *(f32x4*)(rp + bj * FF + n * 16) = acc[ai][bj][m][n]; }
            return;
        }
#pragma unroll
        for (int n = 0; n < 2; ++n) {
            const int cg = cg0 + n * 16;
            f32x4 w0[2], w1[2], w2[2], bb[2];
#pragma unroll
            for (int bj = 0; bj < 2; ++bj) { const int c = cg + bj * FF; w0[bj] = *(const f32x4*)(cw + c); w1[bj] = *(const f32x4*)(cw + FF2 + c); w2[bj] = *(const f32x4*)(cw + 2 * FF2 + c); bb[bj] = *(const f32x4*)(cb + c); }
#pragma unroll
            for (int ai = 0; ai < 2; ++ai) {
                const int blk = u.pm * 4 + ai * 2 + wr;
                const int rowb = blk * 64;
                f32x4 p15[2] = {{0.f, 0.f, 0.f, 0.f}, {0.f, 0.f, 0.f, 0.f}}, p14[2] = {{0.f, 0.f, 0.f, 0.f}, {0.f, 0.f, 0.f, 0.f}};
#pragma unroll
                for (int m = 0; m < 4; ++m) {
                    f32x4 uc[2];
#pragma unroll
                    for (int bj = 0; bj < 2; ++bj) { const f32x4 cur = acc[ai][bj][m][n]; f32x4 pr1, pr2, n15, n14;
#pragma unroll
                        for (int j = 0; j < 4; ++j) { pr1[j] = dpp0<0x111>(cur[j]) + p15[bj][j]; pr2[j] = dpp0<0x112>(cur[j]) + p14[bj][j]; n15[j] = dpp0<0x10F>(cur[j]); n14[j] = dpp0<0x10E>(cur[j]); }
                        p15[bj] = n15; p14[bj] = n14;
                        uc[bj] = w2[bj] * cur + w1[bj] * pr1 + w0[bj] * pr2 + bb[bj];
                        if (m == 0 && fr < 2) *(f32x4*)(HEAD + (size_t)(blk * 2 + fr) * FF2 + cg + bj * FF) = cur;
                        if (m == 3 && fr >= 14) *(f32x4*)(HALO + (size_t)(blk * 2 + fr - 14) * FF2 + cg + bj * FF) = cur;
                    }
                    if (m > 0 || fr >= 2) { u32x2 w; w.x = cvt_pk_bf16(silu_f(uc[0][0]) * uc[1][0], silu_f(uc[0][1]) * uc[1][1]); w.y = cvt_pk_bf16(silu_f(uc[0][2]) * uc[1][2], silu_f(uc[0][3]) * uc[1][3]);
                        *(u32x2*)(ACT + (size_t)(rowb + m * 16 + fr) * FF + cg) = w; }
                }
            }
        }
    }
};

struct TileDesc { const float* W; bf16_t* Wt; int K, N, k0, n0, sc0, nv; };
struct ConvPtrs { const float* up; const float* dn; const float* in; const float* o; unsigned char* ws; };
__device__ __forceinline__ ConvPtrs conv_ptrs(PP p) { ConvPtrs c; c.up = p->in[22]; c.dn = p->in[25]; c.in = p->in[13]; c.o = p->in[21]; c.ws = p->ws; return c; }
__device__ __forceinline__ TileDesc tile_desc(const float* up, const float* dn, const float* win, const float* wo, unsigned char* ws, int t) {
    constexpr int T_UP = 32 * 88, T_DN = 88 * 16, T_IN = 32 * 46;
    const int cls = t < T_UP ? 0 : t < T_UP + T_DN ? 1 : t < T_UP + T_DN + T_IN ? 2 : 3;
    const int u = t - (cls == 0 ? 0 : cls == 1 ? T_UP : cls == 2 ? T_UP + T_DN : T_UP + T_DN + T_IN);
    const int NTn = cls == 0 ? 88 : cls == 2 ? 46 : 16; const int q4 = u >> 2; const int nt = q4 % NTn, kt = (q4 / NTn) * 4 + (u & 3), n0 = nt * 128;
    TileDesc d;
    d.W = cls == 0 ? up : cls == 1 ? dn : cls == 2 ? win : wo;
    d.Wt = (bf16_t*)(ws + (cls == 0 ? WS_WUP : cls == 1 ? WS_WDN : cls == 2 ? WS_WIN : WS_WO));
    d.K = cls == 1 ? FF : D; d.N = cls == 0 ? FF2 : cls == 2 ? INW : D; d.k0 = kt * 64; d.n0 = n0;
    const int pn = n0 >> 8;
    d.sc0 = cls == 0 ? ((n0 & 255) < 128 ? 128 * pn : FF + 128 * pn) : cls == 2 ? (n0 < 4096 ? n0 : (n0 < NPROJ ? n0 + 16 : 4096)) : n0;
    d.nv = cls == 2 ? (n0 < NPROJ ? 128 : (n0 == NPROJ ? 16 : 0)) : 128;
    return d;
}
__device__ __forceinline__ void tile_load(const TileDesc& d, f32x4 (&v)[4]) {
    const int tx = threadIdx.x & 31, ty = threadIdx.x >> 5;
#pragma unroll
    for (int ps = 0; ps < 4; ++ps) v[ps] = (4 * tx < d.nv) ? *(const f32x4*)(d.W + (size_t)(d.k0 + ps * 16 + ty) * d.N + d.sc0 + 4 * tx) : (f32x4){0.f, 0.f, 0.f, 0.f};
}
__device__ __forceinline__ void tile_to_lds(const f32x4 (&v)[4], float* tile) {
    const int tx = threadIdx.x & 31, ty = threadIdx.x >> 5;
#pragma unroll
    for (int ps = 0; ps < 4; ++ps) *(f32x4*)(tile + (ps * 16 + ty) * 132 + ((4 * tx + 8 * ps) & 127)) = v[ps];
}
__device__ __forceinline__ void tile_store(const TileDesc& d, const float* tile) {
    const int n = threadIdx.x >> 2, ks = threadIdx.x & 3; float v[16];
#pragma unroll
    for (int j = 0; j < 16; ++j) v[j] = tile[(ks * 16 + j) * 132 + ((n + 8 * ks) & 127)];
    u32x4 w0, w1; w0.x = cvt_pk_bf16(v[0], v[1]); w0.y = cvt_pk_bf16(v[2], v[3]); w0.z = cvt_pk_bf16(v[4], v[5]); w0.w = cvt_pk_bf16(v[6], v[7]);
    w1.x = cvt_pk_bf16(v[8], v[9]); w1.y = cvt_pk_bf16(v[10], v[11]); w1.z = cvt_pk_bf16(v[12], v[13]); w1.w = cvt_pk_bf16(v[14], v[15]);
    bf16_t* dst = d.Wt + (size_t)(d.n0 + n) * d.K + d.k0 + ks * 16; *(u32x4*)dst = w0; *(u32x4*)(dst + 8) = w1;
}
__device__ __forceinline__ void convert_seq(const ConvPtrs p, int n_extra, int first, int base, int stride, int t_all, int split, int shift, float* tile) {
    const int cnt = n_extra + (base < t_all ? (t_all - base + stride - 1) / stride : 0);
    auto tid_of = [&](int i) { const int v = i < n_extra ? first + 64 * i : base + stride * (i - n_extra); return v < split ? v : v + shift; };
    f32x4 ra[4], rb[4];
    if (cnt > 0) tile_load(tile_desc(p.up, p.dn, p.in, p.o, p.ws, tid_of(0)), ra);
    if (cnt > 1) tile_load(tile_desc(p.up, p.dn, p.in, p.o, p.ws, tid_of(1)), rb);
    for (int i = 0; i < cnt; i += 2) {
        { const TileDesc d = tile_desc(p.up, p.dn, p.in, p.o, p.ws, tid_of(i));
          tile_to_lds(ra, tile); if (i + 2 < cnt) tile_load(tile_desc(p.up, p.dn, p.in, p.o, p.ws, tid_of(i + 2)), ra);
          __syncthreads(); tile_store(d, tile); __syncthreads(); }
        if (i + 1 < cnt) { const TileDesc d = tile_desc(p.up, p.dn, p.in, p.o, p.ws, tid_of(i + 1));
          tile_to_lds(rb, tile); if (i + 3 < cnt) tile_load(tile_desc(p.up, p.dn, p.in, p.o, p.ws, tid_of(i + 3)), rb);
          __syncthreads(); tile_store(d, tile); __syncthreads(); }
    }
}
__device__ __forceinline__ void adaln_strip(PP p, int strip, float* lds) {
    const float* cpr = p->in[7]; const float* csm = p->in[8]; const float* aw = p->in[9]; const float* ab = p->in[10];
    float* mod = (float*)(p->ws + WS_MOD);
    const int tid = threadIdx.x, col4 = tid & 15, kg = (tid >> 4) & 15, rh = tid >> 8;
    float* sc = lds;
    float* red = lds + 36 * 256;
    f32x4 acc[18];
#pragma unroll
    for (int i = 0; i < 18; ++i) acc[i] = (f32x4){0.f, 0.f, 0.f, 0.f};
    const int n0 = strip * 64 + col4 * 4;
    f32x4 w[4], wn[4], wm[4];
#pragma unroll
    for (int q = 0; q < 4; ++q) { w[q] = *(const f32x4*)(aw + (size_t)(kg * 4 + q) * NMODW + n0); wn[q] = *(const f32x4*)(aw + (size_t)(64 + kg * 4 + q) * NMODW + n0); }
#pragma unroll 1
    for (int step = 0; step < 32; ++step) {
        const int kc = (step >> 2) * 256, kl = (step & 3) * 64 + kg * 4;
        if (step + 2 < 32) { const int kn = ((step + 2) >> 2) * 256 + ((step + 2) & 3) * 64 + kg * 4;
#pragma unroll
            for (int q = 0; q < 4; ++q) wm[q] = *(const f32x4*)(aw + (size_t)(kn + q) * NMODW + n0); }
        if ((step & 3) == 0) {
            __syncthreads();
#pragma unroll 1
            for (int hb = 0; hb < 2; ++hb) {
                float cv[9];
#pragma unroll
                for (int it2 = 0; it2 < 9; ++it2) { const int e = tid + (hb * 9 + it2) * NTHR, i = e >> 8, k = e & 255; cv[it2] = i < 4 ? cpr[i * D + kc + k] : csm[(i - 4) * D + kc + k]; }
#pragma unroll
                for (int it2 = 0; it2 < 9; ++it2) sc[tid + (hb * 9 + it2) * NTHR] = silu_f(cv[it2]);
            }
            __syncthreads();
        }
#pragma unroll
        for (int i = 0; i < 18; ++i) { const f32x4 s4 = *(const f32x4*)(sc + (rh * 18 + i) * 256 + kl);
            acc[i] += w[0] * s4[0]; acc[i] += w[1] * s4[1]; acc[i] += w[2] * s4[2]; acc[i] += w[3] * s4[3]; }
#pragma unroll
        for (int q = 0; q < 4; ++q) { w[q] = wn[q]; wn[q] = wm[q]; }
    }
    __syncthreads();
    for (int g = 0; g < 16; ++g) {
        if (kg == g) {
#pragma unroll
            for (int i = 0; i < 18; ++i) { float* rp = red + (rh * 18 + i) * 64 + col4 * 4;
#pragma unroll
                for (int j = 0; j < 4; ++j) rp[j] = (g == 0 ? 0.f : rp[j]) + acc[i][j]; }
        }
        __syncthreads();
    }
    for (int e = tid; e < 36 * 64; e += NTHR) { const int i = e >> 6, c = e & 63; mod[(size_t)i * NMODW + strip * 64 + c] = red[e] + ab[strip * 64 + c]; }
    __syncthreads();
}
__device__ __forceinline__ void phase0(PP p, unsigned char* smem) {
    float* lds = (float*)smem;
    const int bid = blockIdx.x, G = gridDim.x;
    constexpr int T_ALL = 32 * 88 + 88 * 16 + 32 * 46 + 32 * 16;
    if (G == 256) {
        if (bid < 192) adaln_strip(p, bid, lds);
        const ConvPtrs cp = conv_ptrs(p);
        if (bid < 192) convert_seq(cp, 0, 0, 832 + bid, 256, T_ALL - 256, 3968, 256, lds);
        else convert_seq(cp, 13, bid - 192, 832 + bid, 256, T_ALL - 256, 3968, 256, lds);
    } else {
        for (int s2 = bid; s2 < 192; s2 += G) adaln_strip(p, s2, lds);
        const ConvPtrs cp = conv_ptrs(p); convert_seq(cp, 0, 0, bid, G, T_ALL, T_ALL, 0, lds);
    }
}

__device__ __forceinline__ void norm_phase(PP p, const float* xa, const float* xb, const float* nw, int si, bool reduce_parts) {
    const float* mod = (const float*)(p->ws + WS_MOD); bf16_t* H = (bf16_t*)(p->ws + WS_H); float* outp = p->out; const float* parts = (const float*)(p->ws + WS_GDN);
    const int wave = threadIdx.x >> 6, lane = threadIdx.x & 63;
    const int stride = gridDim.x * 8;
    const int npi = (MP + stride - 1) / stride, nsi = (MS + (int)gridDim.x * 2 - 1) / ((int)gridDim.x * 2), nit = npi + nsi;
    auto row_of = [&](int k) -> int { if (k >= nit) return -1; if (k < npi) { const int r = blockIdx.x * 8 + wave + k * stride; return r < MP ? r : -1; }
        const int r = (k - npi) * (int)gridDim.x * 2 + blockIdx.x * 2 + (wave >> 2); return ((wave & 3) == 0 && r < MS) ? MP + r : -1; };
    f32x4 wv[8];
#pragma unroll
    for (int i = 0; i < 8; ++i) wv[i] = *(const f32x4*)(nw + i * 256 + lane * 4);
    f32x4 v[8], vn[8];
    { const int m0_ = row_of(0); if (m0_ >= 0) { const float* xr = m0_ < MP ? xa + (size_t)m0_ * D : xb + (size_t)(m0_ - MP) * D;
#pragma unroll
        for (int i = 0; i < 8; ++i) v[i] = *(const f32x4*)(xr + i * 256 + lane * 4); } }
    for (int k = 0; k < nit; ++k) {
        const int m = row_of(k), mn = row_of(k + 1);
        if (mn >= 0) { const float* xr = mn < MP ? xa + (size_t)mn * D : xb + (size_t)(mn - MP) * D;
#pragma unroll
            for (int i = 0; i < 8; ++i) vn[i] = *(const f32x4*)(xr + i * 256 + lane * 4); }
        if (m >= 0) {
        const float* mr = mod + (size_t)cond_of_row(m) * NMODW + si * D;
        f32x4 sh[8], scl[8];
#pragma unroll
        for (int i = 0; i < 8; ++i) { sh[i] = *(const f32x4*)(mr + i * 256 + lane * 4); scl[i] = *(const f32x4*)(mr + D + i * 256 + lane * 4); }
        if (reduce_parts && m >= MP) {
            const float* part = parts + (size_t)(m - MP) * D; const float* g1 = mod + (size_t)cond_of_row(m) * NMODW + 2 * D;
#pragma unroll
            for (int i = 0; i < 8; ++i) { f32x4 a = {0.f, 0.f, 0.f, 0.f};
#pragma unroll
                for (int sp = 0; sp < 8; ++sp) a += *(const f32x4*)(part + (size_t)sp * MS * D + i * 256 + lane * 4);
                v[i] += *(const f32x4*)(g1 + i * 256 + lane * 4) * a; *(f32x4*)(outp + (size_t)m * D + i * 256 + lane * 4) = v[i]; }
        }
        float ss = 0.f;
#pragma unroll
        for (int i = 0; i < 8; ++i) ss += v[i][0] * v[i][0] + v[i][1] * v[i][1] + v[i][2] * v[i][2] + v[i][3] * v[i][3];
#pragma unroll
        for (int o = 32; o >= 1; o >>= 1) ss += __shfl_xor(ss, o);
        const float rstd = rsqrtf(ss * (1.0f / D) + EPS);
#pragma unroll
        for (int i = 0; i < 8; ++i) { const int c = i * 256 + lane * 4;
            const f32x4 h = (v[i] * rstd * wv[i]) * (scl[i] + 1.0f) + sh[i]; u32x2 o; o.x = cvt_pk_bf16(h[0], h[1]); o.y = cvt_pk_bf16(h[2], h[3]); *(u32x2*)(H + (size_t)m * D + c) = o; }
        }
#pragma unroll
        for (int i = 0; i < 8; ++i) v[i] = vn[i];
    }
}

__device__ __forceinline__ void team_bar(unsigned* cnt, unsigned& target) {
    target += 4u;
    __builtin_amdgcn_fence(__ATOMIC_RELEASE, "workgroup");
    if ((threadIdx.x & 63) == 0) (void)__hip_atomic_fetch_add(cnt, 1u, __ATOMIC_RELAXED, __HIP_MEMORY_SCOPE_WORKGROUP);
    while (__hip_atomic_load(cnt, __ATOMIC_RELAXED, __HIP_MEMORY_SCOPE_WORKGROUP) < target) __builtin_amdgcn_s_sleep(1);
    __builtin_amdgcn_fence(__ATOMIC_ACQUIRE, "workgroup");
}
constexpr int TEAM_LDS = 81920;
__device__ __forceinline__ void gdn_prep(PP p, int item, unsigned char* tl  , unsigned* cnt, unsigned& bt) {
    const int b = item >> 9, h = (item >> 6) & 7, n = item & 63;
    int lt_ = threadIdx.x & 255; asm volatile("" : "+v"(lt_));
    const int lt = lt_, lane = lt & 63, lw = __builtin_amdgcn_readfirstlane(lt >> 6);
    const bf16_t* PROJ = (const bf16_t*)(p->ws + WS_PROJ); const float* AB = (const float*)(p->ws + WS_AB);
    unsigned char* rec = p->ws + WS_GDN + (size_t)item * CH_BYTES;
    const int m0 = b * LP + n * 64;
    bf16_t* QH = (bf16_t*)tl;
    bf16_t* KH = QH + 64 * 136;
    float* GC = (float*)(tl + 34816);
    float* BETA = GC + 64; float* EG = GC + 128; float* BEG = GC + 192;
    bf16_t* QKF = (bf16_t*)(tl + 36864);
    bf16_t* VH = (bf16_t*)(tl + 45056);
    float* AM = (float*)(tl + 62464);
    bf16_t* XS = (bf16_t*)(tl + 45056);
    team_bar(cnt, bt);
    if (lw == 0) {
        const float a = AB[(size_t)(m0 + lane) * 16 + h], bb = AB[(size_t)(m0 + lane) * 16 + 8 + h];
        float g = -__expf(p->in[15][h]) * softplus_f(a + p->in[16][h]);
        float gc = g;
#pragma unroll
        for (int o = 1; o < 64; o <<= 1) { const float t = __shfl_up(gc, o); if (lane >= o) gc += t; }
        const float be = sigmoid_f(bb), eg = __expf(gc);
        GC[lane] = gc; BETA[lane] = be; EG[lane] = eg; BEG[lane] = be * eg;
        if (lane == 63) *(float*)(rec + CH_GL) = eg;
    }
    {
        const float* cw = p->in[14];
#pragma unroll 1
        for (int pass = 0; pass < 2; ++pass) {
            const int slot = pass * 256 + lt, r = slot >> 3, cg = slot & 7; const int t = n * 64 + r;
            u32x4 raw[3][4][2];
#pragma unroll
            for (int which = 0; which < 3; ++which)
#pragma unroll
                for (int i = 0; i < 4; ++i) { const int dr = (t - 3 + i >= 0) ? (r - 3 + i) : r; const bf16_t* src = PROJ + (size_t)(m0 + dr) * NPROJ + which * 1024 + h * 128 + cg * 16;
                    raw[which][i][0] = *(const u32x4*)src; raw[which][i][1] = *(const u32x4*)(src + 8); }
#pragma unroll
            for (int which = 0; which < 3; ++which) {
                const int col = which * 1024 + h * 128 + cg * 16;
                float y[16];
#pragma unroll
                for (int j = 0; j < 16; ++j) y[j] = 0.f;
#pragma unroll
                for (int i = 0; i < 4; ++i) {
                    const float keep = (t - 3 + i >= 0) ? 1.0f : 0.0f;
                    float x[16]; unpack8(raw[which][i][0], x); unpack8(raw[which][i][1], x + 8);
#pragma unroll
                    for (int q = 0; q < 4; ++q) { const f32x4 w = *(const f32x4*)(cw + i * 3072 + col + q * 4) * keep;
#pragma unroll
                        for (int j = 0; j < 4; ++j) y[q * 4 + j] += w[j] * x[q * 4 + j]; }
                }
                float ss = 0.f;
#pragma unroll
                for (int j = 0; j < 16; ++j) { y[j] = silu_f(y[j]); ss += y[j] * y[j]; }
                float rn = 1.0f;
                if (which < 2) { ss += __shfl_xor(ss, 1); ss += __shfl_xor(ss, 2); ss += __shfl_xor(ss, 4); rn = rsqrtf(ss + EPS) * (which == 0 ? 0.08838834764831845f : 1.0f); }
                u32x4 w0, w1;
                w0.x = cvt_pk_bf16(y[0] * rn, y[1] * rn); w0.y = cvt_pk_bf16(y[2] * rn, y[3] * rn); w0.z = cvt_pk_bf16(y[4] * rn, y[5] * rn); w0.w = cvt_pk_bf16(y[6] * rn, y[7] * rn);
                w1.x = cvt_pk_bf16(y[8] * rn, y[9] * rn); w1.y = cvt_pk_bf16(y[10] * rn, y[11] * rn); w1.z = cvt_pk_bf16(y[12] * rn, y[13] * rn); w1.w = cvt_pk_bf16(y[14] * rn, y[15] * rn);
                bf16_t* dst = (which == 0 ? QH : which == 1 ? KH : VH) + r * 136 + cg * 16;
                *(u32x4*)dst = w0; *(u32x4*)(dst + 8) = w1;
            }
            if (n == 63 && r >= 61) {
                float* pc = p->out + O_PCONV + (size_t)(b * 3 + (r - 61)) * 3072;
#pragma unroll
                for (int which = 0; which < 3; ++which) { const int col = which * 1024 + h * 128 + cg * 16; float x[16]; unpack8(raw[which][3][0], x); unpack8(raw[which][3][1], x + 8);
#pragma unroll
                    for (int j = 0; j < 16; ++j) pc[col + j] = x[j]; }
            }
        }
    }
    team_bar(cnt, bt);
    {
        const int fr = lane & 15, kq = lane >> 4;
#pragma unroll
        for (int rep = 0; rep < 4; ++rep) {
            const int tt = lw + rep * 4, ti = tt >> 2, tj = tt & 3;
            f32x4 ck = {0.f, 0.f, 0.f, 0.f}, cq = {0.f, 0.f, 0.f, 0.f};
            if (tj <= ti) {
#pragma unroll
                for (int kk = 0; kk < 4; ++kk) {
                    const bf16x8 ak = *(const bf16x8*)(KH + (16 * ti + fr) * 136 + kk * 32 + kq * 8);
                    const bf16x8 aq = *(const bf16x8*)(QH + (16 * ti + fr) * 136 + kk * 32 + kq * 8);
                    const bf16x8 bk = *(const bf16x8*)(KH + (16 * tj + fr) * 136 + kk * 32 + kq * 8);
                    ck = __builtin_amdgcn_mfma_f32_16x16x32_bf16(ak, bk, ck, 0, 0, 0);
                    cq = __builtin_amdgcn_mfma_f32_16x16x32_bf16(aq, bk, cq, 0, 0, 0);
                }
            }
            const int j = 16 * tj + fr; const float gj = GC[j];
            const int cc = 16 * (tj & 1) + fr; const int kqp = (cc & 15) >> 2, jp = (cc & 3) + (cc >= 16 ? 4 : 0), kc = tj >> 1;
#pragma unroll
            for (int r = 0; r < 4; ++r) {
                const int i = 16 * ti + 4 * kq + r; const float dec = __expf(GC[i] - gj);
                AM[i * 68 + j] = (i > j) ? BETA[i] * dec * ck[r] : 0.f;
                const float qv = (i >= j) ? dec * cq[r] : 0.f;
                const int L = (4 * kq + r) + 16 * kqp;
                QKF[((ti * 2 + kc) * 64 + L) * 8 + jp] = (bf16_t)(cvt_pk_bf16(qv, 0.f) & 0xffffu);
            }
        }
    }
    team_bar(cnt, bt);
    float x[64];
    {
        const int c = lt;
        int zv; asm volatile("v_mov_b32 %0, 0" : "=v"(zv));
        const float* AMv = AM + zv; const float* SCL = (c < 128 ? BETA : BEG) + zv; const bf16_t* R = (c < 128 ? VH : KH) + (c & 127);
        f32x4 amc[16], amn[8];
        float rc = bf2f(R[0]) * SCL[0], rn = 0.f;
#pragma unroll
        for (int i = 0; i < 64; ++i) {
            __builtin_amdgcn_sched_barrier(0);
#pragma unroll
            for (int jj = 8; jj < (i + 3) / 4; ++jj) amc[jj] = *(const f32x4*)(AMv + i * 68 + jj * 4);
            if (i + 1 < 64) { rn = bf2f(R[(i + 1) * 136]) * SCL[i + 1];
#pragma unroll
                for (int jj = 0; jj < ((i + 4) / 4 < 8 ? (i + 4) / 4 : 8); ++jj) amn[jj] = *(const f32x4*)(AMv + (i + 1) * 68 + jj * 4); }
            float a = rc;
#pragma unroll
            for (int jj = 0; jj < (i + 3) / 4; ++jj) {
#pragma unroll
                for (int q = 0; q < 4; ++q) if (jj * 4 + q < i) asm("v_fma_f32 %0, -%1, %2, %0" : "+v"(a) : "v"(amc[jj][q]), "v"(x[jj * 4 + q])); }
            x[i] = a;
            rc = rn;
#pragma unroll
            for (int jj = 0; jj < 8; ++jj) amc[jj] = amn[jj];
        }
    }
    team_bar(cnt, bt);
#pragma unroll
    for (int i = 0; i < 64; ++i) XS[i * 264 + lt] = (bf16_t)(cvt_pk_bf16(x[i], 0.f) & 0xffffu);
    team_bar(cnt, bt);
    {
        const int L = lane, mrow = L & 15, kqp = L >> 4;
        const float g63 = GC[63];
#pragma unroll
        for (int rnd = 0; rnd < 4; ++rnd) { const int f = rnd * 4 + lw, mt = f >> 2, kk = f & 3; const int c = 16 * mt + mrow;
            const u32x2 lo = *(const u32x2*)(XS + c * 264 + 128 + 32 * kk + 4 * kqp), hi = *(const u32x2*)(XS + c * 264 + 128 + 32 * kk + 16 + 4 * kqp);
            u32x4 w; w.x = lo.x; w.y = lo.y; w.z = hi.x; w.w = hi.y;
            *(u32x4*)(rec + CH_W + (size_t)f * 1024 + L * 16) = w; }
#pragma unroll
        for (int rnd = 0; rnd < 2; ++rnd) { const int slot = rnd * 256 + lt, dv = slot >> 2, cs = slot & 3; unsigned pk[8];
#pragma unroll
            for (int q = 0; q < 8; ++q) { const unsigned lo = XS[(16 * cs + 2 * q) * 264 + dv], hi = XS[(16 * cs + 2 * q + 1) * 264 + dv]; pk[q] = lo | (hi << 16); }
            u32x4 w0, w1; w0.x = pk[0]; w0.y = pk[1]; w0.z = pk[2]; w0.w = pk[3]; w1.x = pk[4]; w1.y = pk[5]; w1.z = pk[6]; w1.w = pk[7];
            bf16_t* ut = (bf16_t*)(rec + CH_UT) + dv * 64 + cs * 16; *(u32x4*)ut = w0; *(u32x4*)(ut + 8) = w1; }
#pragma unroll
        for (int rnd = 0; rnd < 4; ++rnd) {
            const int f = rnd * 4 + lw, mt = f >> 2, kk = f & 3; const int c = 16 * mt + mrow; const float e = EG[c];
            const u32x2 lo = *(const u32x2*)(QH + c * 136 + 32 * kk + 4 * kqp), hi = *(const u32x2*)(QH + c * 136 + 32 * kk + 16 + 4 * kqp);
            u32x4 w; w.x = cvt_pk_bf16(bf_lo(lo.x) * e, bf_hi(lo.x) * e); w.y = cvt_pk_bf16(bf_lo(lo.y) * e, bf_hi(lo.y) * e); w.z = cvt_pk_bf16(bf_lo(hi.x) * e, bf_hi(hi.x) * e); w.w = cvt_pk_bf16(bf_lo(hi.y) * e, bf_hi(hi.y) * e);
            *(u32x4*)(rec + CH_QG + (size_t)f * 1024 + L * 16) = w;
        }
#pragma unroll
        for (int rnd = 0; rnd < 4; ++rnd) {
            const int f = rnd * 4 + lw, d = f >> 1, kc = f & 1; const int dk = 16 * d + mrow;
            float v[8];
#pragma unroll
            for (int j = 0; j < 8; ++j) { const int c = 32 * kc + (j < 4 ? 4 * kqp + j : 16 + 4 * kqp + (j - 4)); v[j] = bf2f(KH[c * 136 + dk]) * __expf(g63 - GC[c]); }
            u32x4 w; w.x = cvt_pk_bf16(v[0], v[1]); w.y = cvt_pk_bf16(v[2], v[3]); w.z = cvt_pk_bf16(v[4], v[5]); w.w = cvt_pk_bf16(v[6], v[7]);
            *(u32x4*)(rec + CH_KD + (size_t)f * 1024 + L * 16) = w;
        }
#pragma unroll
        for (int rnd = 0; rnd < 2; ++rnd) { const int e = rnd * 256 + lt; *(u32x4*)(rec + CH_QK + (size_t)e * 16) = *(const u32x4*)((const unsigned char*)QKF + e * 16); }
    }
}

__device__ __forceinline__ void gdn_sample(PP p, int item, unsigned char* smem) {
    const int b = item >> 3, h = item & 7;
    const int tid = threadIdx.x;
    const bf16_t* PROJ = (const bf16_t*)(p->ws + WS_PROJ); const float* AB = (const float*)(p->ws + WS_AB);
    bf16_t* OM = (bf16_t*)(p->ws + WS_H);
    const int m0 = MP + b * 16;
    float* Q = (float*)smem; float* K = Q + 16 * 128; float* V = K + 16 * 128; float* O = V + 16 * 128;
    float* RED = O + 16 * 128;
    float* RED2 = RED + 4 * 128;
    float* GG = RED2 + 4 * 128;
    __syncthreads();
    if (tid < 16) { const float a = AB[(size_t)(m0 + tid) * 16 + h], bb = AB[(size_t)(m0 + tid) * 16 + 8 + h];
        GG[tid] = __expf(-__expf(p->in[15][h]) * softplus_f(a + p->in[16][h])); GG[16 + tid] = sigmoid_f(bb); }
    {
        const int r = tid >> 5, cg = tid & 31; const float* cw = p->in[14]; const float* st = p->in[2] + (size_t)b * 3 * 3072;
#pragma unroll
        for (int which = 0; which < 3; ++which) {
            const int col = which * 1024 + h * 128 + cg * 4; float y[4] = {0.f, 0.f, 0.f, 0.f};
#pragma unroll
            for (int i = 0; i < 4; ++i) { const int t = r - 3 + i; float x[4];
                const u32x2 vp = *(const u32x2*)(PROJ + (size_t)(m0 + (t >= 0 ? t : 0)) * NPROJ + col); const f32x4 vs = *(const f32x4*)(st + (size_t)(t >= 0 ? 0 : 3 + t) * 3072 + col);
                x[0] = t >= 0 ? bf_lo(vp.x) : vs[0]; x[1] = t >= 0 ? bf_hi(vp.x) : vs[1]; x[2] = t >= 0 ? bf_lo(vp.y) : vs[2]; x[3] = t >= 0 ? bf_hi(vp.y) : vs[3];
                const f32x4 w = *(const f32x4*)(cw + i * 3072 + col);
#pragma unroll
                for (int j = 0; j < 4; ++j) y[j] += w[j] * x[j]; }
            float ss = 0.f;
#pragma unroll
            for (int j = 0; j < 4; ++j) { y[j] = silu_f(y[j]); ss += y[j] * y[j]; }
            float rn = 1.0f;
            if (which < 2) {
#pragma unroll
                for (int o = 1; o < 32; o <<= 1) ss += __shfl_xor(ss, o);
                rn = rsqrtf(ss + EPS) * (which == 0 ? 0.08838834764831845f : 1.0f); }
            float* dst = (which == 0 ? Q : which == 1 ? K : V) + r * 128 + cg * 4;
#pragma unroll
            for (int j = 0; j < 4; ++j) dst[j] = y[j] * rn;
            if (r >= 13) {
                const u32x2 v = *(const u32x2*)(PROJ + (size_t)(m0 + r) * NPROJ + col);
                *(f32x4*)(p->out + O_SCONV + (size_t)(b * 3 + r - 13) * 3072 + col) = (f32x4){bf_lo(v.x), bf_hi(v.x), bf_lo(v.y), bf_hi(v.y)}; }
        }
    }
    const int dv = tid & 127, kg = tid >> 7;
    float S[32];
    const float* s0 = p->in[3] + ((size_t)(b * 8 + h) * 128 + kg * 32) * 128 + dv;
#pragma unroll
    for (int i = 0; i < 32; ++i) S[i] = s0[(size_t)i * 128];
    __syncthreads();
    for (int t = 0; t < 16; ++t) {
        const float a = GG[t], be = GG[16 + t]; float part = 0.f;
#pragma unroll
        for (int i = 0; i < 32; ++i) { S[i] *= a; part += K[t * 128 + kg * 32 + i] * S[i]; }
        RED[kg * 128 + dv] = part;
        __syncthreads();
        const float ks = RED[dv] + RED[128 + dv] + RED[256 + dv] + RED[384 + dv];
        const float rr = be * (V[t * 128 + dv] - ks); float po = 0.f;
#pragma unroll
        for (int i = 0; i < 32; ++i) { S[i] += K[t * 128 + kg * 32 + i] * rr; po += Q[t * 128 + kg * 32 + i] * S[i]; }
        RED2[kg * 128 + dv] = po;
        __syncthreads();
        if (kg == 0) O[t * 128 + dv] = RED2[dv] + RED2[128 + dv] + RED2[256 + dv] + RED2[384 + dv];
    }
    float* sd = p->out + O_SDELTA + ((size_t)(b * 8 + h) * 128 + kg * 32) * 128 + dv;
#pragma unroll
    for (int i = 0; i < 32; ++i) sd[(size_t)i * 128] = S[i];
    __syncthreads();
    {
        const int r = tid >> 5, cg = tid & 31; const f32x4 o = *(const f32x4*)(O + r * 128 + cg * 4);
        float ss = o[0] * o[0] + o[1] * o[1] + o[2] * o[2] + o[3] * o[3];
#pragma unroll
        for (int of = 1; of < 32; of <<= 1) ss += __shfl_xor(ss, of);
        const float rs = rsqrtf(ss * (1.0f / 128.f) + EPS); const f32x4 w = *(const f32x4*)(p->in[17] + cg * 4);
        const u32x2 zz = *(const u32x2*)(PROJ + (size_t)(m0 + r) * NPROJ + 3072 + h * 128 + cg * 4);
        const float z[4] = {bf_lo(zz.x), bf_hi(zz.x), bf_lo(zz.y), bf_hi(zz.y)};
        u32x2 ow; ow.x = cvt_pk_bf16(o[0] * rs * w[0] * silu_f(z[0]), o[1] * rs * w[1] * silu_f(z[1])); ow.y = cvt_pk_bf16(o[2] * rs * w[2] * silu_f(z[2]), o[3] * rs * w[3] * silu_f(z[3]));
        *(u32x2*)(OM + (size_t)(m0 + r) * D + h * 128 + cg * 4) = ow;
    }
}

template <int NT  , bool SAMPLE>
__device__ __forceinline__ void swa_item(PP p, int b, int n, int hk, unsigned char* smem) {
    constexpr int SPAN = SAMPLE ? 144 : 192, NQ = SAMPLE ? 16 : 64, VP = NT * 16 + 8;
    const int tid = threadIdx.x, lane = tid & 63, wave = tid >> 6, fr = lane & 15, kq = lane >> 4;
    const bf16_t* PROJ = (const bf16_t*)(p->ws + WS_PROJ); bf16_t* OM = (bf16_t*)(p->ws + WS_H);
    bf16_t* KS = (bf16_t*)smem;
    bf16_t* VT = KS + NT * 16 * 136;
    const int mq0 = SAMPLE ? MP + b * 16 : b * LP + n * 64;
    const float* knw = p->in[19];
    __syncthreads();
    u32x4 kraw[3][2], vraw[3][2];
    if (!SAMPLE) {
#pragma unroll
        for (int pass = 0; pass < 3; ++pass) {
            { const int t = n * 64 - 128 + pass * 64 + (tid >> 3); const bf16_t* src = PROJ + (size_t)(b * LP + (t > 0 ? t : 0)) * NPROJ + 5120 + hk * 128 + (tid & 7) * 16; kraw[pass][0] = *(const u32x4*)src; kraw[pass][1] = *(const u32x4*)(src + 8); }
            { const int t = n * 64 - 128 + pass * 64 + lane; const bf16_t* src = PROJ + (size_t)(b * LP + (t > 0 ? t : 0)) * NPROJ + 5376 + hk * 128 + wave * 16; vraw[pass][0] = *(const u32x4*)src; vraw[pass][1] = *(const u32x4*)(src + 8); }
        }
    }
#pragma unroll
    for (int pass = 0; pass < (NT * 16) / 64 + ((NT * 16) % 64 ? 1 : 0); ++pass) {
        const int key = pass * 64 + (tid >> 3), cg = tid & 7;
        if (key < NT * 16) {
            float x[16]; bool valid = key < SPAN; bool fresh = false; int srow = 0;
            if (SAMPLE) { if (key >= 128) { fresh = true; srow = mq0 + key - 128; } }
            else { const int t = n * 64 - 128 + key; valid = valid && t >= 0; fresh = true; srow = b * LP + t; }
            if (!valid) {
#pragma unroll
                for (int j = 0; j < 16; ++j) x[j] = 0.f;
            } else if (fresh) {
                if (SAMPLE) { const bf16_t* src = PROJ + (size_t)srow * NPROJ + 5120 + hk * 128 + cg * 16; unpack8(*(const u32x4*)src, x); unpack8(*(const u32x4*)(src + 8), x + 8); }
                else { unpack8(kraw[pass][0], x); unpack8(kraw[pass][1], x + 8); }
                float ss = 0.f;
#pragma unroll
                for (int j = 0; j < 16; ++j) ss += x[j] * x[j];
                ss += __shfl_xor(ss, 1); ss += __shfl_xor(ss, 2); ss += __shfl_xor(ss, 4);
                const float rs = rsqrtf(ss * (1.0f / 128.f) + EPS);
#pragma unroll
                for (int j = 0; j < 16; ++j) x[j] = x[j] * rs * knw[cg * 16 + j];
            } else {
                const float* src = p->in[4] + ((size_t)(b * 128 + key) * 2 + hk) * 128 + cg * 16;
#pragma unroll
                for (int q = 0; q < 4; ++q) { const f32x4 v = *(const f32x4*)(src + q * 4); x[q * 4] = v[0]; x[q * 4 + 1] = v[1]; x[q * 4 + 2] = v[2]; x[q * 4 + 3] = v[3]; }
            }
            u32x4 w0, w1;
            w0.x = cvt_pk_bf16(x[0], x[1]); w0.y = cvt_pk_bf16(x[2], x[3]); w0.z = cvt_pk_bf16(x[4], x[5]); w0.w = cvt_pk_bf16(x[6], x[7]);
            w1.x = cvt_pk_bf16(x[8], x[9]); w1.y = cvt_pk_bf16(x[10], x[11]); w1.z = cvt_pk_bf16(x[12], x[13]); w1.w = cvt_pk_bf16(x[14], x[15]);
            *(u32x4*)(KS + key * 136 + cg * 16) = w0; *(u32x4*)(KS + key * 136 + cg * 16 + 8) = w1;
            float* dst = nullptr;
            if (SAMPLE) { if (key >= 16 && key < 144) dst = p->out + O_SK + ((size_t)(b * 128 + key - 16) * 2 + hk) * 128 + cg * 16; }
            else { if (n >= 62 && key >= 128) dst = p->out + O_PK + ((size_t)(b * 128 + (n - 62) * 64 + key - 128) * 2 + hk) * 128 + cg * 16; }
            if (dst) {
#pragma unroll
                for (int q = 0; q < 4; ++q) *(f32x4*)(dst + q * 4) = (f32x4){x[q * 4], x[q * 4 + 1], x[q * 4 + 2], x[q * 4 + 3]}; }
        }
    }
#pragma unroll
    for (int pass = 0; pass < (NT * 16) / 64 + ((NT * 16) % 64 ? 1 : 0); ++pass) {
        const int key = pass * 64 + lane, cg = wave;
        if (key < NT * 16) {
            float x[16]; bool valid = key < SPAN; bool fresh = false; int srow = 0;
            if (SAMPLE) { if (key >= 128) { fresh = true; srow = mq0 + key - 128; } }
            else { const int t = n * 64 - 128 + key; valid = valid && t >= 0; fresh = true; srow = b * LP + t; }
            if (!valid) {
#pragma unroll
                for (int j = 0; j < 16; ++j) x[j] = 0.f;
            } else if (fresh) { if (SAMPLE) { const bf16_t* src = PROJ + (size_t)srow * NPROJ + 5376 + hk * 128 + cg * 16; unpack8(*(const u32x4*)src, x); unpack8(*(const u32x4*)(src + 8), x + 8); } else { unpack8(vraw[pass][0], x); unpack8(vraw[pass][1], x + 8); } }
            else { const float* src = p->in[5] + ((size_t)(b * 128 + key) * 2 + hk) * 128 + cg * 16;
#pragma unroll
                for (int q = 0; q < 4; ++q) { const f32x4 v = *(const f32x4*)(src + q * 4); x[q * 4] = v[0]; x[q * 4 + 1] = v[1]; x[q * 4 + 2] = v[2]; x[q * 4 + 3] = v[3]; } }
#pragma unroll
            for (int j = 0; j < 16; ++j) VT[(cg * 16 + j) * VP + key] = (bf16_t)(cvt_pk_bf16(x[j], 0.f) & 0xffffu);
            float* dst = nullptr;
            if (SAMPLE) { if (key >= 16 && key < 144) dst = p->out + O_SV + ((size_t)(b * 128 + key - 16) * 2 + hk) * 128 + cg * 16; }
            else { if (n >= 62 && key >= 128) dst = p->out + O_PV + ((size_t)(b * 128 + (n - 62) * 64 + key - 128) * 2 + hk) * 128 + cg * 16; }
            if (dst) {
#pragma unroll
                for (int q = 0; q < 4; ++q) *(f32x4*)(dst + q * 4) = (f32x4){x[q * 4], x[q * 4 + 1], x[q * 4 + 2], x[q * 4 + 3]}; }
        }
    }
    __syncthreads();
    if (wave * 32 < NQ * 4) {
        const float* qnw = p->in[18];
        int hq[2], mrow[2], iq[2]; float slope[2], sink[2];
        bf16x8 QF[2][4];
#pragma unroll
        for (int nt2 = 0; nt2 < 2; ++nt2) {
            const int rho = wave * 32 + nt2 * 16 + fr; const int g = rho / NQ; iq[nt2] = rho % NQ; hq[nt2] = hk * 4 + g; mrow[nt2] = mq0 + iq[nt2];
            slope[nt2] = exp2f(-(float)(hq[nt2] + 1)); sink[nt2] = p->in[20][hq[nt2]];
        }
        { u32x4 qr[2][4];
#pragma unroll
          for (int nt2 = 0; nt2 < 2; ++nt2)
#pragma unroll
              for (int kk = 0; kk < 4; ++kk) qr[nt2][kk] = *(const u32x4*)(PROJ + (size_t)mrow[nt2] * NPROJ + 4096 + hq[nt2] * 128 + kk * 32 + kq * 8);
#pragma unroll
          for (int nt2 = 0; nt2 < 2; ++nt2) { float qx[4][8]; float ss = 0.f;
#pragma unroll
              for (int kk = 0; kk < 4; ++kk) { unpack8(qr[nt2][kk], qx[kk]);
#pragma unroll
                  for (int j = 0; j < 8; ++j) ss += qx[kk][j] * qx[kk][j]; }
              ss += __shfl_xor(ss, 16); ss += __shfl_xor(ss, 32);
              const float sc = rsqrtf(ss * (1.0f / 128.f) + EPS) * 0.08838834764831845f;
#pragma unroll
              for (int kk = 0; kk < 4; ++kk) { float w[8];
#pragma unroll
                  for (int j = 0; j < 8; ++j) w[j] = qx[kk][j] * sc * qnw[kk * 32 + kq * 8 + j];
                  u32x4 pk; pk.x = cvt_pk_bf16(w[0], w[1]); pk.y = cvt_pk_bf16(w[2], w[3]); pk.z = cvt_pk_bf16(w[4], w[5]); pk.w = cvt_pk_bf16(w[6], w[7]); QF[nt2][kk] = as_bf16x8(pk); } } }
        bf16x8 PB[2][NT / 2];
#pragma unroll
        for (int nt2 = 0; nt2 < 2; ++nt2) {
            f32x4 st[NT]; float mx = sink[nt2];
#pragma unroll
            for (int mt = 0; mt < NT; mt += 2) {
                __builtin_amdgcn_sched_barrier(0);
                f32x4 a0 = {0.f, 0.f, 0.f, 0.f}, a1 = {0.f, 0.f, 0.f, 0.f};
#pragma unroll
                for (int kk = 0; kk < 4; ++kk) { const bf16x8 k0 = *(const bf16x8*)(KS + (16 * mt + fr) * 136 + kk * 32 + kq * 8), k1 = *(const bf16x8*)(KS + (16 * mt + 16 + fr) * 136 + kk * 32 + kq * 8);
                    a0 = __builtin_amdgcn_mfma_f32_16x16x32_bf16(k0, QF[nt2][kk], a0, 0, 0, 0); a1 = __builtin_amdgcn_mfma_f32_16x16x32_bf16(k1, QF[nt2][kk], a1, 0, 0, 0); }
                int ib = iq[nt2] + 128 - 4 * kq; asm volatile("" : "+v"(ib));
#pragma unroll
                for (int r = 0; r < 4; ++r) { const int key = 16 * mt + 4 * kq + r; bool v0 = key < SPAN, v1 = key + 16 < SPAN; if (!SAMPLE) { v0 = v0 && (n * 64 - 128 + key >= 0); v1 = v1 && (n * 64 - 112 + key >= 0); }
                    const float s0 = v0 ? a0[r] - slope[nt2] * fabsf((float)(ib - (16 * mt + r))) : -INFINITY, s1 = v1 ? a1[r] - slope[nt2] * fabsf((float)(ib - (16 * mt + 16 + r))) : -INFINITY;
                    a0[r] = s0; a1[r] = s1; mx = fmaxf(mx, fmaxf(s0, s1)); }
                st[mt] = a0; st[mt + 1] = a1;
            }
            __builtin_amdgcn_sched_barrier(0);
            mx = fmaxf(mx, __shfl_xor(mx, 16)); mx = fmaxf(mx, __shfl_xor(mx, 32));
            float sum = 0.f;
#pragma unroll
            for (int mt = 0; mt < NT; ++mt)
#pragma unroll
                for (int r = 0; r < 4; ++r) { const float e = __expf(st[mt][r] - mx); st[mt][r] = e; sum += e; }
            sum += __shfl_xor(sum, 16); sum += __shfl_xor(sum, 32);
            const float inv = __builtin_amdgcn_rcpf(sum + __expf(sink[nt2] - mx));
#pragma unroll
            for (int kc = 0; kc < NT / 2; ++kc) { u32x4 pk; pk.x = cvt_pk_bf16(st[2 * kc][0] * inv, st[2 * kc][1] * inv); pk.y = cvt_pk_bf16(st[2 * kc][2] * inv, st[2 * kc][3] * inv);
                pk.z = cvt_pk_bf16(st[2 * kc + 1][0] * inv, st[2 * kc + 1][1] * inv); pk.w = cvt_pk_bf16(st[2 * kc + 1][2] * inv, st[2 * kc + 1][3] * inv); PB[nt2][kc] = as_bf16x8(pk); }
        }
#pragma unroll
        for (int dt = 0; dt < 8; ++dt) {
            __builtin_amdgcn_sched_barrier(0);
            f32x4 o0 = {0.f, 0.f, 0.f, 0.f}, o1 = {0.f, 0.f, 0.f, 0.f};
#pragma unroll
            for (int kc = 0; kc < NT / 2; ++kc) { const u32x2 lo = *(const u32x2*)(VT + (16 * dt + fr) * VP + 32 * kc + 4 * kq), hi = *(const u32x2*)(VT + (16 * dt + fr) * VP + 32 * kc + 16 + 4 * kq);
                u32x4 va; va.x = lo.x; va.y = lo.y; va.z = hi.x; va.w = hi.y;
                o0 = __builtin_amdgcn_mfma_f32_16x16x32_bf16(as_bf16x8(va), PB[0][kc], o0, 0, 0, 0); o1 = __builtin_amdgcn_mfma_f32_16x16x32_bf16(as_bf16x8(va), PB[1][kc], o1, 0, 0, 0); }
            u32x2 ow; ow.x = cvt_pk_bf16(o0[0], o0[1]); ow.y = cvt_pk_bf16(o0[2], o0[3]);
            *(u32x2*)(OM + (size_t)mrow[0] * D + 1024 + hq[0] * 128 + 16 * dt + 4 * kq) = ow;
            ow.x = cvt_pk_bf16(o1[0], o1[1]); ow.y = cvt_pk_bf16(o1[2], o1[3]);
            *(u32x2*)(OM + (size_t)mrow[1] * D + 1024 + hq[1] * 128 + 16 * dt + 4 * kq) = ow;
        }
    }
}

__device__ __forceinline__ void phase3(PP p, unsigned char* smem) {
#ifndef P3_MASK
#define P3_MASK 15
#endif
    const int bid = blockIdx.x, G = gridDim.x;
#ifndef P3_REP
#define P3_REP 0
#endif
    if (P3_MASK & 1) {
        unsigned* cnt = (unsigned*)(smem + 36352) ;
        if (threadIdx.x < 2) cnt[threadIdx.x] = 0u;
        __syncthreads();
        const int team = threadIdx.x >> 8; unsigned bt = 0u;
        for (int r_ = 0; r_ < 1 + (P3_REP & 1); ++r_) for (int it = bid + G * team; it < 2048; it += 2 * G) gdn_prep(p, it, smem + team * TEAM_LDS, cnt + team, bt);
        __syncthreads();
    }
    if (P3_MASK & 2) for (int r_ = 0; r_ < 1 + ((P3_REP >> 1) & 1); ++r_) for (int v = bid; v < 512; v += G) { const int u = (G == 256) ? (v & 7) * 64 + ((v >> 3) & 31) + 32 * (v >> 8) : v;
        swa_item<12, false>(p, u >> 7, (u >> 1) & 63, u & 1, smem); }
    if ((P3_MASK & 4) && G != 256) for (int u = bid; u < 256; u += G) gdn_sample(p, u, smem);
    if ((P3_MASK & 8) && G != 256) for (int u = G - 1 - bid; u < 64; u += G) swa_item<10, true>(p, u >> 1, 0, u & 1, smem);
}

__device__ __forceinline__ void scan_chunk(f32x4 (&S)[8], const unsigned char* cur, float gl, bf16_t* op0, int lane, int fr, int kq, int wave) {
#define FRAG(off, f) (*(const bf16x8*)(cur + (off) + (f) * 1024 + lane * 16))
    bf16x8 sB[4];
#pragma unroll
    for (int kk = 0; kk < 4; ++kk) { u32x4 pk; pk.x = cvt_pk_bf16(S[2 * kk][0], S[2 * kk][1]); pk.y = cvt_pk_bf16(S[2 * kk][2], S[2 * kk][3]); pk.z = cvt_pk_bf16(S[2 * kk + 1][0], S[2 * kk + 1][1]); pk.w = cvt_pk_bf16(S[2 * kk + 1][2], S[2 * kk + 1][3]); sB[kk] = as_bf16x8(pk); }
    bf16x8 Wf[16]; u32x2 uu[4];
#pragma unroll
    for (int f = 0; f < 16; ++f) Wf[f] = FRAG(CH_W, f);
#pragma unroll
    for (int mt = 0; mt < 4; ++mt) uu[mt] = *(const u32x2*)(cur + 57344 + (wave * 16 + fr) * 128 + (16 * mt + 4 * kq) * 2);
    __builtin_amdgcn_sched_barrier(0);
    f32x4 P[4], O[4];
#pragma unroll
    for (int mt = 0; mt < 4; ++mt) { P[mt] = (f32x4){0.f, 0.f, 0.f, 0.f}; O[mt] = (f32x4){0.f, 0.f, 0.f, 0.f}; }
    bf16x8 Gf[16];
#pragma unroll
    for (int kk = 0; kk < 4; ++kk) {
#pragma unroll
        for (int mt = 0; mt < 4; ++mt) { P[mt] = __builtin_amdgcn_mfma_f32_16x16x32_bf16(Wf[mt * 4 + kk], sB[kk], P[mt], 0, 0, 0); Gf[kk * 4 + mt] = FRAG(CH_QG, mt * 4 + kk); }
    }
    __builtin_amdgcn_sched_barrier(0);
    bf16x8 Kf[8], Df[16];
#pragma unroll
    for (int kk = 0; kk < 4; ++kk) {
#pragma unroll
        for (int mt = 0; mt < 4; ++mt) { O[mt] = __builtin_amdgcn_mfma_f32_16x16x32_bf16(Gf[kk * 4 + mt], sB[kk], O[mt], 0, 0, 0); if (kk < 2) Kf[kk * 4 + mt] = FRAG(CH_QK, mt * 2 + kk); else Df[(kk - 2) * 4 + mt] = FRAG(CH_KD, (kk - 2) * 4 + mt); }
    }
    f32x4 vn[4];
#pragma unroll
    for (int mt = 0; mt < 4; ++mt) vn[mt] = (f32x4){bf_lo(uu[mt].x) - P[mt][0], bf_hi(uu[mt].x) - P[mt][1], bf_lo(uu[mt].y) - P[mt][2], bf_hi(uu[mt].y) - P[mt][3]};
    bf16x8 vB[2];
#pragma unroll
    for (int kc = 0; kc < 2; ++kc) { u32x4 pk; pk.x = cvt_pk_bf16(vn[2 * kc][0], vn[2 * kc][1]); pk.y = cvt_pk_bf16(vn[2 * kc][2], vn[2 * kc][3]); pk.z = cvt_pk_bf16(vn[2 * kc + 1][0], vn[2 * kc + 1][1]); pk.w = cvt_pk_bf16(vn[2 * kc + 1][2], vn[2 * kc + 1][3]); vB[kc] = as_bf16x8(pk); }
    __builtin_amdgcn_sched_barrier(0);
#pragma unroll
    for (int kc = 0; kc < 2; ++kc) {
#pragma unroll
        for (int mt = 0; mt < 4; ++mt) { O[mt] = __builtin_amdgcn_mfma_f32_16x16x32_bf16(Kf[kc * 4 + mt], vB[kc], O[mt], 0, 0, 0); Df[8 + kc * 4 + mt] = FRAG(CH_KD, 8 + kc * 4 + mt); }
    }
#pragma unroll
    for (int d = 0; d < 8; ++d) S[d] = S[d] * gl;
    __builtin_amdgcn_sched_barrier(0);
#pragma unroll
    for (int kc = 0; kc < 2; ++kc) {
#pragma unroll
        for (int d = 0; d < 8; ++d) S[d] = __builtin_amdgcn_mfma_f32_16x16x32_bf16(Df[d * 2 + kc], vB[kc], S[d], 0, 0, 0);
    }
#pragma unroll
    for (int mt = 0; mt < 4; ++mt) { bf16_t* op = op0 + (size_t)(16 * mt) * D;
#pragma unroll
        for (int r = 0; r < 4; ++r) op[(size_t)r * D] = (bf16_t)(cvt_pk_bf16(O[mt][r], 0.f) & 0xffffu); }
#undef FRAG
}
__device__ __forceinline__ void phase4(PP p, unsigned char* smem) {
    const int tid = threadIdx.x, lane = tid & 63, wave = tid >> 6, fr = lane & 15, kq = lane >> 4;
    bf16_t* OM = (bf16_t*)(p->ws + WS_H);
    constexpr int NCW = 2, NS = 8 / NCW, USL = 2048 * NCW, BUF = 57344 + USL;
    if (gridDim.x == 256 && blockIdx.x >= 128) { const ConvPtrs cp = conv_ptrs(p); gdn_sample(p, (int)blockIdx.x - 128, smem); gdn_sample(p, (int)blockIdx.x, smem);
        if (blockIdx.x < 192) { const int u = (int)blockIdx.x - 128; swa_item<10, true>(p, u >> 1, 0, u & 1, smem); }
        else { __syncthreads(); convert_seq(cp, 0, 0, (int)blockIdx.x - 192, 64, 256, 0, 3968, (float*)smem); }
        return; }
    for (int item = blockIdx.x; item < 32 * NS; item += gridDim.x) {
        const int xcd = item & 7, iw = item >> 3; const int bh = xcd * 4 + iw / NS, ds = iw % NS; const int b = bh >> 3, h = bh & 7, dvb = ds * 16 * NCW, dv0 = dvb + (wave < NCW ? wave : 0) * 16;
        const unsigned char* rec0 = p->ws + WS_GDN + (size_t)(bh * 64) * CH_BYTES;
        f32x4 S[8];
#pragma unroll
        for (int d = 0; d < 8; ++d) S[d] = (f32x4){0.f, 0.f, 0.f, 0.f};
        u32x4 sa[8], sb[8];
#define SC_LOAD(st, c) do { const unsigned char* r_ = rec0 + (size_t)(c) * CH_BYTES; _Pragma("unroll") for (int i = 0; i < 7; ++i) st[i] = *(const u32x4*)(r_ + (size_t)(i * 512 + tid) * 16); \
        if (tid < 128 * NCW) st[7] = *(const u32x4*)(r_ + CH_UT + (size_t)dvb * 128 + tid * 16); } while (0)
#define SC_STORE(st, buf) do { unsigned char* d_ = smem + (buf) * BUF; _Pragma("unroll") for (int i = 0; i < 7; ++i) *(u32x4*)(d_ + (size_t)(i * 512 + tid) * 16) = st[i]; \
        if (tid < 128 * NCW) *(u32x4*)(d_ + 57344 + tid * 16) = st[7]; } while (0)
        __syncthreads();
        const int glv = __builtin_bit_cast(int, *(const float*)(rec0 + (size_t)lane * CH_BYTES + CH_GL));
        SC_LOAD(sa, 0); SC_LOAD(sb, 1);
        SC_STORE(sa, 0);
        __syncthreads();
        bf16_t* opb = OM + (size_t)(b * LP + 4 * kq) * D + h * 128 + dv0 + fr;
        for (int n = 0; n < 64; n += 2) {
            if (n + 2 < 64) SC_LOAD(sa, n + 2);
            if (wave < NCW) scan_chunk(S, smem, __builtin_bit_cast(float, __builtin_amdgcn_readlane(glv, n)), opb + (size_t)(n * 64) * D, lane, fr, kq, wave);
            SC_STORE(sb, 1);
            __syncthreads();
            if (n + 3 < 64) SC_LOAD(sb, n + 3);
            if (wave < NCW) scan_chunk(S, smem + BUF, __builtin_bit_cast(float, __builtin_amdgcn_readlane(glv, n + 1)), opb + (size_t)((n + 1) * 64) * D, lane, fr, kq, wave);
            if (n + 2 < 64) SC_STORE(sa, 0);
            __syncthreads();
        }
#undef SC_LOAD
#undef SC_STORE
        if (wave < NCW) {
            float* pd = p->out + O_PDELTA + (size_t)bh * 128 * 128;
#pragma unroll
            for (int d = 0; d < 8; ++d)
#pragma unroll
                for (int r = 0; r < 4; ++r) pd[(size_t)(16 * d + 4 * kq + r) * 128 + dv0 + fr] = S[d][r];
        }
    }
}

__device__ __forceinline__ void phase5(PP p) {
    const bf16_t* PROJ = (const bf16_t*)(p->ws + WS_PROJ); bf16_t* OM = (bf16_t*)(p->ws + WS_H);
    const int tid = threadIdx.x, sub = tid & 15, grp = tid >> 4;
    const float* gw = p->in[17];
    for (int pr = blockIdx.x * 32 + grp; pr < MP * 8; pr += gridDim.x * 32) {
        const int m = pr >> 3, h = pr & 7;
        bf16_t* op = OM + (size_t)m * D + h * 128 + sub * 8;
        float o[8], z[8]; unpack8(*(const u32x4*)op, o); unpack8(*(const u32x4*)(PROJ + (size_t)m * NPROJ + 3072 + h * 128 + sub * 8), z);
        float ss = 0.f;
#pragma unroll
        for (int j = 0; j < 8; ++j) ss += o[j] * o[j];
        ss += __shfl_xor(ss, 1); ss += __shfl_xor(ss, 2); ss += __shfl_xor(ss, 4); ss += __shfl_xor(ss, 8);
        const float rs = rsqrtf(ss * (1.0f / 128.f) + EPS);
        float w[8];
#pragma unroll
        for (int j = 0; j < 8; ++j) w[j] = o[j] * rs * gw[sub * 8 + j] * silu_f(z[j]);
        u32x4 pk; pk.x = cvt_pk_bf16(w[0], w[1]); pk.y = cvt_pk_bf16(w[2], w[3]); pk.z = cvt_pk_bf16(w[4], w[5]); pk.w = cvt_pk_bf16(w[6], w[7]);
        *(u32x4*)op = pk;
    }
}

__device__ __forceinline__ void phase9(PP p) {
    const float* HEAD = (const float*)(p->ws + WS_HEAD); const float* HALO = (const float*)(p->ws + WS_HALO); const float* US = (const float*)(p->ws + WS_US);
    bf16_t* ACT = (bf16_t*)(p->ws + WS_PROJ); const float* cw = p->in[23]; const float* cb = p->in[24]; const float* st = p->in[6]; float* outp = p->out;
    const int gt = blockIdx.x * NTHR + threadIdx.x, gs = gridDim.x * NTHR;
    constexpr int FQ = FF / 4, FQ2 = FF2 / 4;
    const f32x4 z4 = {0.f, 0.f, 0.f, 0.f};
    for (int e = gt; e < 256 * 2 * FQ; e += gs) {
        const int c = (e % FQ) * 4, rr = (e / FQ) & 1, blk = e / (2 * FQ);
        const bool first = (blk & 63) == 0;
        f32x4 uc[2];
#pragma unroll
        for (int s = 0; s < 2; ++s) { const int cu = c + s * FF;
            const f32x4 u0 = *(const f32x4*)(HEAD + (size_t)(blk * 2 + rr) * FF2 + cu);
            const float* h1 = first ? HEAD : HALO + (size_t)((blk - 1) * 2 + 1) * FF2; const float* h0 = first ? HEAD : HALO + (size_t)((blk - 1) * 2) * FF2;
            const f32x4 a1 = *(const f32x4*)(h1 + cu), a0 = *(const f32x4*)(h0 + cu), hd0 = *(const f32x4*)(HEAD + (size_t)(blk * 2) * FF2 + cu);
            const f32x4 u1 = rr == 0 ? (first ? z4 : a1) : hd0;
            const f32x4 u2 = rr == 0 ? (first ? z4 : a0) : (first ? z4 : a1);
            uc[s] = *(const f32x4*)(cw + 2 * FF2 + cu) * u0 + *(const f32x4*)(cw + FF2 + cu) * u1 + *(const f32x4*)(cw + cu) * u2 + *(const f32x4*)(cb + cu); }
        u32x2 w; w.x = cvt_pk_bf16(silu_f(uc[0][0]) * uc[1][0], silu_f(uc[0][1]) * uc[1][1]); w.y = cvt_pk_bf16(silu_f(uc[0][2]) * uc[1][2], silu_f(uc[0][3]) * uc[1][3]);
        *(u32x2*)(ACT + (size_t)(blk * 64 + rr) * FF + c) = w;
    }
    for (int e = gt; e < MS * FQ; e += gs) {
        const int c = (e % FQ) * 4, row = e / FQ, b = row >> 4, t = row & 15;
        f32x4 uc[2];
#pragma unroll
        for (int s = 0; s < 2; ++s) { const int cu = c + s * FF;
            const f32x4 u0 = *(const f32x4*)(US + (size_t)row * FF2 + cu);
            const f32x4 u1 = *(const f32x4*)((t >= 1 ? US + (size_t)(row - 1) * FF2 : st + (size_t)(b * 2 + 1) * FF2) + cu);
            const f32x4 u2 = *(const f32x4*)((t >= 2 ? US + (size_t)(row - 2) * FF2 : st + (size_t)(b * 2 + t) * FF2) + cu);
            uc[s] = *(const f32x4*)(cw + 2 * FF2 + cu) * u0 + *(const f32x4*)(cw + FF2 + cu) * u1 + *(const f32x4*)(cw + cu) * u2 + *(const f32x4*)(cb + cu); }
        u32x2 w; w.x = cvt_pk_bf16(silu_f(uc[0][0]) * uc[1][0], silu_f(uc[0][1]) * uc[1][1]); w.y = cvt_pk_bf16(silu_f(uc[0][2]) * uc[1][2], silu_f(uc[0][3]) * uc[1][3]);
        *(u32x2*)(ACT + (size_t)(MP + row) * FF + c) = w;
    }
    for (int e = gt; e < 4 * 2 * FQ2; e += gs) { const int cu = (e % FQ2) * 4, rr = (e / FQ2) & 1, b = e / (2 * FQ2); *(f32x4*)(outp + O_PFFN + (size_t)e * 4) = *(const f32x4*)(HALO + (size_t)((b * 64 + 63) * 2 + rr) * FF2 + cu); }
    for (int e = gt; e < 32 * 2 * FQ2; e += gs) { const int cu = (e % FQ2) * 4, rr = (e / FQ2) & 1, b = e / (2 * FQ2); *(f32x4*)(outp + O_SFFN + (size_t)e * 4) = *(const f32x4*)(US + (size_t)(b * 16 + 14 + rr) * FF2 + cu); }
}

#define XB_TMO      128
#define XB_XCNT(j)  (256  + 64 * (j))
#define XB_XSUB(j)  (1280 + 64 * (j))
#define XB_XGEN(j)  (2304 + 64 * (j))
#define XB_TOP      3328
#define XB_TOPGEN   3392
#define XCD_BAR_WORDS 3456
#define XB_SPIN_CAP (1u << 18)
__device__ __forceinline__ unsigned xb_ld(unsigned* p)              { return __hip_atomic_load(p, __ATOMIC_RELAXED, __HIP_MEMORY_SCOPE_AGENT); }
__device__ __forceinline__ unsigned xb_add(unsigned* p, unsigned v) { return __hip_atomic_fetch_add(p, v, __ATOMIC_RELAXED, __HIP_MEMORY_SCOPE_AGENT); }
__device__ __forceinline__ unsigned xb_xcc_id() { return (unsigned)__builtin_amdgcn_s_getreg((3 << 11) | 20) & 0xFu; }
#define XB_SPIN(cond, bar) do { unsigned _sp = 0; while (cond) { __builtin_amdgcn_s_sleep(1); \
    if ((++_sp & 255u) == 0u) { if (xb_ld(&(bar)[XB_TMO])) break; if (_sp > XB_SPIN_CAP) { atomicAdd(&(bar)[XB_TMO], 1u); break; } } } } while (0)
struct XcdBarrier { unsigned* bar; unsigned x; volatile LAS unsigned* st; };
__device__ __forceinline__ bool sum_ok(unsigned* bar) { return xb_ld(&bar[XB_TMO]) == 0u; }
__device__ __forceinline__ XcdBarrier xcd_barrier_post(unsigned* bar, volatile LAS unsigned* st) {
    XcdBarrier b; b.bar = bar; b.x = xb_xcc_id(); b.st = st;
    if (threadIdx.x == 0) st[2] = xb_add(&bar[XB_XCNT(b.x)], 1u);
    return b;
}
__device__ __forceinline__ void xcd_barrier_complete(unsigned* bar, unsigned x, unsigned& nloc, unsigned& nx, unsigned& all32) {
    const unsigned G = gridDim.x * gridDim.y * gridDim.z;
    unsigned sum, cnt, mine, sp = 0u;
    for (;;) {
        sum = 0u; cnt = 0u; mine = 0u; all32 = 1u;
#pragma unroll
        for (unsigned j = 0; j < 16; ++j) { const unsigned c = xb_ld(&bar[XB_XCNT(j)]); sum += c; cnt += (c > 0u) ? 1u : 0u; mine = (j == x) ? c : mine; if (c != 0u && c != 32u) all32 = 0u; }
        if (sum == G) break;
        __builtin_amdgcn_s_sleep(1);
        if ((++sp & 255u) == 0u) { if (xb_ld(&bar[XB_TMO])) break; if (sp > XB_SPIN_CAP) { atomicAdd(&bar[XB_TMO], 1u); break; } }
    }
    nloc = mine > 0u ? mine : 1u; nx = cnt > 0u ? cnt : 1u;
}
__device__ __forceinline__ void xcd_barrier(const XcdBarrier& b) {
    asm volatile("s_waitcnt vmcnt(0)" ::: "memory");
    __syncthreads();
    if (threadIdx.x == 0) {
        unsigned* bar = b.bar;
        __builtin_amdgcn_s_waitcnt(0);
        unsigned nloc = b.st[0], nx = b.st[1];
        if (nloc == 0u) { unsigned all32 = 0u; xcd_barrier_complete(bar, b.x, nloc, nx, all32); b.st[0] = nloc; b.st[1] = nx; b.st[3] = (all32 != 0u && nx == 8u && sum_ok(bar)) ? 1u : 0u; }
        const unsigned old = xb_add(&bar[XB_XSUB(b.x)], 1u);
        const unsigned gen = old / nloc;
        if (old + 1u == (gen + 1u) * nloc) {
            __builtin_amdgcn_fence(__ATOMIC_RELEASE, "agent");
            asm volatile("s_waitcnt vmcnt(0)" ::: "memory");
            const unsigned og = xb_add(&bar[XB_TOP], 1u);
            const unsigned tg = og / nx;
            if (og + 1u == (tg + 1u) * nx) xb_add(&bar[XB_TOPGEN], 1u);
            else XB_SPIN(xb_ld(&bar[XB_TOPGEN]) == tg, bar);
            __builtin_amdgcn_fence(__ATOMIC_ACQUIRE, "agent");
            xb_add(&bar[XB_XGEN(b.x)], 1u);
            asm volatile("s_waitcnt vmcnt(0)" ::: "memory");
        } else {
            XB_SPIN(xb_ld(&bar[XB_XGEN(b.x)]) == gen, bar);
            __builtin_amdgcn_fence(__ATOMIC_ACQUIRE, "agent");
            asm volatile("s_waitcnt vmcnt(0)" ::: "memory");
        }
    }
    __syncthreads();
}

constexpr int N_PHASES = 12;
__global__ void __launch_bounds__(NTHR, 2) hybrid_fwd(Params p_) {
    extern __shared__ __attribute__((aligned(16))) unsigned char smem[];
    PP p = (PP)__builtin_amdgcn_kernarg_segment_ptr();
    const int lo = p->ph_lo, hi = p->ph_hi;
    const int G = gridDim.x;
    volatile LAS unsigned* bst = (volatile LAS unsigned*)((LAS unsigned char*)smem + LDS_BYTES - 16);
    XcdBarrier xbar; xbar.bar = (unsigned*)(p->ws + WS_BAR); xbar.x = 0; xbar.st = bst;
    if (hi - lo > 1) { if (threadIdx.x < 4) bst[threadIdx.x] = 0u; __syncthreads(); xbar = xcd_barrier_post((unsigned*)(p->ws + WS_BAR), bst); }
#ifndef PH_MASK
#define PH_MASK 0xfff
#endif
#define IN(k) (((PH_MASK >> (k)) & 1) && lo <= (k) && (k) < hi)
#ifndef REP_MASK
#define REP_MASK 0
#endif
#define VCU() ((bst[3] == 1u && (hi - lo > 1)) ? (int)(xbar.x + 8u * bst[2]) : (int)blockIdx.x)
#define LAUNDER() asm volatile("" : "+s"(p))
#define REP(k) for (int rep_ = 0; rep_ < 1 + ((REP_MASK >> (k)) & 1); ++rep_)
#define SEAM(k) do { if (IN(k) && IN((k) + 1)) { xcd_barrier(xbar); } } while (0)
    if (hi == 0x7fffffff) cg::this_grid().sync();
    LAUNDER();
    if (IN(0)) REP(0) phase0(p, smem);
    SEAM(0);
    LAUNDER();
    if (IN(1)) REP(1) norm_phase(p, p->in[0], p->in[1], p->in[11], 0, false);
    SEAM(1);
    LAUNDER();
    if (IN(2)) REP(2) { pg8::Gemm g{(const bf16_t*)(p->ws + WS_H), (const bf16_t*)(p->ws + WS_WIN), MT, NIN_PAD, D, D}; pg8::StaticOrder S; S.init(MT, NIN_PAD, G, VCU());
        Epi1 E{(bf16_t*)(p->ws + WS_PROJ), (float*)(p->ws + WS_AB)}; pg8::gemm_phase<Epi1, pg8::StaticOrder>((LAS unsigned char*)smem, g, S, E); }
    SEAM(2);
    LAUNDER();
    if (IN(3)) REP(3) phase3(p, smem);
    SEAM(3);
    LAUNDER();
    if (IN(4)) REP(4) phase4(p, smem);
    SEAM(4);
    LAUNDER();
    if (IN(5)) phase5(p);
    SEAM(5);
    LAUNDER();
    if (IN(6)) REP(6) { pg8::Gemm g{(const bf16_t*)(p->ws + WS_H), (const bf16_t*)(p->ws + WS_WO), MP, D, D, D}; pg8::StaticOrder S; S.init(MP, D, G, VCU());
        EpiRes E{p->in[0], p->in[1], p->out, (const float*)(p->ws + WS_MOD), 2}; pg8::gemm_phase<EpiRes, pg8::StaticOrder>((LAS unsigned char*)smem, g, S, E);
        pg8::Gemm g2{(const bf16_t*)(p->ws + WS_H) + (size_t)MP * D, (const bf16_t*)(p->ws + WS_WO), MS, D, 256, D}; pg8::SplitOrder S2; S2.init(MS, D, D / 256, G, VCU());
        EpiPart E2{(float*)(p->ws + WS_GDN)}; pg8::gemm_phase<EpiPart, pg8::SplitOrder>((LAS unsigned char*)smem, g2, S2, E2); }
    SEAM(6);
    LAUNDER();
    if (IN(7)) REP(7) norm_phase(p, p->out, p->in[1], p->in[12], 3, true);
    SEAM(7);
    LAUNDER();
    if (IN(8)) REP(8) { pg8::Gemm g{(const bf16_t*)(p->ws + WS_H), (const bf16_t*)(p->ws + WS_WUP), MT, FF2, D, D}; pg8::StaticOrder S; S.init(MT, FF2, G, VCU());
        Epi3 E{(bf16_t*)(p->ws + WS_PROJ), (float*)(p->ws + WS_HEAD), (float*)(p->ws + WS_HALO), (float*)(p->ws + WS_US), p->in[23], p->in[24]}; pg8::gemm_phase<Epi3, pg8::StaticOrder>((LAS unsigned char*)smem, g, S, E); }
    SEAM(8);
    LAUNDER();
    if (IN(9)) REP(9) phase9(p);
    SEAM(9);
    LAUNDER();
    if (IN(10)) { pg8::Gemm g{(const bf16_t*)(p->ws + WS_PROJ), (const bf16_t*)(p->ws + WS_WDN), MP, D, FF, FF}; pg8::StaticOrder S; S.init(MP, D, G, VCU());
        EpiRes E{p->out, p->out + (size_t)MP * D, p->out, (const float*)(p->ws + WS_MOD), 5}; pg8::gemm_phase<EpiRes, pg8::StaticOrder>((LAS unsigned char*)smem, g, S, E);
        pg8::Gemm g2{(const bf16_t*)(p->ws + WS_PROJ) + (size_t)MP * FF, (const bf16_t*)(p->ws + WS_WDN), MS, D, 512, FF}; pg8::SplitOrder S2; S2.init(MS, D, FF / 512, G, VCU());
        EpiPart E2{(float*)(p->ws + WS_GDN)}; pg8::gemm_phase<EpiPart, pg8::SplitOrder>((LAS unsigned char*)smem, g2, S2, E2); }
    SEAM(10);
    LAUNDER();
    if (IN(11)) {
        const float* part = (const float*)(p->ws + WS_GDN); const float* mod = (const float*)(p->ws + WS_MOD);
        for (int e = blockIdx.x * NTHR + threadIdx.x; e < MS * D / 4; e += G * NTHR) { const int row = e >> 9, c = (e & 511) * 4; f32x4 a = {0.f, 0.f, 0.f, 0.f};
#pragma unroll
            for (int sp = 0; sp < 11; ++sp) a += *(const f32x4*)(part + (size_t)sp * MS * D + (size_t)row * D + c);
            float* o = p->out + (size_t)(MP + row) * D + c; *(f32x4*)o = *(const f32x4*)o + *(const f32x4*)(mod + (size_t)(4 + (row >> 4)) * NMODW + 5 * D + c) * a; } }
#undef IN
#undef SEAM
}

extern "C" void kernel_launch(void* const* d_in, const int* in_sizes, int n_in, void* d_out, int out_size, void* d_ws, size_t ws_size, hipStream_t stream) {
    static int grid = 0;
    if (grid == 0) {
        if (n_in != 26 || (size_t)out_size != O_END || ws_size < WS_ALL) { fprintf(stderr, "kernel_launch: unexpected shapes (n_in %d out %d ws %zu)\n", n_in, out_size, ws_size); grid = -1; return; }
        int dev = 0, cus = 0, per_cu = 0;
        hipGetDevice(&dev); hipDeviceGetAttribute(&cus, hipDeviceAttributeMultiprocessorCount, dev);
        if (hipFuncSetAttribute((const void*)hybrid_fwd, hipFuncAttributeMaxDynamicSharedMemorySize, LDS_BYTES) != hipSuccess) { fprintf(stderr, "kernel_launch: hipFuncSetAttribute failed\n"); grid = -1; return; }
        if (hipOccupancyMaxActiveBlocksPerMultiprocessor(&per_cu, (const void*)hybrid_fwd, NTHR, LDS_BYTES) != hipSuccess || per_cu < 1) { fprintf(stderr, "kernel_launch: occupancy query says %d\n", per_cu); per_cu = 1; }
        (void)hipGetLastError();
        grid = cus * 1;
    }
    if (grid < 0) return;
    Params p{};
    for (int i = 0; i < 26; ++i) p.in[i] = (const float*)d_in[i];
    p.out = (float*)d_out; p.ws = (unsigned char*)d_ws;
#if N_LAUNCH_MODE == 1
    if (hipMemsetAsync((char*)d_ws + WS_BAR, 0, 16384, stream) != hipSuccess) { fprintf(stderr, "kernel_launch: memset failed\n"); return; }
    p.ph_lo = 0; p.ph_hi = N_PHASES;
    void* args[] = {&p};
    hipError_t e = hipLaunchCooperativeKernel((const void*)hybrid_fwd, dim3(grid), dim3(NTHR), args, LDS_BYTES, stream);
    if (e != hipSuccess) fprintf(stderr, "cooperative launch failed: %s (grid %d)\n", hipGetErrorString(e), grid);
#else
    for (int ph = 0; ph < N_PHASES; ++ph) { p.ph_lo = ph; p.ph_hi = ph + 1; hipLaunchKernelGGL(hybrid_fwd, dim3(grid), dim3(NTHR), LDS_BYTES, stream, p); }
#endif
}
```
